# Optimizing an MI355X kernel written in HIP

```python
import math
import jax, jax.numpy as jnp
from jax import lax
import numpy as np

D_MODEL = 1024
BATCH = 8
SEQ = 2048
DEPTH = 2
DEC_BATCH = 128
DEC_SEQ = 8
PAST_LEN = 16384
PAGE_SIZE = 128

MIX_W = D_MODEL
SSM_W = MIX_W // 2
SSM_P = 16
SSM_G = SSM_W // SSM_P
SSM_N = 64
ATTN_W = MIX_W - SSM_W
HEAD_DIM = 64
N_HEADS = ATTN_W // HEAD_DIM
N_KV = 2
GRP = N_HEADS // N_KV
KV_W = N_KV * HEAD_DIM
IN_W = SSM_W + ATTN_W + 2 * KV_W
WINDOW = 128
D_FF = 2816
PLE_DIM = 256
EPS = 1e-6
NEG_INF = -1e30
DT_MIN = 1e-3
DT_MAX = 1e-1

kernel_name = 'hymba_s5_swa_sink_macaron_step'

F32 = jnp.float32


def rms_norm(x, g):
    xf = x.astype(F32)
    y = xf * lax.rsqrt(jnp.mean(xf * xf, axis=-1, keepdims=True) + EPS)
    return (y * g.astype(F32)).astype(x.dtype)


def swiglu(h, w_gate, w_up, w_down):
    return (jax.nn.silu(h @ w_gate) * (h @ w_up)) @ w_down


def _ssm_combine(e1, e2):
    a1, b1 = e1
    a2, b2 = e2
    return a1 * a2, a2[:, None] * b1 + b2


def ssm_scan(u, h0, lam_re, lam_im, log_dt, b_re, b_im, c_re, c_im, d, w_glu):
    bt, l, _ = u.shape
    lam = lax.complex(lam_re.astype(F32), lam_im.astype(F32))
    dt = jnp.exp(log_dt.astype(F32))[:, None]
    a_bar = jnp.exp(lam * dt)
    b = lax.complex(b_re.astype(F32), b_im.astype(F32))
    b_bar = ((a_bar - 1.0) / lam)[..., None] * b
    c = lax.complex(c_re.astype(F32), c_im.astype(F32))
    ug = u.astype(F32).reshape(bt, l, SSM_G, SSM_P).astype(jnp.complex64)
    bu = jnp.einsum('gnp,blgp->lbgn', b_bar, ug)
    if h0 is not None:
        bu = bu.at[0].add(a_bar * h0)
    a = jnp.broadcast_to(a_bar, (l, SSM_G, SSM_N))
    _, h = lax.associative_scan(_ssm_combine, (a, bu), axis=0)
    y = jnp.einsum('gpn,lbgn->blgp', c, h).real.reshape(bt, l, SSM_W)
    y = y + d.astype(F32) * u.astype(F32)
    y = jax.nn.gelu(y)
    y = y * jax.nn.sigmoid(y @ w_glu.astype(F32))
    return y.astype(u.dtype), h[-1]


def sink_softmax(scores, sinks):
    s = jnp.broadcast_to(sinks.astype(F32).reshape(N_KV, GRP, 1, 1), scores.shape[:-1] + (1,))
    return jax.nn.softmax(jnp.concatenate([scores, s], axis=-1), axis=-1)[..., :-1]


def band_mask(n_q, n_k, offset):
    diff = (jnp.arange(n_q)[:, None] + offset) - jnp.arange(n_k)[None, :]
    return (diff >= 0) & (diff < WINDOW)


def attn_prompt(q, k, v, sinks):
    b, l = q.shape[:2]
    nb = l // WINDOW
    qb = q.reshape(b, nb, WINDOW, N_KV, GRP, HEAD_DIM)
    kb = k.reshape(b, nb, WINDOW, N_KV, HEAD_DIM)
    vb = v.reshape(b, nb, WINDOW, N_KV, HEAD_DIM)
    pad = ((0, 0), (1, 0), (0, 0), (0, 0), (0, 0))
    kk = jnp.concatenate([jnp.pad(kb, pad)[:, :-1], kb], axis=2)
    vv = jnp.concatenate([jnp.pad(vb, pad)[:, :-1], vb], axis=2)
    band = band_mask(WINDOW, 2 * WINDOW, WINDOW)
    key_pos = jnp.arange(nb)[:, None, None] * WINDOW - WINDOW + jnp.arange(2 * WINDOW)[None, None, :]
    mask = band[None] & (key_pos >= 0)
    scores = jnp.einsum('bnqkgd,bnskd->bnkgqs', qb, kk).astype(F32) * (HEAD_DIM ** -0.5)
    scores = jnp.where(mask[None, :, None, None], scores, NEG_INF)
    probs = sink_softmax(scores, sinks)
    out = jnp.einsum('bnkgqs,bnskd->bnqkgd', probs.astype(v.dtype), vv)
    return out.reshape(b, l, ATTN_W)


def attn_sample(q, k, v, cache_k, cache_v, sinks):
    bt, s = q.shape[:2]
    kk = jnp.concatenate([cache_k.astype(k.dtype), k], axis=1)
    vv = jnp.concatenate([cache_v.astype(v.dtype), v], axis=1)
    qb = q.reshape(bt, s, N_KV, GRP, HEAD_DIM)
    mask = band_mask(s, WINDOW + s, WINDOW)
    scores = jnp.einsum('bqkgd,bskd->bkgqs', qb, kk).astype(F32) * (HEAD_DIM ** -0.5)
    scores = jnp.where(mask, scores, NEG_INF)
    probs = sink_softmax(scores, sinks)
    out = jnp.einsum('bkgqs,bskd->bqkgd', probs.astype(v.dtype), vv)
    return out.reshape(bt, s, ATTN_W), kk[:, -WINDOW:], vv[:, -WINDOW:]


def token_mixer(h, lw, h0, cache_k, cache_v):
    bt, l, _ = h.shape
    z = h @ lw['w_in']
    u = z[..., :SSM_W]
    q = z[..., SSM_W:SSM_W + ATTN_W].reshape(bt, l, N_HEADS, HEAD_DIM)
    k = z[..., SSM_W + ATTN_W:SSM_W + ATTN_W + KV_W].reshape(bt, l, N_KV, HEAD_DIM)
    v = z[..., SSM_W + ATTN_W + KV_W:].reshape(bt, l, N_KV, HEAD_DIM)
    y_ssm, h_last = ssm_scan(u, h0, lw['ssm_lam_re'], lw['ssm_lam_im'], lw['ssm_log_dt'],
                             lw['ssm_b_re'], lw['ssm_b_im'], lw['ssm_c_re'], lw['ssm_c_im'],
                             lw['ssm_d'], lw['ssm_w_glu'])
    if cache_k is None:
        y_attn = attn_prompt(q, k, v, lw['attn_sinks'])
        new_k, new_v = k[:, -WINDOW:], v[:, -WINDOW:]
    else:
        y_attn, new_k, new_v = attn_sample(q, k, v, cache_k, cache_v, lw['attn_sinks'])
    y = jnp.concatenate([rms_norm(y_ssm, lw['ssm_out_norm']), rms_norm(y_attn, lw['attn_out_norm'])], axis=-1)
    return y @ lw['w_out'], new_k, new_v, h_last


def layer(x, p, lw, h0, cache_k, cache_v):
    x = x + 0.5 * swiglu(rms_norm(x, lw['ffn1_norm']), lw['ffn1_w_gate'], lw['ffn1_w_up'], lw['ffn1_w_down'])
    mix, new_k, new_v, h_last = token_mixer(rms_norm(x, lw['mix_norm']), lw, h0, cache_k, cache_v)
    x = x + mix
    x = x + 0.5 * swiglu(rms_norm(x, lw['ffn2_norm']), lw['ffn2_w_gate'], lw['ffn2_w_up'], lw['ffn2_w_down'])
    gate = jax.nn.sigmoid((rms_norm(x, lw['ple_norm']) @ lw['ple_w_gate']).astype(F32))
    x = x + ((p @ lw['ple_w_proj']).astype(F32) * gate).astype(x.dtype)
    return x, new_k, new_v, h_last


def setup_inputs(seed: int = 0) -> dict:
    key = jax.random.key(seed)
    ks = iter(jax.random.split(key, 48))

    def nrm(shape, scale=1.0):
        return jax.random.normal(next(ks), shape, F32) * scale

    def gain(shape):
        return 1.0 + nrm(shape, 0.05)

    L = DEPTH
    inp = {}
    inp['x_prompt'] = nrm((BATCH, SEQ, D_MODEL))
    inp['x_sample'] = nrm((DEC_BATCH, DEC_SEQ, D_MODEL))
    inp['cache_k'] = nrm((L, DEC_BATCH, WINDOW, N_KV, HEAD_DIM))
    inp['cache_v'] = nrm((L, DEC_BATCH, WINDOW, N_KV, HEAD_DIM))
    inp['state_ssm_re'] = nrm((L, DEC_BATCH, SSM_G, SSM_N), 0.5)
    inp['state_ssm_im'] = nrm((L, DEC_BATCH, SSM_G, SSM_N), 0.5)
    inp['p_prompt'] = nrm((L, BATCH, SEQ, PLE_DIM))
    inp['p_sample'] = nrm((L, DEC_BATCH, DEC_SEQ, PLE_DIM))
    inp['ffn1_norm'] = gain((L, D_MODEL))
    inp['ffn1_w_gate'] = nrm((L, D_MODEL, D_FF), D_MODEL ** -0.5)
    inp['ffn1_w_up'] = nrm((L, D_MODEL, D_FF), D_MODEL ** -0.5)
    inp['ffn1_w_down'] = nrm((L, D_FF, D_MODEL), D_FF ** -0.5)
    inp['mix_norm'] = gain((L, D_MODEL))
    inp['w_in'] = nrm((L, D_MODEL, IN_W), D_MODEL ** -0.5)
    inp['ssm_lam_re'] = -0.5 + nrm((L, SSM_G, SSM_N), 0.01)
    inp['ssm_lam_im'] = jnp.pi * jnp.arange(SSM_N, dtype=F32) + nrm((L, SSM_G, SSM_N), 0.01)
    inp['ssm_log_dt'] = jax.random.uniform(next(ks), (L, SSM_G), F32, math.log(DT_MIN), math.log(DT_MAX))
    inp['ssm_b_re'] = nrm((L, SSM_G, SSM_N, SSM_P), (2 * SSM_P) ** -0.5)
    inp['ssm_b_im'] = nrm((L, SSM_G, SSM_N, SSM_P), (2 * SSM_P) ** -0.5)
    inp['ssm_c_re'] = nrm((L, SSM_G, SSM_P, SSM_N), (2 * SSM_N) ** -0.5)
    inp['ssm_c_im'] = nrm((L, SSM_G, SSM_P, SSM_N), (2 * SSM_N) ** -0.5)
    inp['ssm_d'] = nrm((L, SSM_W))
    inp['ssm_w_glu'] = nrm((L, SSM_W, SSM_W), SSM_W ** -0.5)
    inp['ssm_out_norm'] = gain((L, SSM_W))
    inp['attn_sinks'] = nrm((L, N_HEADS), 0.5)
    inp['attn_out_norm'] = gain((L, ATTN_W))
    inp['w_out'] = nrm((L, MIX_W, D_MODEL), MIX_W ** -0.5)
    inp['ffn2_norm'] = gain((L, D_MODEL))
    inp['ffn2_w_gate'] = nrm((L, D_MODEL, D_FF), D_MODEL ** -0.5)
    inp['ffn2_w_up'] = nrm((L, D_MODEL, D_FF), D_MODEL ** -0.5)
    inp['ffn2_w_down'] = nrm((L, D_FF, D_MODEL), D_FF ** -0.5)
    inp['ple_norm'] = gain((L, D_MODEL))
    inp['ple_w_gate'] = nrm((L, D_MODEL, D_MODEL), D_MODEL ** -0.5)
    inp['ple_w_proj'] = nrm((L, PLE_DIM, D_MODEL), PLE_DIM ** -0.5)
    inp['final_norm'] = gain((D_MODEL,))
    return inp


def reference(x_prompt, x_sample, cache_k, cache_v, state_ssm_re, state_ssm_im, p_prompt, p_sample,
              ffn1_norm, ffn1_w_gate, ffn1_w_up, ffn1_w_down, mix_norm, w_in,
              ssm_lam_re, ssm_lam_im, ssm_log_dt, ssm_b_re, ssm_b_im, ssm_c_re, ssm_c_im,
              ssm_d, ssm_w_glu, ssm_out_norm, attn_sinks, attn_out_norm, w_out,
              ffn2_norm, ffn2_w_gate, ffn2_w_up, ffn2_w_down, ple_norm, ple_w_gate, ple_w_proj,
              final_norm):
    stacked = dict(ffn1_norm=ffn1_norm, ffn1_w_gate=ffn1_w_gate, ffn1_w_up=ffn1_w_up, ffn1_w_down=ffn1_w_down,
                   mix_norm=mix_norm, w_in=w_in, ssm_lam_re=ssm_lam_re, ssm_lam_im=ssm_lam_im,
                   ssm_log_dt=ssm_log_dt, ssm_b_re=ssm_b_re, ssm_b_im=ssm_b_im, ssm_c_re=ssm_c_re,
                   ssm_c_im=ssm_c_im, ssm_d=ssm_d, ssm_w_glu=ssm_w_glu, ssm_out_norm=ssm_out_norm,
                   attn_sinks=attn_sinks, attn_out_norm=attn_out_norm, w_out=w_out,
                   ffn2_norm=ffn2_norm, ffn2_w_gate=ffn2_w_gate, ffn2_w_up=ffn2_w_up, ffn2_w_down=ffn2_w_down,
                   ple_norm=ple_norm, ple_w_gate=ple_w_gate, ple_w_proj=ple_w_proj)
    xp, xs = x_prompt, x_sample
    kp_l, vp_l, hp_l, ks_l, vs_l, hs_l = [], [], [], [], [], []
    for i in range(DEPTH):
        lw = {name: arr[i] for name, arr in stacked.items()}
        xp, kp, vp, hp = layer(xp, p_prompt[i], lw, None, None, None)
        h0 = lax.complex(state_ssm_re[i].astype(F32), state_ssm_im[i].astype(F32))
        xs, ks_, vs_, hs = layer(xs, p_sample[i], lw, h0, cache_k[i], cache_v[i])
        kp_l.append(kp); vp_l.append(vp); hp_l.append(hp)
        ks_l.append(ks_); vs_l.append(vs_); hs_l.append(hs)
    y_prompt = rms_norm(xp, final_norm)
    y_sample = rms_norm(xs, final_norm)
    hp_all = jnp.stack(hp_l)
    hs_all = jnp.stack(hs_l)
    return (y_prompt, y_sample,
            jnp.stack(kp_l), jnp.stack(vp_l), hp_all.real, hp_all.imag,
            jnp.stack(ks_l), jnp.stack(vs_l), hs_all.real, hs_all.imag)
```

```cpp
#include <hip/hip_runtime.h>
#include <hip/hip_cooperative_groups.h>
#include <cstdio>
#include <cstdint>
namespace pg8 {
#define PG8_LAS __attribute__((address_space(3)))
typedef unsigned short bf16_t;
typedef short bf16x8 __attribute__((ext_vector_type(8)));
typedef float f32x4 __attribute__((ext_vector_type(4)));
typedef unsigned u32x4 __attribute__((ext_vector_type(4)));
constexpr int BM = 256, BK = 64, HALF = 128, HTB = HALF * BK * 2  , STAGE_BYTES = 8 * HTB, NXCD = 8, WGM = 8;

__host__ __device__ __forceinline__ int lds_byte(int r, int c) { const int st = (r >> 4) * 2 + (c >> 5), rr = r & 15, cc = c & 31, ob = rr * 64 + cc * 2; return st * 1024 + (ob ^ (((ob >> 9) & 1) << 5)); }
__host__ __device__ __forceinline__ void stage_rc(int b, int& R, int& C) { const int st = b / 1024, sb = b % 1024, swz = sb ^ (((sb >> 9) & 1) << 5); R = (st >> 1) * 16 + swz / 64; C = (st & 1) * 32 + (swz % 64) / 2; }
__host__ __device__ __forceinline__ int perm32(int rho) { const int n = rho >> 4, i = rho & 15; return 8 * (i >> 2) + 4 * n + (i & 3); }

struct Unit { int pm, pn; };
struct Gemm { const bf16_t* A; const bf16_t* Bt; int M, N, K; };

struct StaticOrder {
    int nM, nN, nwg, G, c;
    __host__ __device__ void init(int M, int N, int G_, int c_) { nM = M / BM; nN = N / BM; nwg = nM * nN; G = G_; c = c_; }
    __host__ __device__ bool next(int i, Unit& u) const {
        const long L = (long)i * G + c; if (L >= nwg) return false;
        int wgid = (int)L; { const int q = nwg / NXCD, r = nwg % NXCD, xcd = wgid % NXCD, off = wgid / NXCD; wgid = (xcd < r ? xcd * (q + 1) : r * (q + 1) + (xcd - r) * q) + off; }
        const int nig = WGM * nN, gid = wgid / nig, fm = gid * WGM, gsz = (nM - fm) < WGM ? (nM - fm) : WGM;
        u.pm = fm + ((wgid % nig) % gsz); u.pn = (wgid % nig) / gsz; return true;
    }
    __device__ __forceinline__ void a_ready(const Unit&) const {}
    __device__ __forceinline__ void done(const Unit&) const {}
};
__device__ __forceinline__ unsigned cvt_pk_bf16(float lo, float hi) { unsigned r; asm volatile("v_cvt_pk_bf16_f32 %0, %1, %2" : "=v"(r) : "v"(lo), "v"(hi)); return r; }
typedef float f32x2 __attribute__((ext_vector_type(2)));
template <class Epi, class Sched, bool STAMP = false>
__device__ __forceinline__ void gemm_phase(PG8_LAS unsigned char* lds, const Gemm g, const Sched& S, const Epi& E, unsigned long long* stamps) {
    int tid_l = threadIdx.x; asm volatile("" : "+v"(tid_l)); const int tid = tid_l, wid = __builtin_amdgcn_readfirstlane(tid >> 6), lane = tid & 63, wr = wid >> 2, wc = wid & 3, fr = lane & 15, fq = lane >> 4;
    const int K = g.K, nt = K / BK;
    int ts_lo = 0, ts_hi = 0, nts = 0; const unsigned long long rt_entry = STAMP ? (unsigned long long)wall_clock64() : 0ull;
#define PG8_STAMP() do { if (STAMP && wid == 0 && nts < 64) { const unsigned long long _c = (unsigned long long)clock64(); \
        ts_lo = (lane == nts) ? (int)(unsigned)_c : ts_lo; ts_hi = (lane == nts) ? (int)(unsigned)(_c >> 32) : ts_hi; ++nts; } } while (0)
    PG8_STAMP();
    unsigned voffA[2], voffB[2];
#pragma unroll
    for (int i = 0; i < 2; ++i) { int R, C; stage_rc(tid * 16 + i * 8192, R, C); const int Rb = Epi::PERM ? ((R & ~31) + perm32(R & 31)) : R;
        voffA[i] = (unsigned)(R * K + C) * 2u; voffB[i] = (unsigned)(Rb * K + C) * 2u; }
    const size_t kstep = (size_t)(BK * 2);
    const size_t hstep = (size_t)HALF * K * 2;
    const size_t tstep = 2 * hstep;
    const unsigned ldsw = (unsigned)wid * 1024u;
    const int aoff = lds_byte(wr * 64 + fr, fq * 8), boff = lds_byte(wc * 32 + fr, fq * 8);
#define PG8_SA(b, h) (((b) * 2 + (h)) * HTB)
#define PG8_SB(b, h) ((4 + (b) * 2 + (h)) * HTB)
#define PG8_STAGE(bufoff, gbase, voff) do { _Pragma("unroll") for (int _i = 0; _i < 2; ++_i) \
        __builtin_amdgcn_global_load_lds((const unsigned*)((const char*)(gbase) + (voff)[_i]), (PG8_LAS unsigned*)(lds + (bufoff) + ldsw + _i * 8192), 16, 0, 0); } while (0)
#define PG8_LDA(dst, b, h) do { _Pragma("unroll") for (int m = 0; m < 4; ++m) _Pragma("unroll") for (int k = 0; k < 2; ++k) dst[m][k] = *(const PG8_LAS bf16x8*)(lds + PG8_SA(b, h) + aoff + m * 2048 + k * 1024); } while (0)
#define PG8_LDB(dst, b, h) do { _Pragma("unroll") for (int n = 0; n < 2; ++n) _Pragma("unroll") for (int k = 0; k < 2; ++k) dst[n][k] = *(const PG8_LAS bf16x8*)(lds + PG8_SB(b, h) + boff + n * 2048 + k * 1024); } while (0)
#define PG8_MMA(ai, bj, At, Bt) do { __builtin_amdgcn_s_setprio(1); _Pragma("unroll") for (int m = 0; m < 4; ++m) _Pragma("unroll") for (int n = 0; n < 2; ++n) _Pragma("unroll") for (int k = 0; k < 2; ++k) \
        acc[ai][bj][m][n] = __builtin_amdgcn_mfma_f32_16x16x32_bf16(Bt[n][k], At[m][k], acc[ai][bj][m][n], 0, 0, 0); __builtin_amdgcn_s_setprio(0); } while (0)
#define PG8_WAIT_V(n) asm volatile("s_waitcnt vmcnt(" #n ")" ::: "memory")
#define PG8_WAIT_L(n) asm volatile("s_waitcnt lgkmcnt(" #n ")" ::: "memory")
#define PG8_BAR __builtin_amdgcn_s_barrier()
#define PG8_SCHED __builtin_amdgcn_sched_barrier(0)
    Unit cur, nxt; int ui = 0;
    if (!S.next(0, cur)) return;
    f32x4 acc[2][2][4][2];
#pragma unroll
    for (int a = 0; a < 2; ++a)
#pragma unroll
        for (int b = 0; b < 2; ++b)
#pragma unroll
            for (int m = 0; m < 4; ++m)
#pragma unroll
                for (int n = 0; n < 2; ++n) acc[a][b][m][n] = (f32x4){0.f, 0.f, 0.f, 0.f};
    bf16x8 At[4][2], B0[2][2], B1[2][2];
    const char* cA = (const char*)g.A + (size_t)cur.pm * tstep; const char* cB = (const char*)g.Bt + (size_t)cur.pn * tstep;
    S.a_ready(cur);
    PG8_STAGE(PG8_SB(0, 0), cB, voffB); PG8_STAGE(PG8_SA(0, 0), cA, voffA); PG8_STAGE(PG8_SB(0, 1), cB + hstep, voffB); PG8_STAGE(PG8_SA(0, 1), cA + hstep, voffA);
    if (wr == 1) PG8_BAR;
    PG8_WAIT_V(4); PG8_BAR;
    PG8_STAGE(PG8_SB(1, 0), cB + kstep, voffB); PG8_STAGE(PG8_SA(1, 0), cA + kstep, voffA); PG8_STAGE(PG8_SB(1, 1), cB + hstep + kstep, voffB);
    PG8_WAIT_V(6); PG8_BAR;
    PG8_STAMP();
    for (;;) {
        const bool has_next = S.next(ui + 1, nxt);
        const char* nA = has_next ? (const char*)g.A + (size_t)nxt.pm * tstep : cA; const char* nB = has_next ? (const char*)g.Bt + (size_t)nxt.pn * tstep : cB;
        for (int t = 0; t < nt; t += 2) {
            const bool last = (t == nt - 2);
            const char* a1 = cA + (size_t)(t + 1) * kstep;
            const char* a2 = last ? nA : cA + (size_t)(t + 2) * kstep; const char* b2 = last ? nB : cB + (size_t)(t + 2) * kstep;
            const char* a3 = a2 + kstep; const char* b3 = b2 + kstep;
            if (last && has_next) S.a_ready(nxt);
            PG8_LDB(B0, 0, 0); PG8_SCHED; PG8_LDA(At, 0, 0); PG8_STAGE(PG8_SA(1, 1), a1 + hstep, voffA);
            PG8_WAIT_L(8); PG8_BAR; PG8_WAIT_L(0); PG8_MMA(0, 0, At, B0); PG8_BAR; PG8_SCHED;
            PG8_LDB(B1, 0, 1); PG8_STAGE(PG8_SB(0, 0), b2, voffB);
            PG8_BAR; PG8_WAIT_L(0); PG8_MMA(0, 1, At, B1); PG8_BAR;
            PG8_LDA(At, 0, 1); PG8_STAGE(PG8_SA(0, 0), a2, voffA);
            PG8_BAR; PG8_WAIT_L(0); PG8_MMA(1, 0, At, B0); PG8_BAR; PG8_SCHED;
            PG8_STAGE(PG8_SB(0, 1), b2 + hstep, voffB);
            PG8_WAIT_V(6); PG8_BAR; PG8_MMA(1, 1, At, B1); PG8_BAR;
            PG8_LDB(B0, 1, 0); PG8_SCHED; PG8_LDA(At, 1, 0); PG8_STAGE(PG8_SA(0, 1), a2 + hstep, voffA);
            PG8_WAIT_L(8); PG8_BAR; PG8_WAIT_L(0); PG8_MMA(0, 0, At, B0); PG8_BAR; PG8_SCHED;
            PG8_LDB(B1, 1, 1); PG8_STAGE(PG8_SB(1, 0), b3, voffB);
            PG8_BAR; PG8_WAIT_L(0); PG8_MMA(0, 1, At, B1); PG8_BAR;
            PG8_LDA(At, 1, 1); PG8_STAGE(PG8_SA(1, 0), a3, voffA);
            PG8_BAR; PG8_WAIT_L(0); PG8_MMA(1, 0, At, B0); PG8_BAR; PG8_SCHED;
            PG8_STAGE(PG8_SB(1, 1), b3 + hstep, voffB);
            PG8_WAIT_V(6); PG8_BAR; PG8_MMA(1, 1, At, B1); PG8_BAR;
        }
        PG8_STAMP();
        if constexpr (!Epi::AFTER_DRAIN) { E(acc, cur, wr, wc, fr, fq); S.done(cur); }
        PG8_STAMP();
        if (!has_next) break;
#pragma unroll
        for (int a = 0; a < 2; ++a)
#pragma unroll
            for (int b = 0; b < 2; ++b)
#pragma unroll
                for (int m = 0; m < 4; ++m)
#pragma unroll
                    for (int n = 0; n < 2; ++n) acc[a][b][m][n] = (f32x4){0.f, 0.f, 0.f, 0.f};
        cur = nxt; cA = nA; cB = nB; ++ui;
    }
    PG8_WAIT_V(0);
    if (wr == 0) PG8_BAR;
    PG8_BAR;
    if constexpr (Epi::AFTER_DRAIN) { E.fused(acc, cur, wr, wc, fr, fq, lds, wid, lane); S.done(cur); }
    PG8_STAMP();
    if (STAMP && wid == 0) { stamps[lane] = lane < nts ? (((unsigned long long)(unsigned)ts_hi << 32) | (unsigned)ts_lo) : 0ull;
        if (lane == 62) stamps[62] = rt_entry; if (lane == 63) stamps[63] = (unsigned long long)wall_clock64(); }
#undef PG8_STAMP
#undef PG8_SA
#undef PG8_SB
#undef PG8_STAGE
#undef PG8_LDA
#undef PG8_LDB
#undef PG8_MMA
#undef PG8_WAIT_V
#undef PG8_WAIT_L
#undef PG8_BAR
#undef PG8_SCHED
}
}

namespace cg = cooperative_groups;
using pg8::bf16_t; using pg8::bf16x8; using pg8::f32x4; using pg8::u32x4; using pg8::Unit; using pg8::cvt_pk_bf16;
typedef float f32x16 __attribute__((ext_vector_type(16)));
typedef unsigned u32x2 __attribute__((ext_vector_type(2)));

constexpr int D = 1024, MP = 16384, MSM = 1024, M = MP + MSM, FF = 2816, INW = 1280;
constexpr int NL = 2, SEQ = 2048, NB = 8, DB = 128;
constexpr int LDS_BYTES = 131072 + 4096;
constexpr int NIN = 35;

constexpr size_t E_WGU = (size_t)2 * FF * D, E_WD = (size_t)D * FF, E_WIN = (size_t)INW * D, E_WGLU = 512 * 512, E_WO = 1024 * 512, E_WPG = 1024 * 1024, E_WPP = 1024 * 256;
constexpr size_t OW_GU1 = 0, OW_D1 = OW_GU1 + E_WGU, OW_IN = OW_D1 + E_WD, OW_GLU = OW_IN + E_WIN, OW_OA = OW_GLU + E_WGLU, OW_OB = OW_OA + E_WO,
                 OW_GU2 = OW_OB + E_WO, OW_D2 = OW_GU2 + E_WGU, OW_PG = OW_D2 + E_WD, OW_PP = OW_PG + E_WPG, E_WLAYER = OW_PP + E_WPP;
constexpr size_t WS_W = 0;
constexpr size_t WS_XB0 = WS_W + 2 * E_WLAYER * 2;
constexpr size_t WS_XB1 = WS_XB0 + (size_t)M * D * 2;
constexpr size_t WS_HB = WS_XB1 + (size_t)M * D * 2;
constexpr size_t SZ_512 = (size_t)M * 512 * 2;
constexpr size_t WS_KP = WS_HB + (size_t)M * FF * 2;
constexpr size_t WS_VTP = WS_KP + (size_t)MP * 128 * 2;
constexpr size_t WS_KS = WS_VTP + (size_t)MP * 128 * 2;
constexpr size_t WS_VTS = WS_KS + (size_t)NL * DB * 160 * 128 * 2;
constexpr size_t WS_PB = WS_VTS + (size_t)NL * DB * 160 * 128 * 2;
constexpr size_t WS_SSQ = WS_PB + (size_t)NL * M * 256 * 2;
constexpr size_t SZ_SSQ16 = (size_t)M * 16 * 4, SZ_SSQ8 = (size_t)M * 8 * 4;
constexpr size_t WS_TAB = WS_SSQ + 4 * SZ_SSQ16 + 2 * SZ_SSQ8;
constexpr size_t TAB_BB = 0, TAB_CM = 131072, TAB_AR = 262144, TAB_AI = TAB_AR + 8192, TAB_A2R = TAB_AI + 8192, TAB_A2I = TAB_A2R + 8192, TAB_LAYER = TAB_A2I + 8192;
constexpr size_t WS_END = WS_TAB + NL * TAB_LAYER;

constexpr size_t O_Y = 0, O_KP = (size_t)M * D, O_VP = O_KP + (size_t)NL * NB * 128 * 128, O_HPR = O_VP + (size_t)NL * NB * 128 * 128, O_HPI = O_HPR + (size_t)NL * NB * 32 * 64,
                 O_KS = O_HPI + (size_t)NL * NB * 32 * 64, O_VS = O_KS + (size_t)NL * DB * 128 * 128, O_HSR = O_VS + (size_t)NL * DB * 128 * 128, O_HSI = O_HSR + (size_t)NL * DB * 32 * 64;

struct Args { const float* in[NIN]; float* out; unsigned char* ws; };
typedef const __attribute__((address_space(4))) unsigned long long* kargp_t;
__device__ __forceinline__ kargp_t kbase() { kargp_t p = (kargp_t)__builtin_amdgcn_kernarg_segment_ptr(); asm volatile("" : "+s"(p)); return p; }
__device__ __forceinline__ const float* kin(int i) { return (const float*)kbase()[i]; }
__device__ __forceinline__ float* kout() { return (float*)kbase()[NIN]; }
__device__ __forceinline__ unsigned char* kws() { return (unsigned char*)kbase()[NIN + 1]; }

__device__ __forceinline__ float wave_sum(float v) {
#pragma unroll
    for (int o = 1; o < 64; o <<= 1) v += __shfl_xor(v, o);
    return v;
}
__device__ __forceinline__ float sigm(float x) { return __builtin_amdgcn_rcpf(1.0f + __builtin_amdgcn_exp2f(-1.44269504f * x)); }
__device__ __forceinline__ float silu_f(float x) { return x * sigm(x); }
__device__ __forceinline__ float gelu_tanh(float x) { return x * sigm(1.5957691216f * (x + 0.044715f * x * x * x)); }
__device__ __forceinline__ float bf2f(unsigned short b) { return __uint_as_float(((unsigned)b) << 16); }
__device__ __forceinline__ float bflo(unsigned w) { return __uint_as_float(w << 16); }
__device__ __forceinline__ float bfhi(unsigned w) { return __uint_as_float(w & 0xffff0000u); }
__device__ __forceinline__ unsigned short f2bf(float f) { return (unsigned short)(cvt_pk_bf16(f, 0.f) & 0xffffu); }
__device__ __forceinline__ float rs16(const float* ssq, int row) {
    const f32x4* p = (const f32x4*)(ssq + (size_t)row * 16); const f32x4 a = p[0], b = p[1], c = p[2], d = p[3]; const f32x4 s = (a + b) + (c + d);
    return __builtin_amdgcn_rsqf(((s.x + s.y) + (s.z + s.w)) * (1.f / 1024.f) + 1e-6f);
}
__device__ __forceinline__ float rs8(const float* ssq, int row) {
    const f32x4* p = (const f32x4*)(ssq + (size_t)row * 8); const f32x4 a = p[0], b = p[1]; const f32x4 s = a + b;
    return __builtin_amdgcn_rsqf(((s.x + s.y) + (s.z + s.w)) * (1.f / 512.f) + 1e-6f);
}


struct EpiSwiglu {
    static constexpr bool PERM = true, AFTER_DRAIN = false;
    bf16_t* H; const float* ssq;
    __device__ __forceinline__ void operator()(const f32x4 (&acc)[2][2][4][2], const Unit& u, int wr, int wc, int fr, int fq) const {
        const int row0 = u.pm * 256 + wr * 64 + fr, col0 = u.pn * 128 + wc * 32 + 8 * fq;
#pragma unroll
        for (int ai = 0; ai < 2; ++ai)
#pragma unroll
            for (int m = 0; m < 4; ++m) {
                const int row = row0 + ai * 128 + m * 16; const float rs = rs16(ssq, row);
                float hv[8];
#pragma unroll
                for (int n = 0; n < 2; ++n)
#pragma unroll
                    for (int j = 0; j < 4; ++j) { const float g = acc[ai][0][m][n][j] * rs, up = acc[ai][1][m][n][j] * rs; hv[n * 4 + j] = silu_f(g) * up; }
                u32x4 w; w.x = cvt_pk_bf16(hv[0], hv[1]); w.y = cvt_pk_bf16(hv[2], hv[3]); w.z = cvt_pk_bf16(hv[4], hv[5]); w.w = cvt_pk_bf16(hv[6], hv[7]);
                *(u32x4*)(H + (size_t)row * FF + col0) = w;
            }
    }
};

template <int MODE, bool WXB> struct EpiRes {
    static constexpr bool PERM = false, AFTER_DRAIN = false;
    float* x; bf16_t* xb; float* ssq_out; const float* ssq_in; const bf16_t* pp;
    __device__ __forceinline__ void operator()(const f32x4 (&acc)[2][2][4][2], const Unit& u, int wr, int wc, int fr, int fq) const {
        const int row0 = u.pm * 256 + wr * 64 + fr, col0 = u.pn * 256 + wc * 32 + 4 * fq;
#pragma unroll
        for (int ai = 0; ai < 2; ++ai)
#pragma unroll
            for (int m = 0; m < 4; ++m) {
                const int row = row0 + ai * 128 + m * 16; float rs = 0.5f;
                if (MODE == 1) rs = rs8(ssq_in, row);
                if (MODE == 2) rs = rs16(ssq_in, row);
                float s = 0.f;
#pragma unroll
                for (int bj = 0; bj < 2; ++bj)
#pragma unroll
                    for (int n = 0; n < 2; ++n) {
                        const size_t off = (size_t)row * D + col0 + bj * 128 + n * 16;
                        f32x4 xv = *(const f32x4*)(x + off); const f32x4 a = acc[ai][bj][m][n];
                        if (MODE == 2) {
                            const u32x2 pw = *(const u32x2*)(pp + off);
                            xv.x += bflo(pw.x) * sigm(rs * a.x); xv.y += bfhi(pw.x) * sigm(rs * a.y); xv.z += bflo(pw.y) * sigm(rs * a.z); xv.w += bfhi(pw.y) * sigm(rs * a.w);
                        } else xv += a * rs;
                        *(f32x4*)(x + off) = xv;
                        if (WXB) { u32x2 w; w.x = cvt_pk_bf16(xv.x, xv.y); w.y = cvt_pk_bf16(xv.z, xv.w); *(u32x2*)(xb + off) = w; s += (xv.x * xv.x + xv.y * xv.y) + (xv.z * xv.z + xv.w * xv.w); }
                    }
                if (WXB) { s += __shfl_xor(s, 16); s += __shfl_xor(s, 32); if (fq == 0) ssq_out[(size_t)row * 16 + u.pn * 4 + wc] = s; }
            }
    }
};

struct EpiIn {
    static constexpr bool PERM = true, AFTER_DRAIN = false;
    bf16_t *UB, *QB, *KP, *VTP, *KS, *VTS; const float* ssq; float *okp, *ovp, *oks, *ovs; int l;
    __device__ __forceinline__ void operator()(const f32x4 (&acc)[2][2][4][2], const Unit& u, int wr, int wc, int fr, int fq) const {
        const int row0 = u.pm * 256 + wr * 64 + fr, cw = wc * 32 + 8 * fq;
#pragma unroll
        for (int ai = 0; ai < 2; ++ai)
#pragma unroll
            for (int m = 0; m < 4; ++m) {
                const int row = row0 + ai * 128 + m * 16; const float rs = rs16(ssq, row);
                if (u.pn < 4) {
                    const float sc = (u.pn < 2) ? rs : rs * 0.125f; bf16_t* dst = ((u.pn < 2) ? UB : QB) + (size_t)row * 512 + (u.pn & 1) * 256 + cw;
#pragma unroll
                    for (int bj = 0; bj < 2; ++bj) { const f32x4 v0 = acc[ai][bj][m][0] * sc, v1 = acc[ai][bj][m][1] * sc;
                        u32x4 w; w.x = cvt_pk_bf16(v0.x, v0.y); w.y = cvt_pk_bf16(v0.z, v0.w); w.z = cvt_pk_bf16(v1.x, v1.y); w.w = cvt_pk_bf16(v1.z, v1.w);
                        *(u32x4*)(dst + bj * 128) = w; }
                } else {
                    const f32x4 k0 = acc[ai][0][m][0] * rs, k1 = acc[ai][0][m][1] * rs, v0 = acc[ai][1][m][0] * rs, v1 = acc[ai][1][m][1] * rs;
                    u32x4 kw; kw.x = cvt_pk_bf16(k0.x, k0.y); kw.y = cvt_pk_bf16(k0.z, k0.w); kw.z = cvt_pk_bf16(k1.x, k1.y); kw.w = cvt_pk_bf16(k1.z, k1.w);
                    const float vv[8] = {v0.x, v0.y, v0.z, v0.w, v1.x, v1.y, v1.z, v1.w};
                    const int kvh = cw >> 6, d0 = cw & 63;
                    if (row < MP) {
                        const int b = row >> 11, t = row & 2047;
                        *(u32x4*)(KP + (size_t)row * 128 + cw) = kw;
                        bf16_t* vt = VTP + ((size_t)(b * 2 + kvh) * 64 + d0) * 2048 + t;
#pragma unroll
                        for (int j = 0; j < 8; ++j) vt[(size_t)j * 2048] = f2bf(vv[j]);
                        if (t >= 1920) { const size_t o = ((size_t)(l * NB + b) * 128 + (t - 1920)) * 128 + cw;
                            *(f32x4*)(okp + o) = k0; *(f32x4*)(okp + o + 4) = k1; *(f32x4*)(ovp + o) = v0; *(f32x4*)(ovp + o + 4) = v1; }
                    } else {
                        const int r = row - MP, b = r >> 3, s = r & 7;
                        *(u32x4*)(KS + ((size_t)(l * DB + b) * 160 + 128 + s) * 128 + cw) = kw;
                        bf16_t* vt = VTS + ((size_t)((l * DB + b) * 2 + kvh) * 64 + d0) * 160 + 128 + s;
#pragma unroll
                        for (int j = 0; j < 8; ++j) vt[(size_t)j * 160] = f2bf(vv[j]);
                        const size_t o = ((size_t)(l * DB + b) * 128 + 120 + s) * 128 + cw;
                        *(f32x4*)(oks + o) = k0; *(f32x4*)(oks + o + 4) = k1; *(f32x4*)(ovs + o) = v0; *(f32x4*)(ovs + o + 4) = v1;
                    }
                }
            }
    }
};

struct EpiGlu {
    static constexpr bool PERM = true, AFTER_DRAIN = false;
    const bf16_t* YG; bf16_t* YS; float* ssq_out;
    __device__ __forceinline__ void operator()(const f32x4 (&acc)[2][2][4][2], const Unit& u, int wr, int wc, int fr, int fq) const {
        const int row0 = u.pm * 256 + wr * 64 + fr, col0 = u.pn * 256 + wc * 32 + 8 * fq;
#pragma unroll
        for (int ai = 0; ai < 2; ++ai)
#pragma unroll
            for (int m = 0; m < 4; ++m) {
                const int row = row0 + ai * 128 + m * 16; float s = 0.f;
#pragma unroll
                for (int bj = 0; bj < 2; ++bj) {
                    const size_t off = (size_t)row * 512 + col0 + bj * 128; const u32x4 yw = *(const u32x4*)(YG + off);
                    const f32x4 a0 = acc[ai][bj][m][0], a1 = acc[ai][bj][m][1];
                    float o[8];
                    o[0] = bflo(yw.x) * sigm(a0.x); o[1] = bfhi(yw.x) * sigm(a0.y); o[2] = bflo(yw.y) * sigm(a0.z); o[3] = bfhi(yw.y) * sigm(a0.w);
                    o[4] = bflo(yw.z) * sigm(a1.x); o[5] = bfhi(yw.z) * sigm(a1.y); o[6] = bflo(yw.w) * sigm(a1.z); o[7] = bfhi(yw.w) * sigm(a1.w);
#pragma unroll
                    for (int j = 0; j < 8; ++j) s += o[j] * o[j];
                    u32x4 w; w.x = cvt_pk_bf16(o[0], o[1]); w.y = cvt_pk_bf16(o[2], o[3]); w.z = cvt_pk_bf16(o[4], o[5]); w.w = cvt_pk_bf16(o[6], o[7]);
                    *(u32x4*)(YS + off) = w;
                }
                s += __shfl_xor(s, 16); s += __shfl_xor(s, 32); if (fq == 0) ssq_out[(size_t)row * 8 + u.pn * 4 + wc] = s;
            }
    }
};

struct EpiBf {
    static constexpr bool PERM = true, AFTER_DRAIN = false;
    bf16_t* O; int ldc;
    __device__ __forceinline__ void operator()(const f32x4 (&acc)[2][2][4][2], const Unit& u, int wr, int wc, int fr, int fq) const {
        const int row0 = u.pm * 256 + wr * 64 + fr, col0 = u.pn * 256 + wc * 32 + 8 * fq;
#pragma unroll
        for (int ai = 0; ai < 2; ++ai)
#pragma unroll
            for (int m = 0; m < 4; ++m) {
                const int row = row0 + ai * 128 + m * 16;
#pragma unroll
                for (int bj = 0; bj < 2; ++bj) { const f32x4 v0 = acc[ai][bj][m][0], v1 = acc[ai][bj][m][1];
                    u32x4 w; w.x = cvt_pk_bf16(v0.x, v0.y); w.y = cvt_pk_bf16(v0.z, v0.w); w.z = cvt_pk_bf16(v1.x, v1.y); w.w = cvt_pk_bf16(v1.z, v1.w);
                    *(u32x4*)(O + (size_t)row * ldc + col0 + bj * 128) = w; }
            }
    }
};

template <class Epi> __device__ __forceinline__ void run_gemm(unsigned char* lds, const bf16_t* A, const bf16_t* Bt, int N, int K, const Epi& E) {
    pg8::Gemm g{A, Bt, M, N, K}; pg8::StaticOrder S; S.init(M, N, (int)gridDim.x, (int)blockIdx.x);
    pg8::gemm_phase<Epi, pg8::StaticOrder, false>((PG8_LAS unsigned char*)lds, g, S, E, nullptr);
}

__device__ __forceinline__ void tr_item(const float* W, int ldw, const float* gain, bf16_t* WT, int Kd, int k0, int n0, int drow0, float* scr, int lane) {
#pragma unroll 8
    for (int i = 0; i < 32; ++i) { const int kk = 2 * i + (lane >> 5); float v = W[(size_t)(k0 + kk) * ldw + n0 + (lane & 31)]; if (gain) v *= gain[k0 + kk]; scr[kk * 33 + (lane & 31)] = v; }
    asm volatile("s_waitcnt lgkmcnt(0)" ::: "memory");
    const int c = lane & 7;
#pragma unroll
    for (int j = 0; j < 4; ++j) { const int n = (lane >> 3) + 8 * j; const float* s = scr + (8 * c) * 33 + n;
        u32x4 o; o.x = cvt_pk_bf16(s[0 * 33], s[1 * 33]); o.y = cvt_pk_bf16(s[2 * 33], s[3 * 33]); o.z = cvt_pk_bf16(s[4 * 33], s[5 * 33]); o.w = cvt_pk_bf16(s[6 * 33], s[7 * 33]);
        *(u32x4*)(WT + (size_t)(drow0 + n) * Kd + k0 + 8 * c) = o; }
    asm volatile("s_waitcnt lgkmcnt(0)" ::: "memory");
}

__device__ __forceinline__ void cexp_i(double th, double& c, double& s) {
    const double TWO_PI_HI = 6.283185307179586232, TWO_PI_LO = 2.4492935982947064e-16;
    const double k = rint(th * 0.15915494309189534561);
    double r = fma(-k, TWO_PI_HI, th); r = fma(-k, TWO_PI_LO, r);
    const double h = r * 0.125;
    double cr = 1.0, ci = 0.0, tr = 1.0, ti = 0.0;
    for (int n = 1; n <= 16; ++n) { const double nr = -ti * h / n, ni = tr * h / n; tr = nr; ti = ni; cr += tr; ci += ti; }
    for (int q = 0; q < 3; ++q) { const double nr = cr * cr - ci * ci, ni = 2.0 * cr * ci; cr = nr; ci = ni; }
    c = cr; s = ci;
}

__device__ __forceinline__ void p0_phase(unsigned char* lds, int wave, int lane) {
    unsigned char* ws = kws(); float* out = kout();
    const int G = gridDim.x, gw = blockIdx.x * 8 + wave, NGW = G * 8;
    const size_t gt = (size_t)blockIdx.x * 512 + threadIdx.x, NGT = (size_t)G * 512;
    float* scr = (float*)(lds + wave * 16384);
    constexpr int I_FU = 16 * 88, I_FD = 44 * 32, I_IN = 16 * 40, I_GLU = 8 * 16, I_O = 8 * 32, I_PG = 16 * 32, I_PPJ = 4 * 32;
    constexpr int I_LAYER = 6 * I_FU + I_IN + I_GLU + 2 * I_O + I_PG + I_PPJ;
    static_assert(I_FU == I_FD, "items");
    for (int it = gw; it < NL * I_LAYER; it += NGW) {
        const int l = it / I_LAYER; int r = it % I_LAYER;
        bf16_t* WL = (bf16_t*)(ws + WS_W) + (size_t)l * E_WLAYER;
#define TRM(SRC, LDW, GAIN, DST, KD, KROWS, NCOLS, ROWEXPR) { constexpr int nit = ((KROWS) / 64) * ((NCOLS) / 32); if (r < nit) { constexpr int nblk = (NCOLS) / 32; const int kb = r / nblk, nb = r % nblk, k0 = kb * 64, n0 = nb * 32; \
            tr_item(SRC, LDW, GAIN, DST, KD, k0, n0, ROWEXPR, scr, lane); continue; } r -= nit; }
        TRM(kin(9) + (size_t)l * D * FF, FF, kin(8) + l * D, WL + OW_GU1, D, D, FF, ((n0 >> 7) * 256 + (n0 & 127)))
        TRM(kin(10) + (size_t)l * D * FF, FF, kin(8) + l * D, WL + OW_GU1, D, D, FF, ((n0 >> 7) * 256 + 128 + (n0 & 127)))
        TRM(kin(11) + (size_t)l * FF * D, D, (const float*)nullptr, WL + OW_D1, FF, FF, D, n0)
        TRM(kin(13) + (size_t)l * D * INW, INW, kin(12) + l * D, WL + OW_IN, D, D, INW, n0)
        TRM(kin(22) + (size_t)l * 512 * 512, 512, (const float*)nullptr, WL + OW_GLU, 512, 512, 512, n0)
        TRM(kin(26) + (size_t)l * D * D, D, kin(23) + l * 512, WL + OW_OA, 512, 512, D, n0)
        TRM(kin(26) + (size_t)l * D * D + (size_t)512 * D, D, kin(25) + l * 512, WL + OW_OB, 512, 512, D, n0)
        TRM(kin(28) + (size_t)l * D * FF, FF, kin(27) + l * D, WL + OW_GU2, D, D, FF, ((n0 >> 7) * 256 + (n0 & 127)))
        TRM(kin(29) + (size_t)l * D * FF, FF, kin(27) + l * D, WL + OW_GU2, D, D, FF, ((n0 >> 7) * 256 + 128 + (n0 & 127)))
        TRM(kin(30) + (size_t)l * FF * D, D, (const float*)nullptr, WL + OW_D2, FF, FF, D, n0)
        TRM(kin(32) + (size_t)l * D * D, D, kin(31) + l * D, WL + OW_PG, D, D, D, n0)
        TRM(kin(33) + (size_t)l * 256 * D, D, (const float*)nullptr, WL + OW_PP, 256, 256, D, n0)
#undef TRM
    }
    {
        bf16_t* XB0 = (bf16_t*)(ws + WS_XB0); float* ssq0 = (float*)(ws + WS_SSQ);
        for (int m = gw; m < M; m += NGW) {
            const float* src = (m < MP) ? kin(0) + (size_t)m * D : kin(1) + (size_t)(m - MP) * D;
            float s = 0.f;
#pragma unroll
            for (int j = 0; j < 4; ++j) { const f32x4 v = ((const f32x4*)src)[lane + 64 * j]; ((f32x4*)(out + (size_t)m * D))[lane + 64 * j] = v;
                u32x2 w; w.x = cvt_pk_bf16(v.x, v.y); w.y = cvt_pk_bf16(v.z, v.w); ((u32x2*)(XB0 + (size_t)m * D))[lane + 64 * j] = w; s += (v.x * v.x + v.y * v.y) + (v.z * v.z + v.w * v.w); }
            s = wave_sum(s);
            if (lane < 16) ssq0[(size_t)m * 16 + lane] = (lane == 0) ? s : 0.f;
        }
    }
    {
        bf16_t* PB = (bf16_t*)(ws + WS_PB);
        for (size_t i = gt; i < (size_t)NL * M * 64; i += NGT) { const int l = (int)(i / ((size_t)M * 64)); const size_t rem = i % ((size_t)M * 64); const int row = (int)(rem >> 6), c4 = (int)(rem & 63);
            const float* src = (row < MP) ? kin(6) + ((size_t)l * MP + row) * 256 + c4 * 4 : kin(7) + ((size_t)l * MSM + (row - MP)) * 256 + c4 * 4;
            const f32x4 v = *(const f32x4*)src; u32x2 w; w.x = cvt_pk_bf16(v.x, v.y); w.y = cvt_pk_bf16(v.z, v.w); ((u32x2*)PB)[i] = w; }
    }
    {
        bf16_t* KS = (bf16_t*)(ws + WS_KS); bf16_t* VTS = (bf16_t*)(ws + WS_VTS);
        for (size_t i = gt; i < (size_t)NL * DB * 160 * 32; i += NGT) { const int c4 = (int)(i & 31); const size_t t1 = i >> 5; const int key = (int)(t1 % 160); const size_t lb = t1 / 160;
            u32x2 w; w.x = 0u; w.y = 0u;
            if (key < 128) { const f32x4 v = *(const f32x4*)(kin(2) + (lb * 128 + key) * 128 + c4 * 4); w.x = cvt_pk_bf16(v.x, v.y); w.y = cvt_pk_bf16(v.z, v.w); }
            ((u32x2*)KS)[i] = w; }
        for (size_t i = gt; i < (size_t)NL * DB * 128 * 160; i += NGT) { const int t = (int)(i % 160); const size_t t1 = i / 160; const int c = (int)(t1 & 127); const size_t lb = t1 >> 7;
            float v = 0.f; if (t < 128) v = kin(3)[(lb * 128 + t) * 128 + c];
            VTS[i] = f2bf(v); }
        for (size_t i = gt; i < (size_t)NL * DB * 120 * 32; i += NGT) { const int c4 = (int)(i & 31); const size_t t1 = i >> 5; const int j = (int)(t1 % 120); const size_t lb = t1 / 120;
            const size_t so = (lb * 128 + j + 8) * 128 + c4 * 4, dofs = (lb * 128 + j) * 128 + c4 * 4;
            *(f32x4*)(out + O_KS + dofs) = *(const f32x4*)(kin(2) + so); *(f32x4*)(out + O_VS + dofs) = *(const f32x4*)(kin(3) + so); }
    }
    for (size_t i = gt; i < (size_t)NL * 32 * 64; i += NGT) {
        const int n = (int)(i & 63), lg = (int)(i >> 6), l = lg >> 5, g = lg & 31;
        unsigned char* tab = ws + WS_TAB + (size_t)l * TAB_LAYER;
        const double lr = (double)kin(14)[i], li = (double)kin(15)[i], dt = exp((double)kin(16)[lg]);
        const double zr = lr * dt, zi = li * dt; double c1, s1; cexp_i(zi, c1, s1); const double ea = exp(zr); const double ar = ea * c1, ai = ea * s1;
        double c2, s2; cexp_i(256.0 * zi, c2, s2); const double e2 = exp(256.0 * zr);
        ((float*)(tab + TAB_AR))[g * 64 + n] = (float)ar; ((float*)(tab + TAB_AI))[g * 64 + n] = (float)ai;
        ((float*)(tab + TAB_A2R))[g * 64 + n] = (float)(e2 * c2); ((float*)(tab + TAB_A2I))[g * 64 + n] = (float)(e2 * s2);
        const double nr = ar - 1.0, ni = ai, den = lr * lr + li * li; const double cr = (nr * lr + ni * li) / den, ci = (ni * lr - nr * li) / den;
        bf16_t* bb = (bf16_t*)(tab + TAB_BB) + (size_t)g * 128 * 16; bf16_t* cm = (bf16_t*)(tab + TAB_CM) + (size_t)g * 16 * 128;
        for (int p = 0; p < 16; ++p) {
            const double br = (double)kin(17)[i * 16 + p], bi = (double)kin(18)[i * 16 + p];
            bb[n * 16 + p] = f2bf((float)(cr * br - ci * bi)); bb[(64 + n) * 16 + p] = f2bf((float)(cr * bi + ci * br));
            cm[p * 128 + n] = f2bf(kin(19)[((size_t)lg * 16 + p) * 64 + n]); cm[p * 128 + 64 + n] = f2bf(-kin(20)[((size_t)lg * 16 + p) * 64 + n]);
        }
    }
}

#define MFMA32(a, b, c) __builtin_amdgcn_mfma_f32_32x32x16_bf16((a), (b), (c), 0, 0, 0)
#define MFMA16(a, b, c) __builtin_amdgcn_mfma_f32_16x16x32_bf16((a), (b), (c), 0, 0, 0)

template <bool PASS2, int SEG>
__device__ __forceinline__ void ssm_sub(unsigned char* wl, const bf16_t* urow0, const bf16x8 (&bfr)[4], const bf16x8 (&cfr)[4], float ar, float ai, float& hr, float& hi, int lane,
                                        const float* h0re, const float* h0im, float* ofre, float* ofim, int segstride, bf16_t* ygrow0, f32x4 dv) {
    float* BU = (float*)wl; unsigned short* HB = (unsigned short*)wl;
    const int r = lane & 31, hf = lane >> 5;
    asm volatile("" ::: "memory");
    {
        const bf16x8 ua = *(const bf16x8*)(urow0 + (size_t)r * 512 + hf * 8);
#pragma unroll
        for (int cb = 0; cb < 4; ++cb) {
            f32x16 acc;
#pragma unroll
            for (int i = 0; i < 16; ++i) acc[i] = 0.f;
            acc = MFMA32(ua, bfr[cb], acc);
#pragma unroll
            for (int i = 0; i < 16; ++i) BU[((i & 3) + 8 * (i >> 2) + 4 * hf) * 128 + cb * 32 + r] = acc[i];
        }
    }
    asm volatile("" ::: "memory");
#pragma unroll 8
    for (int t = 0; t < 32; ++t) {
        if (SEG < 32 && (t % SEG) == 0) { hr = h0re[(size_t)(t / SEG) * segstride + lane]; hi = h0im[(size_t)(t / SEG) * segstride + lane]; }
        const float br = BU[t * 128 + lane], bi = BU[t * 128 + 64 + lane];
        const float nr = fmaf(ar, hr, fmaf(-ai, hi, br)), ni = fmaf(ar, hi, fmaf(ai, hr, bi));
        hr = nr; hi = ni;
        if (PASS2) { HB[t * 136 + lane] = f2bf(hr); HB[t * 136 + 64 + lane] = f2bf(hi); }
        if (SEG < 32 && (t % SEG) == SEG - 1) { ofre[(size_t)(t / SEG) * segstride + lane] = hr; ofim[(size_t)(t / SEG) * segstride + lane] = hi; }
    }
    asm volatile("" ::: "memory");
    if (PASS2) {
        const int tk = lane & 15, q4 = lane >> 4;
#pragma unroll
        for (int tb = 0; tb < 2; ++tb) {
            f32x4 acc = {0.f, 0.f, 0.f, 0.f};
#pragma unroll
            for (int ks = 0; ks < 4; ++ks) { const bf16x8 hfrag = *(const bf16x8*)(wl + (tb * 16 + tk) * 272 + (ks * 32 + q4 * 8) * 2); acc = MFMA16(cfr[ks], hfrag, acc); }
            const size_t ro = (size_t)(tb * 16 + tk) * 512 + 4 * q4;
            const u32x2 uu = *(const u32x2*)(urow0 + ro);
            const float y0 = gelu_tanh(acc.x + dv.x * bflo(uu.x)), y1 = gelu_tanh(acc.y + dv.y * bfhi(uu.x)), y2 = gelu_tanh(acc.z + dv.z * bflo(uu.y)), y3 = gelu_tanh(acc.w + dv.w * bfhi(uu.y));
            u32x2 w; w.x = cvt_pk_bf16(y0, y1); w.y = cvt_pk_bf16(y2, y3); *(u32x2*)(ygrow0 + ro) = w;
        }
    }
    asm volatile("" ::: "memory");
}

__device__ __forceinline__ void ssm_phase(unsigned char* lds, int l, int wave, int lane) {
    unsigned char* ws = kws(); float* out = kout();
    const unsigned char* tab = ws + WS_TAB + (size_t)l * TAB_LAYER;
    const bf16_t* UB = (const bf16_t*)(ws + WS_HB); bf16_t* YG = (bf16_t*)(ws + WS_HB + 2 * SZ_512);
    unsigned char* wl = lds + wave * 16384; float* xch = (float*)(lds + 131072);
    const int r = lane & 31, hf = lane >> 5, tk = lane & 15, q4 = lane >> 4;
    for (int unit = blockIdx.x; unit < NB * 32; unit += gridDim.x) {
        const int b = unit >> 5, g = unit & 31;
        bf16x8 bfr[4], cfr[4];
#pragma unroll
        for (int cb = 0; cb < 4; ++cb) bfr[cb] = *(const bf16x8*)((const bf16_t*)(tab + TAB_BB) + ((size_t)g * 128 + cb * 32 + r) * 16 + hf * 8);
#pragma unroll
        for (int ks = 0; ks < 4; ++ks) cfr[ks] = *(const bf16x8*)((const bf16_t*)(tab + TAB_CM) + ((size_t)g * 16 + tk) * 128 + ks * 32 + q4 * 8);
        const float ar = ((const float*)(tab + TAB_AR))[g * 64 + lane], ai = ((const float*)(tab + TAB_AI))[g * 64 + lane];
        const float a2r = ((const float*)(tab + TAB_A2R))[g * 64 + lane], a2i = ((const float*)(tab + TAB_A2I))[g * 64 + lane];
        const f32x4 dv = *(const f32x4*)(kin(21) + l * 512 + g * 16 + 4 * q4);
        const size_t row0 = (size_t)b * SEQ + wave * 256;
        float hr = 0.f, hi = 0.f;
        for (int sc = 0; sc < 8; ++sc)
            ssm_sub<false, 32>(wl, UB + (row0 + sc * 32) * 512 + g * 16, bfr, cfr, ar, ai, hr, hi, lane, nullptr, nullptr, nullptr, nullptr, 0, nullptr, dv);
        xch[wave * 128 + lane] = hr; xch[wave * 128 + 64 + lane] = hi;
        __syncthreads();
        float cr = 0.f, ci = 0.f;
        for (int j = 0; j < wave; ++j) { const float sr = xch[j * 128 + lane], si = xch[j * 128 + 64 + lane];
            const float nr = fmaf(a2r, cr, fmaf(-a2i, ci, sr)), ni = fmaf(a2r, ci, fmaf(a2i, cr, si)); cr = nr; ci = ni; }
        hr = cr; hi = ci;
        for (int sc = 0; sc < 8; ++sc)
            ssm_sub<true, 32>(wl, UB + (row0 + sc * 32) * 512 + g * 16, bfr, cfr, ar, ai, hr, hi, lane, nullptr, nullptr, nullptr, nullptr, 0, YG + (row0 + sc * 32) * 512 + g * 16, dv);
        if (wave == 7) { out[O_HPR + ((size_t)(l * NB + b) * 32 + g) * 64 + lane] = hr; out[O_HPI + ((size_t)(l * NB + b) * 32 + g) * 64 + lane] = hi; }
        __syncthreads();
    }
    for (int wu = blockIdx.x * 8 + wave; wu < 32 * 32; wu += gridDim.x * 8) {
        const int g = wu & 31, bq = wu >> 5;
        bf16x8 bfr[4], cfr[4];
#pragma unroll
        for (int cb = 0; cb < 4; ++cb) bfr[cb] = *(const bf16x8*)((const bf16_t*)(tab + TAB_BB) + ((size_t)g * 128 + cb * 32 + r) * 16 + hf * 8);
#pragma unroll
        for (int ks = 0; ks < 4; ++ks) cfr[ks] = *(const bf16x8*)((const bf16_t*)(tab + TAB_CM) + ((size_t)g * 16 + tk) * 128 + ks * 32 + q4 * 8);
        const float ar = ((const float*)(tab + TAB_AR))[g * 64 + lane], ai = ((const float*)(tab + TAB_AI))[g * 64 + lane];
        const f32x4 dv = *(const f32x4*)(kin(21) + l * 512 + g * 16 + 4 * q4);
        const size_t row0 = (size_t)MP + bq * 32; const size_t so = ((size_t)(l * DB + bq * 4) * 32 + g) * 64;
        float hr = 0.f, hi = 0.f;
        ssm_sub<true, 8>(wl, UB + row0 * 512 + g * 16, bfr, cfr, ar, ai, hr, hi, lane, kin(4) + so, kin(5) + so, out + O_HSR + so, out + O_HSI + so, 32 * 64, YG + row0 * 512 + g * 16, dv);
    }
}

__device__ __forceinline__ void attn_wave(const bf16_t* QB, const bf16_t* Kseq, const bf16_t* Vseq, int tstride, int qrow_base, int nq, int q0, float sink, bf16_t* YA, float* ssqT, int h, int lane) {
    const int r = lane & 31, hf = lane >> 5;
    const int qrow = qrow_base + (r < nq ? r : nq - 1);
    bf16x8 qf[4];
#pragma unroll
    for (int ks = 0; ks < 4; ++ks) qf[ks] = *(const bf16x8*)(QB + (size_t)qrow * 512 + h * 64 + ks * 16 + hf * 8);
    f32x16 s[5];
    const int kb0 = q0 - 128;
#pragma unroll
    for (int jb = 0; jb < 5; ++jb) {
#pragma unroll
        for (int i = 0; i < 16; ++i) s[jb][i] = 0.f;
        const int kp0 = kb0 + 32 * jb;
        if (kp0 >= 0) {
            const bf16_t* kptr = Kseq + (size_t)(kp0 + r) * 128 + hf * 8;
#pragma unroll
            for (int ks = 0; ks < 4; ++ks) { const bf16x8 kf = *(const bf16x8*)(kptr + ks * 16); s[jb] = MFMA32(kf, qf[ks], s[jb]); }
        }
    }
    const int qp = q0 + r;
    float mx = sink;
#pragma unroll
    for (int jb = 0; jb < 5; ++jb)
#pragma unroll
        for (int i = 0; i < 16; ++i) { const int kp = kb0 + 32 * jb + (i & 3) + 8 * (i >> 2) + 4 * hf; const bool ok = (kp >= 0) && (kp <= qp) && (qp - kp < 128);
            s[jb][i] = ok ? s[jb][i] : -1e30f; mx = fmaxf(mx, s[jb][i]); }
    mx = fmaxf(mx, __shfl_xor(mx, 32));
    float sum = 0.f;
#pragma unroll
    for (int jb = 0; jb < 5; ++jb)
#pragma unroll
        for (int i = 0; i < 16; ++i) { const float p = (s[jb][i] > -1e29f) ? __builtin_amdgcn_exp2f((s[jb][i] - mx) * 1.44269504f) : 0.f; s[jb][i] = p; sum += p; }
    sum += __shfl_xor(sum, 32);
    sum += __builtin_amdgcn_exp2f((sink - mx) * 1.44269504f);
    const float inv = 1.0f / sum;
    f32x16 o[2];
#pragma unroll
    for (int i = 0; i < 16; ++i) { o[0][i] = 0.f; o[1][i] = 0.f; }
#pragma unroll
    for (int jb = 0; jb < 5; ++jb) {
        const int kp0 = kb0 + 32 * jb;
        if (kp0 >= 0) {
#pragma unroll
            for (int st = 0; st < 2; ++st) {
                union { bf16x8 v; unsigned u[4]; } pf;
#pragma unroll
                for (int j = 0; j < 4; ++j) pf.u[j] = cvt_pk_bf16(s[jb][8 * st + 2 * j], s[jb][8 * st + 2 * j + 1]);
#pragma unroll
                for (int db = 0; db < 2; ++db) {
                    const bf16_t* vptr = Vseq + (size_t)(db * 32 + r) * tstride + kp0 + 16 * st + 4 * hf;
                    union { bf16x8 v; u32x2 u[2]; } vf; vf.u[0] = *(const u32x2*)vptr; vf.u[1] = *(const u32x2*)(vptr + 8);
                    o[db] = MFMA32(vf.v, pf.v, o[db]);
                }
            }
        }
    }
    float sq = 0.f;
#pragma unroll
    for (int db = 0; db < 2; ++db)
#pragma unroll
        for (int ig = 0; ig < 4; ++ig) {
            const float v0 = o[db][4 * ig] * inv, v1 = o[db][4 * ig + 1] * inv, v2 = o[db][4 * ig + 2] * inv, v3 = o[db][4 * ig + 3] * inv;
            sq += (v0 * v0 + v1 * v1) + (v2 * v2 + v3 * v3);
            if (r < nq) { u32x2 w; w.x = cvt_pk_bf16(v0, v1); w.y = cvt_pk_bf16(v2, v3); *(u32x2*)(YA + (size_t)qrow * 512 + h * 64 + db * 32 + 8 * ig + 4 * hf) = w; }
        }
    sq += __shfl_xor(sq, 32);
    if (hf == 0 && r < nq) ssqT[(size_t)qrow * 8 + h] = sq;
}

__device__ __forceinline__ void attn_phase(int l, int wave, int lane) {
    unsigned char* ws = kws();
    const bf16_t* QB = (const bf16_t*)(ws + WS_HB + SZ_512); bf16_t* YA = (bf16_t*)(ws + WS_HB + 4 * SZ_512);
    const bf16_t* KP = (const bf16_t*)(ws + WS_KP); const bf16_t* VTP = (const bf16_t*)(ws + WS_VTP);
    const bf16_t* KS = (const bf16_t*)(ws + WS_KS); const bf16_t* VTS = (const bf16_t*)(ws + WS_VTS);
    float* ssqT = (float*)(ws + WS_SSQ + 4 * SZ_SSQ16 + SZ_SSQ8);
    const int h = wave, kvh = h >> 2; const float sink = kin(24)[l * 8 + h];
    for (int bu = blockIdx.x; bu < 512 + DB; bu += gridDim.x) {
        if (bu < 512) { const int b = bu >> 6, q0 = (bu & 63) * 32;
            attn_wave(QB, KP + (size_t)b * SEQ * 128 + kvh * 64, VTP + (size_t)(b * 2 + kvh) * 64 * 2048, 2048, b * SEQ + q0, 32, q0, sink, YA, ssqT, h, lane);
        } else { const int sb = bu - 512;
            attn_wave(QB, KS + (size_t)(l * DB + sb) * 160 * 128 + kvh * 64, VTS + (size_t)((l * DB + sb) * 2 + kvh) * 64 * 160, 160, MP + sb * 8, 8, 128, sink, YA, ssqT, h, lane);
        }
    }
}

#define PH_BEGIN unsigned char* ws = kws(); float* out = kout(); (void)out; \
    bf16_t* XBa = (bf16_t*)(ws + WS_XB0); bf16_t* XBb = (bf16_t*)(ws + WS_XB1); bf16_t* HB = (bf16_t*)(ws + WS_HB); (void)XBa; (void)XBb; (void)HB; \
    const bf16_t* WL = (const bf16_t*)(ws + WS_W) + (size_t)l * E_WLAYER; (void)WL; \
    float* ssq0 = (float*)(ws + WS_SSQ); float* ssq1 = (float*)(ws + WS_SSQ + SZ_SSQ16); float* ssq2 = (float*)(ws + WS_SSQ + 2 * SZ_SSQ16); float* ssq3 = (float*)(ws + WS_SSQ + 3 * SZ_SSQ16); \
    float* ssqS = (float*)(ws + WS_SSQ + 4 * SZ_SSQ16); float* ssqT = (float*)(ws + WS_SSQ + 4 * SZ_SSQ16 + SZ_SSQ8); (void)ssq0; (void)ssq1; (void)ssq2; (void)ssq3; (void)ssqS; (void)ssqT;

__global__ void __launch_bounds__(512, 2) mega_fwd(Args a_unused) {
    extern __shared__ __attribute__((aligned(16))) unsigned char lds[];
    cg::grid_group grid = cg::this_grid();
    {
        int tid = threadIdx.x; asm volatile("" : "+v"(tid)); const int lane = tid & 63, wave = __builtin_amdgcn_readfirstlane(tid >> 6);
        p0_phase(lds, wave, lane);
    }
    grid.sync();
#pragma nounroll
    for (int l = 0; l < NL; ++l) {
        { PH_BEGIN EpiSwiglu E{HB, ssq0}; run_gemm(lds, XBa, WL + OW_GU1, 2 * FF, D, E); }
        grid.sync();
        { PH_BEGIN EpiRes<0, true> E{out, XBb, ssq1, nullptr, nullptr}; run_gemm(lds, HB, WL + OW_D1, D, FF, E); }
        grid.sync();
        { PH_BEGIN EpiIn E{HB, (bf16_t*)(ws + WS_HB + SZ_512), (bf16_t*)(ws + WS_KP), (bf16_t*)(ws + WS_VTP), (bf16_t*)(ws + WS_KS), (bf16_t*)(ws + WS_VTS), ssq1, out + O_KP, out + O_VP, out + O_KS, out + O_VS, l};
          run_gemm(lds, XBb, WL + OW_IN, INW, D, E); }
        grid.sync();
        {
            int tid = threadIdx.x; asm volatile("" : "+v"(tid)); const int lane = tid & 63, wave = __builtin_amdgcn_readfirstlane(tid >> 6);
            ssm_phase(lds, l, wave, lane);
        }
        {
            int tid = threadIdx.x; asm volatile("" : "+v"(tid)); const int lane = tid & 63, wave = __builtin_amdgcn_readfirstlane(tid >> 6);
            attn_phase(l, wave, lane);
        }
        grid.sync();
        { PH_BEGIN const bf16_t* YG = (const bf16_t*)(ws + WS_HB + 2 * SZ_512); EpiGlu E{YG, (bf16_t*)(ws + WS_HB + 3 * SZ_512), ssqS}; run_gemm(lds, YG, WL + OW_GLU, 512, 512, E); }
        grid.sync();
        { PH_BEGIN EpiRes<1, false> E{out, nullptr, nullptr, ssqS, nullptr}; run_gemm(lds, (const bf16_t*)(ws + WS_HB + 3 * SZ_512), WL + OW_OA, D, 512, E); }
        { PH_BEGIN EpiRes<1, true> E{out, XBa, ssq2, ssqT, nullptr}; run_gemm(lds, (const bf16_t*)(ws + WS_HB + 4 * SZ_512), WL + OW_OB, D, 512, E); }
        grid.sync();
        { PH_BEGIN EpiSwiglu E{HB, ssq2}; run_gemm(lds, XBa, WL + OW_GU2, 2 * FF, D, E); }
        grid.sync();
        { PH_BEGIN EpiRes<0, true> E{out, XBb, ssq3, nullptr, nullptr}; run_gemm(lds, HB, WL + OW_D2, D, FF, E); }
        grid.sync();
        { PH_BEGIN EpiBf E{HB, D}; run_gemm(lds, (const bf16_t*)(ws + WS_PB) + (size_t)l * M * 256, WL + OW_PP, D, 256, E); }
        __threadfence(); __syncthreads();
        { PH_BEGIN EpiRes<2, true> E{out, XBa, ssq0, ssq3, HB}; run_gemm(lds, XBb, WL + OW_PG, D, D, E); }
        grid.sync();
    }
    {
        int tid = threadIdx.x; asm volatile("" : "+v"(tid)); const int lane = tid & 63, wave = __builtin_amdgcn_readfirstlane(tid >> 6);
        unsigned char* ws = kws(); float* out = kout(); const float* ssq0 = (const float*)(ws + WS_SSQ);
        const float* gfin = kin(34);
        for (int m = blockIdx.x * 8 + wave; m < M; m += gridDim.x * 8) {
            float t = (lane < 16) ? ssq0[(size_t)m * 16 + lane] : 0.f; t = wave_sum(t);
            const float rs = __builtin_amdgcn_rsqf(t * (1.f / 1024.f) + 1e-6f);
#pragma unroll
            for (int j = 0; j < 4; ++j) { f32x4 v = ((f32x4*)(out + (size_t)m * D))[lane + 64 * j]; const f32x4 g = ((const f32x4*)gfin)[lane + 64 * j]; v = v * rs * g; ((f32x4*)(out + (size_t)m * D))[lane + 64 * j] = v; }
        }
    }
}

extern "C" void kernel_launch(void* const* d_in, const int* in_sizes, int n_in, void* d_out, int out_size, void* d_ws, size_t ws_size, hipStream_t stream) {
    static int grid_blocks = 0;
    if (!grid_blocks) {
        int dev = 0, cus = 0, per_cu = 0;
        hipGetDevice(&dev);
        hipDeviceGetAttribute(&cus, hipDeviceAttributeMultiprocessorCount, dev);
        hipFuncSetAttribute((const void*)mega_fwd, hipFuncAttributeMaxDynamicSharedMemorySize, LDS_BYTES);
        hipOccupancyMaxActiveBlocksPerMultiprocessor(&per_cu, (const void*)mega_fwd, 512, LDS_BYTES);
        if (per_cu < 1) per_cu = 1;
        if (cus < 1) cus = 256;
        grid_blocks = cus * per_cu;
        if (ws_size < WS_END) fprintf(stderr, "kernel_launch: workspace too small: %zu < %zu\n", ws_size, (size_t)WS_END);
    }
    Args a{};
    for (int i = 0; i < NIN; ++i) a.in[i] = (const float*)d_in[i];
    a.out = (float*)d_out; a.ws = (unsigned char*)d_ws;
    void* args[] = {&a};
    hipError_t e = hipLaunchCooperativeKernel((const void*)mega_fwd, dim3(grid_blocks), dim3(512), args, LDS_BYTES, stream);
    if (e != hipSuccess) fprintf(stderr, "cooperative launch failed: %s (grid %d)\n", hipGetErrorString(e), grid_blocks);
}
```

```cpp
#include <hip/hip_runtime.h>
#include <hip/hip_cooperative_groups.h>
#include <cstdio>
#include <cstdint>
namespace pg8 {
#define PG8_LAS __attribute__((address_space(3)))
typedef unsigned short bf16_t;
typedef short bf16x8 __attribute__((ext_vector_type(8)));
typedef float f32x4 __attribute__((ext_vector_type(4)));
typedef unsigned u32x4 __attribute__((ext_vector_type(4)));
constexpr int BM = 256, BK = 64, HALF = 128, HTB = HALF * BK * 2  , STAGE_BYTES = 8 * HTB, NXCD = 8, WGM = 8;

__host__ __device__ __forceinline__ int lds_byte(int r, int c) { const int st = (r >> 4) * 2 + (c >> 5), rr = r & 15, cc = c & 31, ob = rr * 64 + cc * 2; return st * 1024 + (ob ^ (((ob >> 9) & 1) << 5)); }
__host__ __device__ __forceinline__ void stage_rc(int b, int& R, int& C) { const int st = b / 1024, sb = b % 1024, swz = sb ^ (((sb >> 9) & 1) << 5); R = (st >> 1) * 16 + swz / 64; C = (st & 1) * 32 + (swz % 64) / 2; }
__host__ __device__ __forceinline__ int perm32(int rho) { const int n = rho >> 4, i = rho & 15; return 8 * (i >> 2) + 4 * n + (i & 3); }

struct Unit { int pm, pn, seg; };
struct Gemm { const bf16_t* A; const bf16_t* Bt; int M, N, K; const bf16_t* A2; const bf16_t* Bt2; };

struct StaticOrder {
    int nM, nN, nwg, G, c;
    __host__ __device__ void init(int M, int N, int G_, int c_) { nM = M / BM; nN = N / BM; nwg = nM * nN; G = G_; c = c_; }
    __host__ __device__ bool next(int i, Unit& u) const {
        const long L = (long)i * G + c; if (L >= nwg) return false;
        int wgid = (int)L; { const int q = nwg / NXCD, r = nwg % NXCD, xcd = wgid % NXCD, off = wgid / NXCD; wgid = (xcd < r ? xcd * (q + 1) : r * (q + 1) + (xcd - r) * q) + off; }
        const int nig = WGM * nN, gid = wgid / nig, fm = gid * WGM, gsz = (nM - fm) < WGM ? (nM - fm) : WGM;
        u.pm = fm + ((wgid % nig) % gsz); u.pn = (wgid % nig) / gsz; u.seg = 0; return true;
    }
    __device__ __forceinline__ void a_ready(const Unit&) const {}
    __device__ __forceinline__ void done(const Unit&) const {}
};
__device__ __forceinline__ unsigned cvt_pk_bf16(float lo, float hi) { unsigned r; asm volatile("v_cvt_pk_bf16_f32 %0, %1, %2" : "=v"(r) : "v"(lo), "v"(hi)); return r; }
typedef float f32x2 __attribute__((ext_vector_type(2)));
__device__ __forceinline__ int tid_from_lds(const volatile PG8_LAS unsigned* tidtab) {
    const unsigned slot = (unsigned)__builtin_amdgcn_s_getreg((5 << 11) | 4) & 63u;
    const int w = __builtin_amdgcn_readfirstlane((int)tidtab[slot]);
    int ln; asm volatile("v_mbcnt_lo_u32_b32 %0, -1, 0\n\tv_mbcnt_hi_u32_b32 %0, -1, %0" : "=v"(ln));
    return w * 64 + ln;
}
constexpr int TIDTAB_OFF = 131072 + 4096 + 16;
struct TwoSegOrder : StaticOrder {
    __host__ __device__ bool next(int i, Unit& u) const { if (!StaticOrder::next(i >> 1, u)) return false; u.seg = i & 1; return true; }
};
template <class Epi, class Sched, bool STAMP = false>
__device__ __forceinline__ void gemm_phase(PG8_LAS unsigned char* lds, const Gemm g, const Sched& S, const Epi& E, unsigned long long* stamps) {
    int tid_l = tid_from_lds((const volatile PG8_LAS unsigned*)(lds + TIDTAB_OFF)); asm volatile("" : "+v"(tid_l)); const int tid = tid_l, wid = __builtin_amdgcn_readfirstlane(tid >> 6), lane = tid & 63, wr = wid >> 2, wc = wid & 3, fr = lane & 15, fq = lane >> 4;
    const int K = g.K, nt = K / BK;
    int ts_lo = 0, ts_hi = 0, nts = 0; const unsigned long long rt_entry = STAMP ? (unsigned long long)wall_clock64() : 0ull;
#define PG8_STAMP() do { if (STAMP && wid == 0 && nts < 64) { const unsigned long long _c = (unsigned long long)clock64(); \
        ts_lo = (lane == nts) ? (int)(unsigned)_c : ts_lo; ts_hi = (lane == nts) ? (int)(unsigned)(_c >> 32) : ts_hi; ++nts; } } while (0)
    PG8_STAMP();
    unsigned voffA[2], voffB[2];
#pragma unroll
    for (int i = 0; i < 2; ++i) { int R, C; stage_rc(tid * 16 + i * 8192, R, C); const int Rb = Epi::PERM ? ((R & ~31) + perm32(R & 31)) : R;
        voffA[i] = (unsigned)(R * K + C) * 2u; voffB[i] = (unsigned)(Rb * K + C) * 2u; }
    const size_t kstep = (size_t)(BK * 2);
    const size_t hstep = (size_t)HALF * K * 2;
    const size_t tstep = 2 * hstep;
    const unsigned ldsw = (unsigned)wid * 1024u;
    const int aoff = lds_byte(wr * 64 + fr, fq * 8), boff = lds_byte(wc * 32 + fr, fq * 8);
#define PG8_SA(b, h) (((b) * 2 + (h)) * HTB)
#define PG8_SB(b, h) ((4 + (b) * 2 + (h)) * HTB)
#define PG8_STAGE(bufoff, gbase, voff) do { _Pragma("unroll") for (int _i = 0; _i < 2; ++_i) \
        __builtin_amdgcn_global_load_lds((const unsigned*)((const char*)(gbase) + (voff)[_i]), (PG8_LAS unsigned*)(lds + (bufoff) + ldsw + _i * 8192), 16, 0, 0); } while (0)
#define PG8_LDA(dst, b, h) do { _Pragma("unroll") for (int m = 0; m < 4; ++m) _Pragma("unroll") for (int k = 0; k < 2; ++k) dst[m][k] = *(const PG8_LAS bf16x8*)(lds + PG8_SA(b, h) + aoff + m * 2048 + k * 1024); } while (0)
#define PG8_LDB(dst, b, h) do { _Pragma("unroll") for (int n = 0; n < 2; ++n) _Pragma("unroll") for (int k = 0; k < 2; ++k) dst[n][k] = *(const PG8_LAS bf16x8*)(lds + PG8_SB(b, h) + boff + n * 2048 + k * 1024); } while (0)
#define PG8_MMA(ai, bj, At, Bt) do { __builtin_amdgcn_s_setprio(1); _Pragma("unroll") for (int m = 0; m < 4; ++m) _Pragma("unroll") for (int n = 0; n < 2; ++n) _Pragma("unroll") for (int k = 0; k < 2; ++k) \
        acc[ai][bj][m][n] = __builtin_amdgcn_mfma_f32_16x16x32_bf16(Bt[n][k], At[m][k], acc[ai][bj][m][n], 0, 0, 0); __builtin_amdgcn_s_setprio(0); } while (0)
#define PG8_WAIT_V(n) asm volatile("s_waitcnt vmcnt(" #n ")" ::: "memory")
#define PG8_WAIT_L(n) asm volatile("s_waitcnt lgkmcnt(" #n ")" ::: "memory")
#define PG8_BAR __builtin_amdgcn_s_barrier()
#define PG8_SCHED __builtin_amdgcn_sched_barrier(0)
    Unit cur, nxt; int ui = 0;
    if (!S.next(0, cur)) return;
    f32x4 acc[2][2][4][2];
#pragma unroll
    for (int a = 0; a < 2; ++a)
#pragma unroll
        for (int b = 0; b < 2; ++b)
#pragma unroll
            for (int m = 0; m < 4; ++m)
#pragma unroll
                for (int n = 0; n < 2; ++n) acc[a][b][m][n] = (f32x4){0.f, 0.f, 0.f, 0.f};
    bf16x8 At[4][2], B0[2][2], B1[2][2];
    const char* cA = (const char*)(cur.seg ? g.A2 : g.A) + (size_t)cur.pm * tstep; const char* cB = (const char*)(cur.seg ? g.Bt2 : g.Bt) + (size_t)cur.pn * tstep;
    S.a_ready(cur);
    PG8_STAGE(PG8_SB(0, 0), cB, voffB); PG8_STAGE(PG8_SB(0, 1), cB + hstep, voffB); PG8_STAGE(PG8_SA(0, 0), cA, voffA); PG8_STAGE(PG8_SA(0, 1), cA + hstep, voffA);
    if (wr == 1) PG8_BAR;
    PG8_WAIT_V(2); PG8_BAR;
    PG8_STAGE(PG8_SB(1, 0), cB + kstep, voffB); PG8_STAGE(PG8_SA(1, 0), cA + kstep, voffA); PG8_STAGE(PG8_SB(1, 1), cB + hstep + kstep, voffB);
    PG8_WAIT_V(6); PG8_BAR;
    PG8_STAMP();
    for (;;) {
        const bool has_next = S.next(ui + 1, nxt);
        const char* nA = has_next ? (const char*)(nxt.seg ? g.A2 : g.A) + (size_t)nxt.pm * tstep : cA; const char* nB = has_next ? (const char*)(nxt.seg ? g.Bt2 : g.Bt) + (size_t)nxt.pn * tstep : cB;
        for (int t = 0; t < nt; t += 2) {
            const bool last = (t == nt - 2);
            const char* a1 = cA + (size_t)(t + 1) * kstep;
            const char* a2 = last ? nA : cA + (size_t)(t + 2) * kstep; const char* b2 = last ? nB : cB + (size_t)(t + 2) * kstep;
            const char* a3 = a2 + kstep; const char* b3 = b2 + kstep;
            if (last && has_next) S.a_ready(nxt);
            PG8_LDB(B0, 0, 0); PG8_LDB(B1, 0, 1); PG8_SCHED; PG8_LDA(At, 0, 0); PG8_STAGE(PG8_SA(1, 1), a1 + hstep, voffA);
            PG8_WAIT_V(8); PG8_WAIT_L(0); PG8_BAR; PG8_MMA(0, 0, At, B0); PG8_MMA(0, 1, At, B1); PG8_BAR; PG8_SCHED;
            PG8_LDA(At, 0, 1); PG8_STAGE(PG8_SB(0, 0), b2, voffB); PG8_STAGE(PG8_SB(0, 1), b2 + hstep, voffB); PG8_STAGE(PG8_SA(0, 0), a2, voffA);
            PG8_WAIT_V(8); PG8_WAIT_L(0); PG8_BAR; PG8_MMA(1, 0, At, B0); PG8_MMA(1, 1, At, B1); PG8_BAR; PG8_SCHED;
            PG8_LDB(B0, 1, 0); PG8_LDB(B1, 1, 1); PG8_SCHED; PG8_LDA(At, 1, 0); PG8_STAGE(PG8_SA(0, 1), a2 + hstep, voffA);
            PG8_WAIT_V(8); PG8_WAIT_L(0); PG8_BAR; PG8_MMA(0, 0, At, B0); PG8_MMA(0, 1, At, B1); PG8_BAR; PG8_SCHED;
            PG8_LDA(At, 1, 1); PG8_STAGE(PG8_SB(1, 0), b3, voffB); PG8_STAGE(PG8_SB(1, 1), b3 + hstep, voffB); PG8_STAGE(PG8_SA(1, 0), a3, voffA);
            PG8_WAIT_V(8); PG8_WAIT_L(0); PG8_BAR; PG8_MMA(1, 0, At, B0); PG8_MMA(1, 1, At, B1); PG8_BAR; PG8_SCHED;
        }
        PG8_STAMP();
        if (wr == 0) PG8_BAR;
        bool keep = false;
        int t2 = tid_from_lds((const volatile PG8_LAS unsigned*)(lds + TIDTAB_OFF)); asm volatile("" : "+v"(t2));
        const int wid2 = __builtin_amdgcn_readfirstlane(t2 >> 6), ln2 = t2 & 63, wr2 = wid2 >> 2, wc2 = wid2 & 3, fr2 = ln2 & 15, fq2 = ln2 >> 4;
        if constexpr (Epi::TWOSEG) { if (cur.seg == 0) { E.between(acc, cur, wr2, wc2, fr2, fq2); keep = true; } }
        if constexpr (!Epi::AFTER_DRAIN) { if (!keep) { E(acc, cur, wr2, wc2, fr2, fq2); S.done(cur); } }
        PG8_STAMP();
        if (!has_next) break;
        if (!keep) {
#pragma unroll
        for (int a = 0; a < 2; ++a)
#pragma unroll
            for (int b = 0; b < 2; ++b)
#pragma unroll
                for (int m = 0; m < 4; ++m)
#pragma unroll
                    for (int n = 0; n < 2; ++n) acc[a][b][m][n] = (f32x4){0.f, 0.f, 0.f, 0.f};
        }
        cur = nxt; cA = nA; cB = nB; ++ui;
        if (wr == 1) PG8_BAR;
    }
    PG8_WAIT_V(0);
    PG8_BAR;
    if constexpr (Epi::AFTER_DRAIN) { E.fused(acc, cur, wr, wc, fr, fq, lds, wid, lane); S.done(cur); }
    PG8_STAMP();
    if (STAMP && wid == 0) { stamps[lane] = lane < nts ? (((unsigned long long)(unsigned)ts_hi << 32) | (unsigned)ts_lo) : 0ull;
        if (lane == 62) stamps[62] = rt_entry; if (lane == 63) stamps[63] = (unsigned long long)wall_clock64(); }
#undef PG8_STAMP
#undef PG8_SA
#undef PG8_SB
#undef PG8_STAGE
#undef PG8_LDA
#undef PG8_LDB
#undef PG8_MMA
#undef PG8_WAIT_V
#undef PG8_WAIT_L
#undef PG8_BAR
#undef PG8_SCHED
}
}

namespace cg = cooperative_groups;
using pg8::bf16_t; using pg8::bf16x8; using pg8::f32x4; using pg8::u32x4; using pg8::Unit; using pg8::cvt_pk_bf16;
typedef float f32x16 __attribute__((ext_vector_type(16)));
typedef unsigned u32x2 __attribute__((ext_vector_type(2)));
typedef float f32x2s __attribute__((ext_vector_type(2)));

constexpr int D = 1024, MP = 16384, MSM = 1024, M = MP + MSM, FF = 2816, INW = 1280;
constexpr int NL = 2, SEQ = 2048, NB = 8, DB = 128;
constexpr int ST_OFF = 131072 + 4096, LDS_BYTES = ST_OFF + 16 + 256;
static_assert(pg8::TIDTAB_OFF == ST_OFF + 16, "tid table offset");
#define MYTID() pg8::tid_from_lds((const volatile LAS unsigned*)(lds + ST_OFF + 16))
constexpr int NIN = 35;

constexpr size_t E_WGU = (size_t)2 * FF * D, E_WD = (size_t)D * FF, E_WIN = (size_t)INW * D, E_WGLU = 512 * 512, E_WO = 1024 * 512, E_WPG = 1024 * 1024, E_WPP = 1024 * 256;
constexpr size_t OW_GU1 = 0, OW_D1 = OW_GU1 + E_WGU, OW_IN = OW_D1 + E_WD, OW_GLU = OW_IN + E_WIN, OW_OA = OW_GLU + E_WGLU, OW_OB = OW_OA + E_WO,
                 OW_GU2 = OW_OB + E_WO, OW_D2 = OW_GU2 + E_WGU, OW_PG = OW_D2 + E_WD, OW_PP = OW_PG + E_WPG, E_WLAYER = OW_PP + E_WPP;
constexpr size_t WS_W = 0;
constexpr size_t WS_XB0 = WS_W + 2 * E_WLAYER * 2;
constexpr size_t WS_XB1 = WS_XB0 + (size_t)M * D * 2;
constexpr size_t WS_HB = WS_XB1 + (size_t)M * D * 2;
constexpr size_t SZ_512 = (size_t)M * 512 * 2;
constexpr size_t WS_KP = WS_HB + (size_t)M * FF * 2;
constexpr size_t WS_VTP = WS_KP + (size_t)MP * 128 * 2;
constexpr size_t WS_KS = WS_VTP + (size_t)MP * 128 * 2;
constexpr size_t WS_VTS = WS_KS + (size_t)NL * DB * 160 * 128 * 2;
constexpr size_t WS_PB = WS_VTS + (size_t)NL * DB * 160 * 128 * 2;
constexpr size_t WS_SSQ = WS_PB + (size_t)NL * M * 256 * 2;
constexpr size_t SZ_SSQ16 = (size_t)M * 16 * 4, SZ_SSQ8 = (size_t)M * 8 * 4;
constexpr size_t WS_TAB = WS_SSQ + 4 * SZ_SSQ16 + 2 * SZ_SSQ8;
constexpr size_t TAB_BB = 0, TAB_CM = 131072, TAB_AR = 262144, TAB_AI = TAB_AR + 8192, TAB_A2R = TAB_AI + 8192, TAB_A2I = TAB_A2R + 8192, TAB_LAYER = TAB_A2I + 8192;
constexpr size_t WS_BAR = WS_TAB + NL * TAB_LAYER;
constexpr size_t WS_END = WS_BAR + 16384;

constexpr size_t O_Y = 0, O_KP = (size_t)M * D, O_VP = O_KP + (size_t)NL * NB * 128 * 128, O_HPR = O_VP + (size_t)NL * NB * 128 * 128, O_HPI = O_HPR + (size_t)NL * NB * 32 * 64,
                 O_KS = O_HPI + (size_t)NL * NB * 32 * 64, O_VS = O_KS + (size_t)NL * DB * 128 * 128, O_HSR = O_VS + (size_t)NL * DB * 128 * 128, O_HSI = O_HSR + (size_t)NL * DB * 32 * 64;

struct Args { const float* in[NIN]; float* out; unsigned char* ws; };
typedef const __attribute__((address_space(4))) unsigned long long* kargp_t;
__device__ __forceinline__ kargp_t kbase() { kargp_t p = (kargp_t)__builtin_amdgcn_kernarg_segment_ptr(); asm volatile("" : "+s"(p)); return p; }
__device__ __forceinline__ const float* kin(int i) { return (const float*)kbase()[i]; }
__device__ __forceinline__ float* kout() { return (float*)kbase()[NIN]; }
__device__ __forceinline__ unsigned char* kws() { return (unsigned char*)kbase()[NIN + 1]; }

__device__ __forceinline__ int bid() { int b = (int)blockIdx.x; asm volatile("" : "+s"(b)); return b; }
__device__ __forceinline__ int gdim() { int g = (int)gridDim.x; asm volatile("" : "+s"(g)); return g; }
__device__ __forceinline__ float wave_sum(float v) {
#pragma unroll
    for (int o = 1; o < 64; o <<= 1) v += __shfl_xor(v, o);
    return v;
}
__device__ __forceinline__ float sigm(float x) { return __builtin_amdgcn_rcpf(1.0f + __builtin_amdgcn_exp2f(-1.44269504f * x)); }
__device__ __forceinline__ float silu_f(float x) { return x * sigm(x); }
__device__ __forceinline__ float gelu_tanh(float x) { return x * sigm(1.5957691216f * (x + 0.044715f * x * x * x)); }
__device__ __forceinline__ float bf2f(unsigned short b) { return __uint_as_float(((unsigned)b) << 16); }
__device__ __forceinline__ float bflo(unsigned w) { return __uint_as_float(w << 16); }
__device__ __forceinline__ float bfhi(unsigned w) { return __uint_as_float(w & 0xffff0000u); }
__device__ __forceinline__ unsigned short f2bf(float f) { return (unsigned short)(cvt_pk_bf16(f, 0.f) & 0xffffu); }
__device__ __forceinline__ int vt_idx(int t, int d) { const int u = t & 15; return (t >> 4) * 1024 + d * 16 + (((u >> 2) & 1) << 3) + ((u >> 3) << 2) + (u & 3); }
__device__ __forceinline__ float rs16(const float* ssq, int row) {
    const f32x4* p = (const f32x4*)(ssq + (size_t)row * 16); const f32x4 a = p[0], b = p[1], c = p[2], d = p[3]; const f32x4 s = (a + b) + (c + d);
    return __builtin_amdgcn_rsqf(((s.x + s.y) + (s.z + s.w)) * (1.f / 1024.f) + 1e-6f);
}
__device__ __forceinline__ float rs16c(const float* ssq, int row, int fq) {
    const f32x4 a = *(const f32x4*)(ssq + (size_t)row * 16 + 4 * fq); float s = (a.x + a.y) + (a.z + a.w); s += __shfl_xor(s, 16); s += __shfl_xor(s, 32);
    return __builtin_amdgcn_rsqf(s * (1.f / 1024.f) + 1e-6f);
}
__device__ __forceinline__ float rs8(const float* ssq, int row) {
    const f32x4* p = (const f32x4*)(ssq + (size_t)row * 8); const f32x4 a = p[0], b = p[1]; const f32x4 s = a + b;
    return __builtin_amdgcn_rsqf(((s.x + s.y) + (s.z + s.w)) * (1.f / 512.f) + 1e-6f);
}


struct EpiSwiglu {
    static constexpr bool PERM = true, AFTER_DRAIN = false, TWOSEG = false;
    bf16_t* H; const float* ssq;
    __device__ __forceinline__ void operator()(const f32x4 (&acc)[2][2][4][2], const Unit& u, int wr, int wc, int fr, int fq) const {
        const int row0 = u.pm * 256 + wr * 64 + fr, col0 = u.pn * 128 + wc * 32 + 8 * fq;
#pragma unroll
        for (int ai = 0; ai < 2; ++ai)
#pragma unroll
            for (int m = 0; m < 4; ++m) {
                const int row = row0 + ai * 128 + m * 16; const float rs = rs16c(ssq, row, fq);
                const float c1 = -1.44269504f * rs, c2 = rs * rs;
                unsigned wq[4];
#pragma unroll
                for (int n = 0; n < 2; ++n)
#pragma unroll
                    for (int jp = 0; jp < 2; ++jp) {
                        const f32x2s g = {acc[ai][0][m][n][2 * jp], acc[ai][0][m][n][2 * jp + 1]}, up = {acc[ai][1][m][n][2 * jp], acc[ai][1][m][n][2 * jp + 1]};
                        const f32x2s t = g * c1;
                        f32x2s d = {__builtin_amdgcn_exp2f(t.x), __builtin_amdgcn_exp2f(t.y)}; d = d + 1.0f;
                        const float r = __builtin_amdgcn_rcpf(d.x * d.y);
                        const f32x2s inv = (f32x2s){d.y, d.x} * r;
                        const f32x2s hh = ((g * up) * c2) * inv;
                        wq[n * 2 + jp] = cvt_pk_bf16(hh.x, hh.y);
                    }
                u32x4 w; w.x = wq[0]; w.y = wq[1]; w.z = wq[2]; w.w = wq[3];
                *(u32x4*)(H + (size_t)row * FF + col0) = w;
            }
    }
};

template <int MODE, bool WXB> struct EpiRes {
    static constexpr bool PERM = true, AFTER_DRAIN = false, TWOSEG = (MODE == 1);
    const bf16_t* xin; bf16_t* xb; float* ssq_out; const float* ssq_in; const bf16_t* pp;
    __device__ __forceinline__ void between(f32x4 (&acc)[2][2][4][2], const Unit& u, int wr, int wc, int fr, int fq) const {
        const int row0 = u.pm * 256 + wr * 64 + fr;
#pragma unroll
        for (int ai = 0; ai < 2; ++ai)
#pragma unroll
            for (int m = 0; m < 4; ++m) { const int row = row0 + ai * 128 + m * 16; const float ratio = rs8((const float*)pp, row) / rs8(ssq_in, row);
#pragma unroll
                for (int bj = 0; bj < 2; ++bj)
#pragma unroll
                    for (int n = 0; n < 2; ++n) acc[ai][bj][m][n] *= ratio; }
    }
    __device__ __forceinline__ void operator()(const f32x4 (&acc)[2][2][4][2], const Unit& u, int wr, int wc, int fr, int fq) const {
        const int row0 = u.pm * 256 + wr * 64 + fr, col0 = u.pn * 256 + wc * 32 + 8 * fq;
#pragma unroll
        for (int ai = 0; ai < 2; ++ai)
#pragma unroll
            for (int m = 0; m < 4; ++m) {
                const int row = row0 + ai * 128 + m * 16; float rs = 0.5f;
                if (MODE == 1) rs = rs8(ssq_in, row);
                if (MODE == 2) rs = rs16c(ssq_in, row, fq);
                float s = 0.f;
#pragma unroll
                for (int bj = 0; bj < 2; ++bj) {
                    const size_t off = (size_t)row * D + col0 + bj * 128;
                    const u32x4 xw = *(const u32x4*)(xin + off); const f32x4 a0 = acc[ai][bj][m][0], a1 = acc[ai][bj][m][1];
                    float xv[8] = {bflo(xw.x), bfhi(xw.x), bflo(xw.y), bfhi(xw.y), bflo(xw.z), bfhi(xw.z), bflo(xw.w), bfhi(xw.w)};
                    const float av[8] = {a0.x, a0.y, a0.z, a0.w, a1.x, a1.y, a1.z, a1.w};
                    if (MODE == 2) {
                        const u32x4 pw = *(const u32x4*)(pp + off);
                        const float pv[8] = {bflo(pw.x), bfhi(pw.x), bflo(pw.y), bfhi(pw.y), bflo(pw.z), bfhi(pw.z), bflo(pw.w), bfhi(pw.w)};
#pragma unroll
                        for (int q = 0; q < 8; ++q) xv[q] += pv[q] * sigm(rs * av[q]);
                    } else {
#pragma unroll
                        for (int q = 0; q < 8; ++q) xv[q] += av[q] * rs;
                    }
                    u32x4 w; w.x = cvt_pk_bf16(xv[0], xv[1]); w.y = cvt_pk_bf16(xv[2], xv[3]); w.z = cvt_pk_bf16(xv[4], xv[5]); w.w = cvt_pk_bf16(xv[6], xv[7]);
                    *(u32x4*)(xb + off) = w;
#pragma unroll
                    for (int q = 0; q < 8; ++q) s += xv[q] * xv[q];
                }
                if (WXB) { s += __shfl_xor(s, 16); s += __shfl_xor(s, 32); if (fq == 0) ssq_out[(size_t)row * 16 + u.pn * 4 + wc] = s; }
            }
    }
};

struct EpiIn {
    static constexpr bool PERM = true, AFTER_DRAIN = false, TWOSEG = false;
    bf16_t *UB, *QB, *KP, *VTP, *KS, *VTS; const float* ssq; float *okp, *ovp, *oks, *ovs; int l;
    __device__ __forceinline__ void operator()(const f32x4 (&acc)[2][2][4][2], const Unit& u, int wr, int wc, int fr, int fq) const {
        const int row0 = u.pm * 256 + wr * 64 + fr, cw = wc * 32 + 8 * fq;
#pragma unroll
        for (int ai = 0; ai < 2; ++ai)
#pragma unroll
            for (int m = 0; m < 4; ++m) {
                const int row = row0 + ai * 128 + m * 16; const float rs = rs16c(ssq, row, fq);
                if (u.pn < 4) {
                    const float sc = (u.pn < 2) ? rs : rs * 0.125f; bf16_t* dst = ((u.pn < 2) ? UB : QB) + (size_t)row * 512 + (u.pn & 1) * 256 + cw;
#pragma unroll
                    for (int bj = 0; bj < 2; ++bj) { const f32x4 v0 = acc[ai][bj][m][0] * sc, v1 = acc[ai][bj][m][1] * sc;
                        u32x4 w; w.x = cvt_pk_bf16(v0.x, v0.y); w.y = cvt_pk_bf16(v0.z, v0.w); w.z = cvt_pk_bf16(v1.x, v1.y); w.w = cvt_pk_bf16(v1.z, v1.w);
                        *(u32x4*)(dst + bj * 128) = w; }
                } else {
                    const f32x4 k0 = acc[ai][0][m][0] * rs, k1 = acc[ai][0][m][1] * rs, v0 = acc[ai][1][m][0] * rs, v1 = acc[ai][1][m][1] * rs;
                    u32x4 kw; kw.x = cvt_pk_bf16(k0.x, k0.y); kw.y = cvt_pk_bf16(k0.z, k0.w); kw.z = cvt_pk_bf16(k1.x, k1.y); kw.w = cvt_pk_bf16(k1.z, k1.w);
                    const float vv[8] = {v0.x, v0.y, v0.z, v0.w, v1.x, v1.y, v1.z, v1.w};
                    const int kvh = cw >> 6, d0 = cw & 63;
                    if (row < MP) {
                        const int b = row >> 11, t = row & 2047;
                        *(u32x4*)(KP + (size_t)row * 128 + cw) = kw;
                        bf16_t* vt = VTP + (size_t)(b * 2 + kvh) * 131072;
#pragma unroll
                        for (int j = 0; j < 8; ++j) vt[vt_idx(t, d0 + j)] = f2bf(vv[j]);
                        if (t >= 1920) { const size_t o = ((size_t)(l * NB + b) * 128 + (t - 1920)) * 128 + cw;
                            *(f32x4*)(okp + o) = k0; *(f32x4*)(okp + o + 4) = k1; *(f32x4*)(ovp + o) = v0; *(f32x4*)(ovp + o + 4) = v1; }
                    } else {
                        const int r = row - MP, b = r >> 3, s = r & 7;
                        *(u32x4*)(KS + ((size_t)(l * DB + b) * 160 + 128 + s) * 128 + cw) = kw;
                        bf16_t* vt = VTS + (size_t)((l * DB + b) * 2 + kvh) * 10240;
#pragma unroll
                        for (int j = 0; j < 8; ++j) vt[vt_idx(128 + s, d0 + j)] = f2bf(vv[j]);
                        const size_t o = ((size_t)(l * DB + b) * 128 + 120 + s) * 128 + cw;
                        *(f32x4*)(oks + o) = k0; *(f32x4*)(oks + o + 4) = k1; *(f32x4*)(ovs + o) = v0; *(f32x4*)(ovs + o + 4) = v1;
                    }
                }
            }
    }
};

struct EpiGlu {
    static constexpr bool PERM = true, AFTER_DRAIN = false, TWOSEG = false;
    const bf16_t* YG; bf16_t* YS; float* ssq_out;
    __device__ __forceinline__ void operator()(const f32x4 (&acc)[2][2][4][2], const Unit& u, int wr, int wc, int fr, int fq) const {
        const int row0 = u.pm * 256 + wr * 64 + fr, col0 = u.pn * 256 + wc * 32 + 8 * fq;
#pragma unroll
        for (int ai = 0; ai < 2; ++ai)
#pragma unroll
            for (int m = 0; m < 4; ++m) {
                const int row = row0 + ai * 128 + m * 16; float s = 0.f;
#pragma unroll
                for (int bj = 0; bj < 2; ++bj) {
                    const size_t off = (size_t)row * 512 + col0 + bj * 128; const u32x4 yw = *(const u32x4*)(YG + off);
                    const f32x4 a0 = acc[ai][bj][m][0], a1 = acc[ai][bj][m][1];
                    float o[8];
                    o[0] = bflo(yw.x) * sigm(a0.x); o[1] = bfhi(yw.x) * sigm(a0.y); o[2] = bflo(yw.y) * sigm(a0.z); o[3] = bfhi(yw.y) * sigm(a0.w);
                    o[4] = bflo(yw.z) * sigm(a1.x); o[5] = bfhi(yw.z) * sigm(a1.y); o[6] = bflo(yw.w) * sigm(a1.z); o[7] = bfhi(yw.w) * sigm(a1.w);
#pragma unroll
                    for (int j = 0; j < 8; ++j) s += o[j] * o[j];
                    u32x4 w; w.x = cvt_pk_bf16(o[0], o[1]); w.y = cvt_pk_bf16(o[2], o[3]); w.z = cvt_pk_bf16(o[4], o[5]); w.w = cvt_pk_bf16(o[6], o[7]);
                    *(u32x4*)(YS + off) = w;
                }
                s += __shfl_xor(s, 16); s += __shfl_xor(s, 32); if (fq == 0) ssq_out[(size_t)row * 8 + u.pn * 4 + wc] = s;
            }
    }
};

struct EpiBf {
    static constexpr bool PERM = true, AFTER_DRAIN = false, TWOSEG = false;
    bf16_t* O; int ldc;
    __device__ __forceinline__ void operator()(const f32x4 (&acc)[2][2][4][2], const Unit& u, int wr, int wc, int fr, int fq) const {
        const int row0 = u.pm * 256 + wr * 64 + fr, col0 = u.pn * 256 + wc * 32 + 8 * fq;
#pragma unroll
        for (int ai = 0; ai < 2; ++ai)
#pragma unroll
            for (int m = 0; m < 4; ++m) {
                const int row = row0 + ai * 128 + m * 16;
#pragma unroll
                for (int bj = 0; bj < 2; ++bj) { const f32x4 v0 = acc[ai][bj][m][0], v1 = acc[ai][bj][m][1];
                    u32x4 w; w.x = cvt_pk_bf16(v0.x, v0.y); w.y = cvt_pk_bf16(v0.z, v0.w); w.z = cvt_pk_bf16(v1.x, v1.y); w.w = cvt_pk_bf16(v1.z, v1.w);
                    *(u32x4*)(O + (size_t)row * ldc + col0 + bj * 128) = w; }
            }
    }
};

template <class Epi> __device__ __forceinline__ void run_gemm(unsigned char* lds, const bf16_t* A, const bf16_t* Bt, int N, int K, const Epi& E, int MR = MP, int skip = 0) {
    pg8::Gemm g{A, Bt, MR, N, K}; pg8::StaticOrder S; S.init(MR, N, gdim() - skip, bid() - skip);
    pg8::gemm_phase<Epi, pg8::StaticOrder, false>((PG8_LAS unsigned char*)lds, g, S, E, nullptr);
}

#ifndef MFMA16
#ifndef MFMA16
#define MFMA16(a, b, c) __builtin_amdgcn_mfma_f32_16x16x32_bf16((a), (b), (c), 0, 0, 0)
#endif
#endif

template <class Epi> __device__ __forceinline__ void run_gemm2(unsigned char* lds, const bf16_t* A, const bf16_t* Bt, const bf16_t* A2, const bf16_t* Bt2, int N, int K, const Epi& E, int MR = MP) {
    pg8::Gemm g{A, Bt, MR, N, K, A2, Bt2}; pg8::TwoSegOrder S; S.init(MR, N, gdim(), bid());
    pg8::gemm_phase<Epi, pg8::TwoSegOrder, false>((PG8_LAS unsigned char*)lds, g, S, E, nullptr);
}

template <class BRow>
__device__ __forceinline__ void small_gemm_item(unsigned char* lds, const bf16_t* Arows, int lda, const bf16_t* Bt, int K, const BRow& brow, int wave, int lane) {
    const int fr = lane & 15, fq = lane >> 4, kw = K >> 3, k0 = wave * kw;
    f32x4 acc[4][4];
#pragma unroll
    for (int a = 0; a < 4; ++a)
#pragma unroll
        for (int b = 0; b < 4; ++b) acc[a][b] = (f32x4){0.f, 0.f, 0.f, 0.f};
    const bf16_t* ap = Arows + (size_t)fr * lda + k0 + fq * 8;
    const bf16_t* bp[4];
#pragma unroll
    for (int nb = 0; nb < 4; ++nb) bp[nb] = Bt + (size_t)brow(nb * 16 + fr) * K + k0 + fq * 8;
    for (int kc = 0; kc < kw; kc += 128) {
        bf16x8 a[4][4], b[4][4];
#pragma unroll
        for (int s = 0; s < 4; ++s) {
            if (kc + 32 * s < kw) {
#pragma unroll
                for (int i = 0; i < 4; ++i) { a[s][i] = *(const bf16x8*)(ap + (size_t)i * 16 * lda + kc + 32 * s); b[s][i] = *(const bf16x8*)(bp[i] + kc + 32 * s); }
            }
        }
#pragma unroll
        for (int s = 0; s < 4; ++s) {
            if (kc + 32 * s < kw) {
#pragma unroll
                for (int mb = 0; mb < 4; ++mb)
#pragma unroll
                    for (int nb = 0; nb < 4; ++nb) acc[mb][nb] = MFMA16(b[s][nb], a[s][mb], acc[mb][nb]);
            }
        }
    }
    float* P = (float*)(lds + wave * 16384);
#pragma unroll
    for (int mb = 0; mb < 4; ++mb)
#pragma unroll
        for (int nb = 0; nb < 4; ++nb) { const int mm = mb * 16 + fr; *(f32x4*)(P + mm * 64 + (((nb * 4 + fq) ^ (mm & 7)) << 2)) = acc[mb][nb]; }
}
__device__ __forceinline__ f32x4 small_read(const unsigned char* lds, int mm, int cg) {
    const int o = mm * 64 + ((cg ^ (mm & 7)) << 2);
    f32x4 s = *(const f32x4*)((const float*)lds + o);
#pragma unroll
    for (int w = 1; w < 8; ++w) s += *(const f32x4*)((const float*)(lds + w * 16384) + o);
    return s;
}
struct BRowLin { int base; __device__ __forceinline__ int operator()(int c) const { return base + c; } };
struct BRowGU { int gbase; __device__ __forceinline__ int operator()(int c) const { return gbase + (c & 31) + ((c >> 5) << 7); } };

struct SmallArgs { const bf16_t* A; int lda; const bf16_t* Bt; int K; int l; int xsel, so, si, mode, src; };
template <int KIND>
__device__ __forceinline__ void small_phase(unsigned char* lds, const SmallArgs& sa, int ncb, int skip, int wave, int lane) {
    const int nvb = gdim() - skip, vb = bid() - skip;
    if (vb < 0) return;
    const int tid = wave * 64 + lane, mm = tid >> 3, j = tid & 7;
    for (int id = vb; id < 16 * ncb; id += nvb) {
        int rg = id & 15, cb = id >> 4;
        if (ncb == 16 && skip == 0 && nvb == 256) { const int xcd = id & 7, jj = id >> 3; rg = (xcd >> 1) * 4 + (jj & 3); cb = (xcd & 1) * 8 + (jj >> 2); }
        const bf16_t* Arows = sa.A + (size_t)(MP + rg * 64) * sa.lda;
        if (KIND == 0) { BRowGU br{((cb * 32) >> 7) * 256 + ((cb * 32) & 127)}; small_gemm_item(lds, Arows, sa.lda, sa.Bt, sa.K, br, wave, lane); }
        else { BRowLin br{cb * 64}; small_gemm_item(lds, Arows, sa.lda, sa.Bt, sa.K, br, wave, lane); }
        __syncthreads();
        unsigned char* ws = kws(); float* out = kout();
        const int row = MP + rg * 64 + mm;
        if (KIND == 0) {
            const float rs = rs16((const float*)(ws + WS_SSQ + (size_t)sa.si * SZ_SSQ16), row);
            const f32x4 g = small_read(lds, mm, j) * rs, u = small_read(lds, mm, 8 + j) * rs;
            u32x2 w; w.x = cvt_pk_bf16(silu_f(g.x) * u.x, silu_f(g.y) * u.y); w.y = cvt_pk_bf16(silu_f(g.z) * u.z, silu_f(g.w) * u.w);
            *(u32x2*)((bf16_t*)(ws + WS_HB) + (size_t)row * FF + cb * 32 + 4 * j) = w;
        } else {
            const f32x4 v0 = small_read(lds, mm, 2 * j), v1 = small_read(lds, mm, 2 * j + 1);
            const int col = cb * 64 + 8 * j;
            if (KIND == 1) {
                const bf16_t* xi = (const bf16_t*)(ws + (sa.src ? WS_XB1 : WS_XB0)) + (size_t)row * D + col; bf16_t* xb = (bf16_t*)(ws + (sa.xsel ? WS_XB1 : WS_XB0)) + (size_t)row * D + col;
                const u32x4 xw = *(const u32x4*)xi;
                f32x4 x0 = {bflo(xw.x), bfhi(xw.x), bflo(xw.y), bfhi(xw.y)}, x1 = {bflo(xw.z), bfhi(xw.z), bflo(xw.w), bfhi(xw.w)};
                if (sa.mode == 0) { x0 += v0 * 0.5f; x1 += v1 * 0.5f; }
                else if (sa.mode == 1) { const float rs = rs8((const float*)(ws + WS_SSQ + 4 * SZ_SSQ16 + (size_t)sa.si * SZ_SSQ8), row); x0 += v0 * rs; x1 += v1 * rs; }
                else { const float rs = rs16((const float*)(ws + WS_SSQ + (size_t)sa.si * SZ_SSQ16), row); const u32x4 pw = *(const u32x4*)((const bf16_t*)out + (size_t)row * D + col);
                    x0.x += bflo(pw.x) * sigm(rs * v0.x); x0.y += bfhi(pw.x) * sigm(rs * v0.y); x0.z += bflo(pw.y) * sigm(rs * v0.z); x0.w += bfhi(pw.y) * sigm(rs * v0.w);
                    x1.x += bflo(pw.z) * sigm(rs * v1.x); x1.y += bfhi(pw.z) * sigm(rs * v1.y); x1.z += bflo(pw.w) * sigm(rs * v1.z); x1.w += bfhi(pw.w) * sigm(rs * v1.w); }
                { u32x4 w; w.x = cvt_pk_bf16(x0.x, x0.y); w.y = cvt_pk_bf16(x0.z, x0.w); w.z = cvt_pk_bf16(x1.x, x1.y); w.w = cvt_pk_bf16(x1.z, x1.w); *(u32x4*)xb = w; }
                if (sa.so >= 0) {
                    float s = ((x0.x * x0.x + x0.y * x0.y) + (x0.z * x0.z + x0.w * x0.w)) + ((x1.x * x1.x + x1.y * x1.y) + (x1.z * x1.z + x1.w * x1.w));
                    s += __shfl_xor(s, 1); s += __shfl_xor(s, 2); s += __shfl_xor(s, 4);
                    if (j == 0) ((float*)(ws + WS_SSQ + (size_t)sa.so * SZ_SSQ16))[(size_t)row * 16 + cb] = s;
                }
            } else if (KIND == 2) {
                const float rs = rs16((const float*)(ws + WS_SSQ + SZ_SSQ16), row); const int l = sa.l;
                const int r = row - MP, b = r >> 3, s = r & 7;
                if (cb < 16) { const float sc = (cb < 8) ? rs : rs * 0.125f; const f32x4 a0 = v0 * sc, a1 = v1 * sc;
                    u32x4 w; w.x = cvt_pk_bf16(a0.x, a0.y); w.y = cvt_pk_bf16(a0.z, a0.w); w.z = cvt_pk_bf16(a1.x, a1.y); w.w = cvt_pk_bf16(a1.z, a1.w);
                    *(u32x4*)((bf16_t*)(ws + WS_HB + (cb < 8 ? 0 : SZ_512)) + (size_t)row * 512 + (col & 511)) = w;
                } else { const f32x4 a0 = v0 * rs, a1 = v1 * rs; const int ck = col & 127; const size_t o = ((size_t)(l * DB + b) * 128 + 120 + s) * 128 + ck;
                    if (cb < 18) { u32x4 w; w.x = cvt_pk_bf16(a0.x, a0.y); w.y = cvt_pk_bf16(a0.z, a0.w); w.z = cvt_pk_bf16(a1.x, a1.y); w.w = cvt_pk_bf16(a1.z, a1.w);
                        *(u32x4*)((bf16_t*)(ws + WS_KS) + ((size_t)(l * DB + b) * 160 + 128 + s) * 128 + ck) = w;
                        *(f32x4*)(out + O_KS + o) = a0; *(f32x4*)(out + O_KS + o + 4) = a1;
                    } else { const float vv[8] = {a0.x, a0.y, a0.z, a0.w, a1.x, a1.y, a1.z, a1.w}; const int kvh = ck >> 6, d0 = ck & 63;
                        bf16_t* vt = (bf16_t*)(ws + WS_VTS) + (size_t)((l * DB + b) * 2 + kvh) * 10240;
#pragma unroll
                        for (int q = 0; q < 8; ++q) vt[vt_idx(128 + s, d0 + q)] = f2bf(vv[q]);
                        *(f32x4*)(out + O_VS + o) = a0; *(f32x4*)(out + O_VS + o + 4) = a1; }
                }
            } else if (KIND == 3) {
                const size_t off = (size_t)row * 512 + col; const u32x4 yw = *(const u32x4*)((const bf16_t*)(ws + WS_HB + 2 * SZ_512) + off);
                float o[8];
                o[0] = bflo(yw.x) * sigm(v0.x); o[1] = bfhi(yw.x) * sigm(v0.y); o[2] = bflo(yw.y) * sigm(v0.z); o[3] = bfhi(yw.y) * sigm(v0.w);
                o[4] = bflo(yw.z) * sigm(v1.x); o[5] = bfhi(yw.z) * sigm(v1.y); o[6] = bflo(yw.w) * sigm(v1.z); o[7] = bfhi(yw.w) * sigm(v1.w);
                float s = 0.f;
#pragma unroll
                for (int q = 0; q < 8; ++q) s += o[q] * o[q];
                u32x4 w; w.x = cvt_pk_bf16(o[0], o[1]); w.y = cvt_pk_bf16(o[2], o[3]); w.z = cvt_pk_bf16(o[4], o[5]); w.w = cvt_pk_bf16(o[6], o[7]);
                *(u32x4*)((bf16_t*)(ws + WS_HB + 3 * SZ_512) + off) = w;
                s += __shfl_xor(s, 1); s += __shfl_xor(s, 2); s += __shfl_xor(s, 4);
                if (j == 0) ((float*)(ws + WS_SSQ + 4 * SZ_SSQ16))[(size_t)row * 8 + cb] = s;
            } else {
                u32x4 w; w.x = cvt_pk_bf16(v0.x, v0.y); w.y = cvt_pk_bf16(v0.z, v0.w); w.z = cvt_pk_bf16(v1.x, v1.y); w.w = cvt_pk_bf16(v1.z, v1.w);
                *(u32x4*)((bf16_t*)out + (size_t)row * D + col) = w;
            }
        }
        __syncthreads();
    }
}
#define SMALL(KIND, NCB, SKIP, ...) { int tid_ = MYTID(); asm volatile("" : "+v"(tid_)); const int lane_ = tid_ & 63, wave_ = __builtin_amdgcn_readfirstlane(tid_ >> 6); \
    unsigned char* ws_ = kws(); (void)ws_; SmallArgs sa_ = __VA_ARGS__; small_phase<KIND>(lds, sa_, NCB, SKIP, wave_, lane_); }

__device__ __forceinline__ void tr_item(const float* W, int ldw, const float* gain, bf16_t* WT, int Kd, int k0, int n0, int drow0, float* scr, int lane) {
    float tv[32];
#pragma unroll
    for (int i = 0; i < 32; ++i) { const int kk = 2 * i + (lane >> 5); tv[i] = W[(size_t)(k0 + kk) * ldw + n0 + (lane & 31)]; }
    if (gain) {
#pragma unroll
        for (int i = 0; i < 32; ++i) tv[i] *= gain[k0 + 2 * i + (lane >> 5)]; }
#pragma unroll
    for (int i = 0; i < 32; ++i) scr[(2 * i + (lane >> 5)) * 33 + (lane & 31)] = tv[i];
    asm volatile("s_waitcnt lgkmcnt(0)" ::: "memory");
    const int c = lane & 7;
#pragma unroll
    for (int j = 0; j < 4; ++j) { const int n = (lane >> 3) + 8 * j; const float* s = scr + (8 * c) * 33 + n;
        u32x4 o; o.x = cvt_pk_bf16(s[0 * 33], s[1 * 33]); o.y = cvt_pk_bf16(s[2 * 33], s[3 * 33]); o.z = cvt_pk_bf16(s[4 * 33], s[5 * 33]); o.w = cvt_pk_bf16(s[6 * 33], s[7 * 33]);
        *(u32x4*)(WT + (size_t)(drow0 + n) * Kd + k0 + 8 * c) = o; }
    asm volatile("s_waitcnt lgkmcnt(0)" ::: "memory");
}

__device__ __forceinline__ void cexp_i(double th, double& c, double& s) {
    const double TWO_PI_HI = 6.283185307179586232, TWO_PI_LO = 2.4492935982947064e-16;
    const double k = rint(th * 0.15915494309189534561);
    double r = fma(-k, TWO_PI_HI, th); r = fma(-k, TWO_PI_LO, r);
    const double h = r * 0.125;
    double cr = 1.0, ci = 0.0, tr = 1.0, ti = 0.0;
    for (int n = 1; n <= 16; ++n) { const double nr = -ti * h / n, ni = tr * h / n; tr = nr; ti = ni; cr += tr; ci += ti; }
    for (int q = 0; q < 3; ++q) { const double nr = cr * cr - ci * ci, ni = 2.0 * cr * ci; cr = nr; ci = ni; }
    c = cr; s = ci;
}

constexpr int I_LAYER_ALL = 6 * (16 * 88) + 16 * 40 + 8 * 16 + 2 * (8 * 32) + 16 * 32 + 4 * 32;
__device__ __forceinline__ void conv_weights(unsigned char* lds, int wave, int lane, int l, int it_begin, int it_end, int vgw, int VNGW) {
    unsigned char* ws = kws(); float* scr = (float*)(lds + wave * 16384);
    constexpr int I_FU = 16 * 88, I_FD = 44 * 32, I_IN = 16 * 40, I_GLU = 8 * 16, I_O = 8 * 32, I_PG = 16 * 32, I_PPJ = 4 * 32;
    constexpr int I_LAYER = 6 * I_FU + I_IN + I_GLU + 2 * I_O + I_PG + I_PPJ;
    static_assert(I_FU == I_FD && I_LAYER == I_LAYER_ALL, "items");
    for (int it = it_begin + vgw; it < it_end; it += VNGW) {
        int r = it;
        bf16_t* WL = (bf16_t*)(ws + WS_W) + (size_t)l * E_WLAYER;
#define TRM(SRC, LDW, GAIN, DST, KD, KROWS, NCOLS, ROWEXPR) { constexpr int nit = ((KROWS) / 64) * ((NCOLS) / 32); if (r < nit) { constexpr int nblk = (NCOLS) / 32; const int kb = r / nblk, nb = r % nblk, k0 = kb * 64, n0 = nb * 32; \
            tr_item(SRC, LDW, GAIN, DST, KD, k0, n0, ROWEXPR, scr, lane); continue; } r -= nit; }
        TRM(kin(9) + (size_t)l * D * FF, FF, kin(8) + l * D, WL + OW_GU1, D, D, FF, ((n0 >> 7) * 256 + (n0 & 127)))
        TRM(kin(10) + (size_t)l * D * FF, FF, kin(8) + l * D, WL + OW_GU1, D, D, FF, ((n0 >> 7) * 256 + 128 + (n0 & 127)))
        TRM(kin(11) + (size_t)l * FF * D, D, (const float*)nullptr, WL + OW_D1, FF, FF, D, n0)
        TRM(kin(13) + (size_t)l * D * INW, INW, kin(12) + l * D, WL + OW_IN, D, D, INW, n0)
        TRM(kin(22) + (size_t)l * 512 * 512, 512, (const float*)nullptr, WL + OW_GLU, 512, 512, 512, n0)
        TRM(kin(26) + (size_t)l * D * D, D, kin(23) + l * 512, WL + OW_OA, 512, 512, D, n0)
        TRM(kin(26) + (size_t)l * D * D + (size_t)512 * D, D, kin(25) + l * 512, WL + OW_OB, 512, 512, D, n0)
        TRM(kin(28) + (size_t)l * D * FF, FF, kin(27) + l * D, WL + OW_GU2, D, D, FF, ((n0 >> 7) * 256 + (n0 & 127)))
        TRM(kin(29) + (size_t)l * D * FF, FF, kin(27) + l * D, WL + OW_GU2, D, D, FF, ((n0 >> 7) * 256 + 128 + (n0 & 127)))
        TRM(kin(30) + (size_t)l * FF * D, D, (const float*)nullptr, WL + OW_D2, FF, FF, D, n0)
        TRM(kin(32) + (size_t)l * D * D, D, kin(31) + l * D, WL + OW_PG, D, D, D, n0)
        TRM(kin(33) + (size_t)l * 256 * D, D, (const float*)nullptr, WL + OW_PP, 256, 256, D, n0)
#undef TRM
    }
}

__device__ __forceinline__ void p0_phase(unsigned char* lds, int wave, int lane) {
    unsigned char* ws = kws(); float* out = kout();
    const int G = gridDim.x, gw = blockIdx.x * 8 + wave, NGW = G * 8;
    conv_weights(lds, wave, lane, 0, 0, 2 * 16 * 88, gw, NGW);
    {
        bf16_t* XB0 = (bf16_t*)(ws + WS_XB0); float* ssq0 = (float*)(ws + WS_SSQ);
        for (int m = gw; m < M; m += NGW) {
            const float* src = (m < MP) ? kin(0) + (size_t)m * D : kin(1) + (size_t)(m - MP) * D;
            float s = 0.f;
#pragma unroll
            for (int j = 0; j < 4; ++j) { const f32x4 v = ((const f32x4*)src)[lane + 64 * j];
                u32x2 w; w.x = cvt_pk_bf16(v.x, v.y); w.y = cvt_pk_bf16(v.z, v.w); ((u32x2*)(XB0 + (size_t)m * D))[lane + 64 * j] = w; s += (v.x * v.x + v.y * v.y) + (v.z * v.z + v.w * v.w); }
            s = wave_sum(s);
            if (lane < 16) ssq0[(size_t)m * 16 + lane] = (lane == 0) ? s : 0.f;
        }
    }
    const size_t gt = (size_t)blockIdx.x * 512 + wave * 64 + lane, NGT = (size_t)G * 512;
    for (size_t i = gt; i < (size_t)NL * 32 * 64; i += NGT) {
        const int n = (int)(i & 63), lg = (int)(i >> 6), l = lg >> 5, g = lg & 31;
        unsigned char* tab = ws + WS_TAB + (size_t)l * TAB_LAYER;
        const double lr = (double)kin(14)[i], li = (double)kin(15)[i], dt = exp((double)kin(16)[lg]);
        const double zr = lr * dt, zi = li * dt; double c1, s1; cexp_i(zi, c1, s1); const double ea = exp(zr); const double ar = ea * c1, ai = ea * s1;
        double c2, s2; cexp_i(256.0 * zi, c2, s2); const double e2 = exp(256.0 * zr);
        ((float*)(tab + TAB_AR))[g * 64 + n] = (float)ar; ((float*)(tab + TAB_AI))[g * 64 + n] = (float)ai;
        ((float*)(tab + TAB_A2R))[g * 64 + n] = (float)(e2 * c2); ((float*)(tab + TAB_A2I))[g * 64 + n] = (float)(e2 * s2);
        const double nr = ar - 1.0, ni = ai, den = lr * lr + li * li; const double cr = (nr * lr + ni * li) / den, ci = (ni * lr - nr * li) / den;
        bf16_t* bb = (bf16_t*)(tab + TAB_BB) + (size_t)g * 128 * 16; bf16_t* cm = (bf16_t*)(tab + TAB_CM) + (size_t)g * 16 * 128;
        for (int p = 0; p < 16; ++p) {
            const double br = (double)kin(17)[i * 16 + p], bi = (double)kin(18)[i * 16 + p];
            bb[n * 16 + p] = f2bf((float)(cr * br - ci * bi)); bb[(64 + n) * 16 + p] = f2bf((float)(cr * bi + ci * br));
            cm[p * 128 + n] = f2bf(kin(19)[((size_t)lg * 16 + p) * 64 + n]); cm[p * 128 + 64 + n] = f2bf(-kin(20)[((size_t)lg * 16 + p) * 64 + n]);
        }
    }
}
__device__ __forceinline__ void p0_misc(int wave, int lane, int vb, int NVB) {
    unsigned char* ws = kws(); float* out = kout();
    const size_t gt = (size_t)vb * 512 + wave * 64 + lane, NGT = (size_t)NVB * 512;
    {
        bf16_t* PB = (bf16_t*)(ws + WS_PB);
        for (size_t i = gt; i < (size_t)NL * M * 64; i += NGT) { const int l = (int)(i / ((size_t)M * 64)); const size_t rem = i % ((size_t)M * 64); const int row = (int)(rem >> 6), c4 = (int)(rem & 63);
            const float* src = (row < MP) ? kin(6) + ((size_t)l * MP + row) * 256 + c4 * 4 : kin(7) + ((size_t)l * MSM + (row - MP)) * 256 + c4 * 4;
            const f32x4 v = *(const f32x4*)src; u32x2 w; w.x = cvt_pk_bf16(v.x, v.y); w.y = cvt_pk_bf16(v.z, v.w); ((u32x2*)PB)[i] = w; }
    }
    {
        bf16_t* KS = (bf16_t*)(ws + WS_KS); bf16_t* VTS = (bf16_t*)(ws + WS_VTS);
        for (size_t i = gt; i < (size_t)NL * DB * 160 * 32; i += NGT) { const int c4 = (int)(i & 31); const size_t t1 = i >> 5; const int key = (int)(t1 % 160); const size_t lb = t1 / 160;
            u32x2 w; w.x = 0u; w.y = 0u;
            if (key < 128) { const f32x4 v = *(const f32x4*)(kin(2) + (lb * 128 + key) * 128 + c4 * 4); w.x = cvt_pk_bf16(v.x, v.y); w.y = cvt_pk_bf16(v.z, v.w); }
            ((u32x2*)KS)[i] = w; }
        for (size_t i = gt; i < (size_t)NL * DB * 32 * 160; i += NGT) { const int t = (int)(i % 160); const size_t t1 = i / 160; const int c4 = (int)(t1 & 31); const size_t lb = t1 >> 5;
            f32x4 v = {0.f, 0.f, 0.f, 0.f}; if (t < 128) v = *(const f32x4*)(kin(3) + (lb * 128 + t) * 128 + c4 * 4);
            const int c = c4 * 4; bf16_t* d = VTS + (lb * 2 + (c >> 6)) * 10240; const int i0 = vt_idx(t, c & 63); d[i0] = f2bf(v.x); d[i0 + 16] = f2bf(v.y); d[i0 + 32] = f2bf(v.z); d[i0 + 48] = f2bf(v.w); }
        for (size_t i = gt; i < (size_t)NL * DB * 120 * 32; i += NGT) { const int c4 = (int)(i & 31); const size_t t1 = i >> 5; const int j = (int)(t1 % 120); const size_t lb = t1 / 120;
            const size_t so = (lb * 128 + j + 8) * 128 + c4 * 4, dofs = (lb * 128 + j) * 128 + c4 * 4;
            *(f32x4*)(out + O_KS + dofs) = *(const f32x4*)(kin(2) + so); *(f32x4*)(out + O_VS + dofs) = *(const f32x4*)(kin(3) + so); }
    }
}

#define MFMA32(a, b, c) __builtin_amdgcn_mfma_f32_32x32x16_bf16((a), (b), (c), 0, 0, 0)
#ifndef MFMA16
#define MFMA16(a, b, c) __builtin_amdgcn_mfma_f32_16x16x32_bf16((a), (b), (c), 0, 0, 0)
#endif

template <bool PASS2, int SEG>
__device__ __forceinline__ void ssm_sub(unsigned char* wl, const bf16_t* urow0, const bf16x8 ua, const bf16x8 (&bfr)[4], const bf16x8 (&cfr)[4], float ar, float ai, float& hr, float& hi, int lane,
                                        const float* h0re, const float* h0im, float* ofre, float* ofim, int segstride, bf16_t* ygrow0, f32x4 dv) {
    float* BU = (float*)wl; unsigned short* HB = (unsigned short*)wl;
    const int r = lane & 31, hf = lane >> 5;
    u32x2 uu[2] = {{0u, 0u}, {0u, 0u}};
    if (PASS2) {
#pragma unroll
        for (int tb = 0; tb < 2; ++tb) uu[tb] = *(const u32x2*)(urow0 + (size_t)(tb * 16 + (lane & 15)) * 512 + 4 * (lane >> 4)); }
    asm volatile("" ::: "memory");
    {
#pragma unroll
        for (int cb = 0; cb < 4; ++cb) {
            f32x16 acc;
#pragma unroll
            for (int i = 0; i < 16; ++i) acc[i] = 0.f;
            acc = MFMA32(ua, bfr[cb], acc);
#pragma unroll
            for (int i = 0; i < 16; ++i) BU[((i & 3) + 8 * (i >> 2) + 4 * hf) * 128 + cb * 32 + r] = acc[i];
        }
    }
    asm volatile("" ::: "memory");
#pragma unroll 8
    for (int t = 0; t < 32; ++t) {
        if (SEG < 32 && (t % SEG) == 0) { hr = h0re[(size_t)(t / SEG) * segstride + lane]; hi = h0im[(size_t)(t / SEG) * segstride + lane]; }
        const float br = BU[t * 128 + lane], bi = BU[t * 128 + 64 + lane];
        const float nr = fmaf(ar, hr, fmaf(-ai, hi, br)), ni = fmaf(ar, hi, fmaf(ai, hr, bi));
        hr = nr; hi = ni;
        if (PASS2) { HB[t * 136 + lane] = f2bf(hr); HB[t * 136 + 64 + lane] = f2bf(hi); }
        if (SEG < 32 && (t % SEG) == SEG - 1) { ofre[(size_t)(t / SEG) * segstride + lane] = hr; ofim[(size_t)(t / SEG) * segstride + lane] = hi; }
    }
    asm volatile("" ::: "memory");
    if (PASS2) {
        const int tk = lane & 15, q4 = lane >> 4;
#pragma unroll
        for (int tb = 0; tb < 2; ++tb) {
            f32x4 acc = {0.f, 0.f, 0.f, 0.f};
#pragma unroll
            for (int ks = 0; ks < 4; ++ks) { const bf16x8 hfrag = *(const bf16x8*)(wl + (tb * 16 + tk) * 272 + (ks * 32 + q4 * 8) * 2); acc = MFMA16(cfr[ks], hfrag, acc); }
            const size_t ro = (size_t)(tb * 16 + tk) * 512 + 4 * q4;
            const float y0 = gelu_tanh(acc.x + dv.x * bflo(uu[tb].x)), y1 = gelu_tanh(acc.y + dv.y * bfhi(uu[tb].x)), y2 = gelu_tanh(acc.z + dv.z * bflo(uu[tb].y)), y3 = gelu_tanh(acc.w + dv.w * bfhi(uu[tb].y));
            u32x2 w; w.x = cvt_pk_bf16(y0, y1); w.y = cvt_pk_bf16(y2, y3); *(u32x2*)(ygrow0 + ro) = w;
        }
    }
    asm volatile("" ::: "memory");
}

__device__ __forceinline__ void ssm_phase(unsigned char* lds, int l, int wave, int lane) {
    unsigned char* ws = kws(); float* out = kout();
    const unsigned char* tab = ws + WS_TAB + (size_t)l * TAB_LAYER;
    const bf16_t* UB = (const bf16_t*)(ws + WS_HB); bf16_t* YG = (bf16_t*)(ws + WS_HB + 2 * SZ_512);
    unsigned char* wl = lds + wave * 16384; float* xch = (float*)(lds + 131072);
    const int r = lane & 31, hf = lane >> 5, tk = lane & 15, q4 = lane >> 4;
    for (int unit = blockIdx.x; unit < NB * 32; unit += gridDim.x) {
        const int b = unit >> 5, g = unit & 31;
        bf16x8 bfr[4], cfr[4];
#pragma unroll
        for (int cb = 0; cb < 4; ++cb) bfr[cb] = *(const bf16x8*)((const bf16_t*)(tab + TAB_BB) + ((size_t)g * 128 + cb * 32 + r) * 16 + hf * 8);
#pragma unroll
        for (int ks = 0; ks < 4; ++ks) cfr[ks] = *(const bf16x8*)((const bf16_t*)(tab + TAB_CM) + ((size_t)g * 16 + tk) * 128 + ks * 32 + q4 * 8);
        const float ar = ((const float*)(tab + TAB_AR))[g * 64 + lane], ai = ((const float*)(tab + TAB_AI))[g * 64 + lane];
        const float a2r = ((const float*)(tab + TAB_A2R))[g * 64 + lane], a2i = ((const float*)(tab + TAB_A2I))[g * 64 + lane];
        const f32x4 dv = *(const f32x4*)(kin(21) + l * 512 + g * 16 + 4 * q4);
        const size_t row0 = (size_t)b * SEQ + wave * 256;
        float hr = 0.f, hi = 0.f;
        const bf16_t* ub0 = UB + row0 * 512 + g * 16 + (size_t)r * 512 + hf * 8;
        bf16x8 ua = *(const bf16x8*)ub0;
        for (int sc = 0; sc < 8; ++sc) { const bf16x8 uc = ua; ua = *(const bf16x8*)(ub0 + (size_t)((sc + 1) & 7) * 32 * 512);
            ssm_sub<false, 32>(wl, UB + (row0 + sc * 32) * 512 + g * 16, uc, bfr, cfr, ar, ai, hr, hi, lane, nullptr, nullptr, nullptr, nullptr, 0, nullptr, dv); }
        xch[wave * 128 + lane] = hr; xch[wave * 128 + 64 + lane] = hi;
        __syncthreads();
        float cr = 0.f, ci = 0.f;
        for (int j = 0; j < wave; ++j) { const float sr = xch[j * 128 + lane], si = xch[j * 128 + 64 + lane];
            const float nr = fmaf(a2r, cr, fmaf(-a2i, ci, sr)), ni = fmaf(a2r, ci, fmaf(a2i, cr, si)); cr = nr; ci = ni; }
        hr = cr; hi = ci;
        for (int sc = 0; sc < 8; ++sc) { const bf16x8 uc = ua; ua = *(const bf16x8*)(ub0 + (size_t)((sc + 1) & 7) * 32 * 512);
            ssm_sub<true, 32>(wl, UB + (row0 + sc * 32) * 512 + g * 16, uc, bfr, cfr, ar, ai, hr, hi, lane, nullptr, nullptr, nullptr, nullptr, 0, YG + (row0 + sc * 32) * 512 + g * 16, dv); }
        if (wave == 7) { out[O_HPR + ((size_t)(l * NB + b) * 32 + g) * 64 + lane] = hr; out[O_HPI + ((size_t)(l * NB + b) * 32 + g) * 64 + lane] = hi; }
        __syncthreads();
    }
    for (int wu = blockIdx.x * 8 + wave; wu < 32 * 32; wu += gridDim.x * 8) {
        const int g = wu & 31, bq = wu >> 5;
        bf16x8 bfr[4], cfr[4];
#pragma unroll
        for (int cb = 0; cb < 4; ++cb) bfr[cb] = *(const bf16x8*)((const bf16_t*)(tab + TAB_BB) + ((size_t)g * 128 + cb * 32 + r) * 16 + hf * 8);
#pragma unroll
        for (int ks = 0; ks < 4; ++ks) cfr[ks] = *(const bf16x8*)((const bf16_t*)(tab + TAB_CM) + ((size_t)g * 16 + tk) * 128 + ks * 32 + q4 * 8);
        const float ar = ((const float*)(tab + TAB_AR))[g * 64 + lane], ai = ((const float*)(tab + TAB_AI))[g * 64 + lane];
        const f32x4 dv = *(const f32x4*)(kin(21) + l * 512 + g * 16 + 4 * q4);
        const size_t row0 = (size_t)MP + bq * 32; const size_t so = ((size_t)(l * DB + bq * 4) * 32 + g) * 64;
        float hr = 0.f, hi = 0.f;
        ssm_sub<true, 8>(wl, UB + row0 * 512 + g * 16, *(const bf16x8*)(UB + row0 * 512 + g * 16 + (size_t)r * 512 + hf * 8), bfr, cfr, ar, ai, hr, hi, lane, kin(4) + so, kin(5) + so, out + O_HSR + so, out + O_HSI + so, 32 * 64, YG + row0 * 512 + g * 16, dv);
    }
}

__device__ __forceinline__ void attn_wave(const bf16_t* QB, const bf16_t* Kseq, const bf16_t* Vseq, int tstride, int qrow_base, int nq, int q0, float sink, bf16_t* YA, float* ssqT, int h, int lane) {
    const int r = lane & 31, hf = lane >> 5;
    const int qrow = qrow_base + (r < nq ? r : nq - 1);
    bf16x8 qf[4];
#pragma unroll
    for (int ks = 0; ks < 4; ++ks) qf[ks] = *(const bf16x8*)(QB + (size_t)qrow * 512 + h * 64 + ks * 16 + hf * 8);
    f32x16 s[5];
    const int kb0 = q0 - 128;
#pragma unroll
    for (int jb = 0; jb < 5; ++jb) {
#pragma unroll
        for (int i = 0; i < 16; ++i) s[jb][i] = 0.f;
        const int kp0 = kb0 + 32 * jb;
        if (kp0 >= 0) {
            const bf16_t* kptr = Kseq + (size_t)(kp0 + r) * 128 + hf * 8;
#pragma unroll
            for (int ks = 0; ks < 4; ++ks) { const bf16x8 kf = *(const bf16x8*)(kptr + ks * 16); s[jb] = MFMA32(kf, qf[ks], s[jb]); }
        }
    }
    bf16x8 vfr[5][2][2];
#pragma unroll
    for (int jb = 0; jb < 5; ++jb) {
        const int kp0 = kb0 + 32 * jb;
#pragma unroll
        for (int st = 0; st < 2; ++st)
#pragma unroll
            for (int db = 0; db < 2; ++db) {
                if (kp0 >= 0) vfr[jb][st][db] = *(const bf16x8*)(Vseq + (size_t)((kp0 + 16 * st) >> 4) * 1024 + (db * 32 + r) * 16 + hf * 8);
                else vfr[jb][st][db] = (bf16x8){0, 0, 0, 0, 0, 0, 0, 0}; }
    }
    const int qp = q0 + r;
    float mx = sink;
#pragma unroll
    for (int jb = 0; jb < 5; ++jb)
#pragma unroll
        for (int i = 0; i < 16; ++i) { const int kp = kb0 + 32 * jb + (i & 3) + 8 * (i >> 2) + 4 * hf; const bool ok = (kp >= 0) && (kp <= qp) && (qp - kp < 128);
            s[jb][i] = ok ? s[jb][i] : -1e30f; mx = fmaxf(mx, s[jb][i]); }
    mx = fmaxf(mx, __shfl_xor(mx, 32));
    float sum = 0.f;
#pragma unroll
    for (int jb = 0; jb < 5; ++jb)
#pragma unroll
        for (int i = 0; i < 16; ++i) { const float p = (s[jb][i] > -1e29f) ? __builtin_amdgcn_exp2f((s[jb][i] - mx) * 1.44269504f) : 0.f; s[jb][i] = p; sum += p; }
    sum += __shfl_xor(sum, 32);
    sum += __builtin_amdgcn_exp2f((sink - mx) * 1.44269504f);
    const float inv = 1.0f / sum;
    f32x16 o[2];
#pragma unroll
    for (int i = 0; i < 16; ++i) { o[0][i] = 0.f; o[1][i] = 0.f; }
#pragma unroll
    for (int jb = 0; jb < 5; ++jb) {
        const int kp0 = kb0 + 32 * jb;
        if (kp0 >= 0) {
#pragma unroll
            for (int st = 0; st < 2; ++st) {
                union { bf16x8 v; unsigned u[4]; } pf;
#pragma unroll
                for (int j = 0; j < 4; ++j) pf.u[j] = cvt_pk_bf16(s[jb][8 * st + 2 * j], s[jb][8 * st + 2 * j + 1]);
#pragma unroll
                for (int db = 0; db < 2; ++db) {
                    o[db] = MFMA32(vfr[jb][st][db], pf.v, o[db]);
                }
            }
        }
    }
    float sq = 0.f;
#pragma unroll
    for (int db = 0; db < 2; ++db)
#pragma unroll
        for (int ig = 0; ig < 4; ++ig) {
            const float v0 = o[db][4 * ig] * inv, v1 = o[db][4 * ig + 1] * inv, v2 = o[db][4 * ig + 2] * inv, v3 = o[db][4 * ig + 3] * inv;
            sq += (v0 * v0 + v1 * v1) + (v2 * v2 + v3 * v3);
            if (r < nq) { u32x2 w; w.x = cvt_pk_bf16(v0, v1); w.y = cvt_pk_bf16(v2, v3); *(u32x2*)(YA + (size_t)qrow * 512 + h * 64 + db * 32 + 8 * ig + 4 * hf) = w; }
        }
    sq += __shfl_xor(sq, 32);
    if (hf == 0 && r < nq) ssqT[(size_t)qrow * 8 + h] = sq;
}

__device__ __forceinline__ void attn_phase(int l, int wave, int lane) {
    unsigned char* ws = kws();
    const bf16_t* QB = (const bf16_t*)(ws + WS_HB + SZ_512); bf16_t* YA = (bf16_t*)(ws + WS_HB + 4 * SZ_512);
    const bf16_t* KP = (const bf16_t*)(ws + WS_KP); const bf16_t* VTP = (const bf16_t*)(ws + WS_VTP);
    const bf16_t* KS = (const bf16_t*)(ws + WS_KS); const bf16_t* VTS = (const bf16_t*)(ws + WS_VTS);
    float* ssqT = (float*)(ws + WS_SSQ + 4 * SZ_SSQ16 + SZ_SSQ8);
    const int h = wave, kvh = h >> 2; const float sink = kin(24)[l * 8 + h];
    const int c = (int)blockIdx.x; const bool deal = (gridDim.x == 256);
    for (int k = 0; k < 640; ++k) {
        int bu;
        if (deal) { if (c >= 128) { if (k < 3) bu = 3 * (c - 128) + k; else break; } else { if (k < 2) bu = 384 + 2 * c + k; else break; } }
        else { bu = c + k * (int)gridDim.x; if (bu >= 512 + DB) break; }
        if (bu < 512) { const int b = bu >> 6, q0 = (bu & 63) * 32;
            attn_wave(QB, KP + (size_t)b * SEQ * 128 + kvh * 64, VTP + (size_t)(b * 2 + kvh) * 64 * 2048, 2048, b * SEQ + q0, 32, q0, sink, YA, ssqT, h, lane);
        } else { const int sb = bu - 512;
            attn_wave(QB, KS + (size_t)(l * DB + sb) * 160 * 128 + kvh * 64, VTS + (size_t)((l * DB + sb) * 2 + kvh) * 64 * 160, 160, MP + sb * 8, 8, 128, sink, YA, ssqT, h, lane);
        }
    }
}

#define XB_TMO      128
#define XB_XCNT(j)  (256  + 64 * (j))
#define XB_XSUB(j)  (1280 + 64 * (j))
#define XB_XGEN(j)  (2304 + 64 * (j))
#define XB_TOP      3328
#define XB_TOPGEN   3392
#define XCD_BAR_WORDS 3456
#define XB_SPIN_CAP (1u << 18)
#define LAS __attribute__((address_space(3)))

__device__ __forceinline__ unsigned xb_ld(unsigned* p)              { return __hip_atomic_load(p, __ATOMIC_RELAXED, __HIP_MEMORY_SCOPE_AGENT); }
__device__ __forceinline__ unsigned xb_add(unsigned* p, unsigned v) { return __hip_atomic_fetch_add(p, v, __ATOMIC_RELAXED, __HIP_MEMORY_SCOPE_AGENT); }
__device__ __forceinline__ unsigned xb_xcc_id() { return (unsigned)__builtin_amdgcn_s_getreg((3 << 11) | 20) & 0xFu; }
#define XB_SPIN(cond, bar) do { unsigned _sp = 0; while (cond) { __builtin_amdgcn_s_sleep(1); \
    if ((++_sp & 255u) == 0u) { if (xb_ld(&(bar)[XB_TMO])) break; if (_sp > XB_SPIN_CAP) { atomicAdd(&(bar)[XB_TMO], 1u); break; } } } } while (0)

struct XcdBarrier {
    unsigned* bar; unsigned x;
    volatile LAS unsigned* st;
};

__device__ __forceinline__ XcdBarrier xcd_barrier_post(unsigned* bar, volatile LAS unsigned* st) {
    XcdBarrier b; b.bar = bar; b.x = xb_xcc_id(); b.st = st;
    if (threadIdx.x == 0) (void)xb_add(&bar[XB_XCNT(b.x)], 1u);
    return b;
}
__device__ __forceinline__ void xcd_barrier_complete(unsigned* bar, unsigned x, unsigned& nloc, unsigned& nx) {
    const unsigned G = gridDim.x * gridDim.y * gridDim.z;
    unsigned sum, cnt, mine, sp = 0u;
    for (;;) {
        sum = 0u; cnt = 0u; mine = 0u;
#pragma unroll
        for (unsigned j = 0; j < 16; ++j) { const unsigned c = xb_ld(&bar[XB_XCNT(j)]); sum += c; cnt += (c > 0u) ? 1u : 0u; mine = (j == x) ? c : mine; }
        if (sum == G) break;
        __builtin_amdgcn_s_sleep(1);
        if ((++sp & 255u) == 0u) { if (xb_ld(&bar[XB_TMO])) break; if (sp > XB_SPIN_CAP) { atomicAdd(&bar[XB_TMO], 1u); break; } }
    }
    nloc = mine > 0u ? mine : 1u; nx = cnt > 0u ? cnt : 1u;
}

__device__ __forceinline__ void xcd_barrier(const XcdBarrier& b) {
    asm volatile("s_waitcnt vmcnt(0)" ::: "memory");
    __syncthreads();
    if (pg8::tid_from_lds((const volatile LAS unsigned*)(b.st + 4)) == 0) {
        unsigned* bar = b.bar;
        __builtin_amdgcn_s_waitcnt(0);
        unsigned nloc = b.st[0], nx = b.st[1];
        if (nloc == 0u) { xcd_barrier_complete(bar, b.x, nloc, nx); b.st[0] = nloc; b.st[1] = nx; }
        const unsigned old = xb_add(&bar[XB_XSUB(b.x)], 1u);
        const unsigned gen = old / nloc;
        if (old + 1u == (gen + 1u) * nloc) {
            __builtin_amdgcn_fence(__ATOMIC_RELEASE, "agent");
            asm volatile("s_waitcnt vmcnt(0)" ::: "memory");
            const unsigned og = xb_add(&bar[XB_TOP], 1u);
            const unsigned tg = og / nx;
            if (og + 1u == (tg + 1u) * nx) xb_add(&bar[XB_TOPGEN], 1u);
            else XB_SPIN(xb_ld(&bar[XB_TOPGEN]) == tg, bar);
            __builtin_amdgcn_fence(__ATOMIC_ACQUIRE, "agent");
            xb_add(&bar[XB_XGEN(b.x)], 1u);
            asm volatile("s_waitcnt vmcnt(0)" ::: "memory");
        } else {
            XB_SPIN(xb_ld(&bar[XB_XGEN(b.x)]) == gen, bar);
            __builtin_amdgcn_fence(__ATOMIC_ACQUIRE, "agent");
            asm volatile("s_waitcnt vmcnt(0)" ::: "memory");
        }
    }
    __syncthreads();
}

__device__ __forceinline__ void gbar(unsigned char* lds) {
    XcdBarrier b; b.bar = (unsigned*)(kws() + WS_BAR); b.x = xb_xcc_id(); b.st = (volatile LAS unsigned*)(lds + ST_OFF);
    xcd_barrier(b);
}
#define PH_BEGIN unsigned char* ws = kws(); float* out = kout(); (void)out; \
    bf16_t* XBa = (bf16_t*)(ws + WS_XB0); bf16_t* XBb = (bf16_t*)(ws + WS_XB1); bf16_t* HB = (bf16_t*)(ws + WS_HB); (void)XBa; (void)XBb; (void)HB; \
    const bf16_t* WL = (const bf16_t*)(ws + WS_W) + (size_t)l * E_WLAYER; (void)WL; \
    float* ssq0 = (float*)(ws + WS_SSQ); float* ssq1 = (float*)(ws + WS_SSQ + SZ_SSQ16); float* ssq2 = (float*)(ws + WS_SSQ + 2 * SZ_SSQ16); float* ssq3 = (float*)(ws + WS_SSQ + 3 * SZ_SSQ16); \
    float* ssqS = (float*)(ws + WS_SSQ + 4 * SZ_SSQ16); float* ssqT = (float*)(ws + WS_SSQ + 4 * SZ_SSQ16 + SZ_SSQ8); (void)ssq0; (void)ssq1; (void)ssq2; (void)ssq3; (void)ssqS; (void)ssqT;

__global__ void __launch_bounds__(512, 2) mega_fwd(Args a_unused) {
    extern __shared__ __attribute__((aligned(16))) unsigned char lds[];
    cg::grid_group grid = cg::this_grid();
    if (gridDim.x == 0x7fffffffu) grid.sync();
    if (threadIdx.x < 4) ((volatile LAS unsigned*)(lds + ST_OFF))[threadIdx.x] = 0u;
    if ((threadIdx.x & 63) == 0) ((volatile LAS unsigned*)(lds + ST_OFF + 16))[(unsigned)__builtin_amdgcn_s_getreg((5 << 11) | 4) & 63u] = threadIdx.x >> 6;
    __syncthreads();
    (void)xcd_barrier_post((unsigned*)(kws() + WS_BAR), (volatile LAS unsigned*)(lds + ST_OFF));
    {
        int tid = MYTID(); asm volatile("" : "+v"(tid)); const int lane = tid & 63, wave = __builtin_amdgcn_readfirstlane(tid >> 6);
        p0_phase(lds, wave, lane);
    }
    gbar(lds);
#pragma nounroll
    for (int l = 0; l < NL; ++l) {
        { PH_BEGIN EpiSwiglu E{HB, ssq0}; run_gemm(lds, XBa, WL + OW_GU1, 2 * FF, D, E, M); }
        if (l == 0 && bid() >= 216) { int tid = MYTID(); asm volatile("" : "+v"(tid)); const int lane = tid & 63, wave = __builtin_amdgcn_readfirstlane(tid >> 6);
            conv_weights(lds, wave, lane, 0, 2 * 16 * 88, 3 * 16 * 88, (bid() - 216) * 8 + wave, (gdim() - 216) * 8); }
        gbar(lds);
        { PH_BEGIN EpiRes<0, true> E{XBa, XBb, ssq1, nullptr, nullptr}; run_gemm(lds, HB, WL + OW_D1, D, FF, E); }
        { PH_BEGIN SMALL(1, 16, 0, {HB, FF, WL + OW_D1, FF, l, 1, 1, 0, 0, 0}) }
        { int tid = MYTID(); asm volatile("" : "+v"(tid)); const int lane = tid & 63, wave = __builtin_amdgcn_readfirstlane(tid >> 6);
          if (l == 0) { conv_weights(lds, wave, lane, 0, 3 * 16 * 88, I_LAYER_ALL, bid() * 8 + wave, gdim() * 8); p0_misc(wave, lane, bid(), gdim()); }
        }
        gbar(lds);
        { PH_BEGIN EpiIn E{HB, (bf16_t*)(ws + WS_HB + SZ_512), (bf16_t*)(ws + WS_KP), (bf16_t*)(ws + WS_VTP), (bf16_t*)(ws + WS_KS), (bf16_t*)(ws + WS_VTS), ssq1, out + O_KP, out + O_VP, out + O_KS, out + O_VS, l};
          run_gemm(lds, XBb, WL + OW_IN, INW, D, E, M); }
        if (l + 1 < NL && bid() >= 84) { int tid = MYTID(); asm volatile("" : "+v"(tid)); const int lane = tid & 63, wave = __builtin_amdgcn_readfirstlane(tid >> 6);
            conv_weights(lds, wave, lane, l + 1, 0, I_LAYER_ALL, (bid() - 84) * 8 + wave, (gdim() - 84) * 8); }
        if (l + 1 == NL && bid() >= 84) {
            { PH_BEGIN EpiBf E{(bf16_t*)out, D}; run_gemm(lds, (const bf16_t*)(ws + WS_PB) + (size_t)l * M * 256, WL + OW_PP, D, 256, E, MP, 84); }
            { PH_BEGIN SMALL(4, 16, 84, {(const bf16_t*)(ws + WS_PB) + (size_t)l * M * 256, 256, WL + OW_PP, 256, l, 0, 0, 0, 0, 0}) } }
        gbar(lds);
        {
            int tid = MYTID(); asm volatile("" : "+v"(tid)); const int lane = tid & 63, wave = __builtin_amdgcn_readfirstlane(tid >> 6);
            ssm_phase(lds, l, wave, lane);
        }
        gbar(lds);
        { PH_BEGIN const bf16_t* YG = (const bf16_t*)(ws + WS_HB + 2 * SZ_512); EpiGlu E{YG, (bf16_t*)(ws + WS_HB + 3 * SZ_512), ssqS}; run_gemm(lds, YG, WL + OW_GLU, 512, 512, E); }
        { PH_BEGIN SMALL(3, 8, 128, {(const bf16_t*)(ws + WS_HB + 2 * SZ_512), 512, WL + OW_GLU, 512, l, 0, 0, 0, 0, 0}) }
        {
            int tid = MYTID(); asm volatile("" : "+v"(tid)); const int lane = tid & 63, wave = __builtin_amdgcn_readfirstlane(tid >> 6);
            attn_phase(l, wave, lane);
        }
        gbar(lds);
        { PH_BEGIN SMALL(1, 16, 0, {(const bf16_t*)(ws + WS_HB + 3 * SZ_512), 512, WL + OW_OA, 512, l, 0, -1, 0, 1, 1}) }
        { PH_BEGIN EpiRes<1, true> E{XBb, XBa, ssq2, ssqT, (const bf16_t*)ssqS};
          run_gemm2(lds, (const bf16_t*)(ws + WS_HB + 3 * SZ_512), WL + OW_OA, (const bf16_t*)(ws + WS_HB + 4 * SZ_512), WL + OW_OB, D, 512, E); }
        { PH_BEGIN SMALL(1, 16, 0, {(const bf16_t*)(ws + WS_HB + 4 * SZ_512), 512, WL + OW_OB, 512, l, 0, 2, 1, 1, 0}) }
        gbar(lds);
        { PH_BEGIN EpiSwiglu E{HB, ssq2}; run_gemm(lds, XBa, WL + OW_GU2, 2 * FF, D, E, M); }
        gbar(lds);
        { PH_BEGIN EpiRes<0, true> E{XBa, XBb, ssq3, nullptr, nullptr}; run_gemm(lds, HB, WL + OW_D2, D, FF, E); }
        { PH_BEGIN SMALL(1, 16, 0, {HB, FF, WL + OW_D2, FF, l, 1, 3, 0, 0, 0}) }
        if (l + 1 < NL) {
            { PH_BEGIN EpiBf E{(bf16_t*)out, D}; run_gemm(lds, (const bf16_t*)(ws + WS_PB) + (size_t)l * M * 256, WL + OW_PP, D, 256, E); }
            { PH_BEGIN SMALL(4, 16, 0, {(const bf16_t*)(ws + WS_PB) + (size_t)l * M * 256, 256, WL + OW_PP, 256, l, 0, 0, 0, 0, 0}) } }
        gbar(lds);
        { PH_BEGIN EpiRes<2, true> E{XBb, XBa, ssq0, ssq3, (const bf16_t*)out}; run_gemm(lds, XBb, WL + OW_PG, D, D, E); }
        { PH_BEGIN SMALL(1, 16, 0, {XBb, D, WL + OW_PG, D, l, 0, 0, 3, 2, 1}) }
        gbar(lds);
    }
    {
        int tid = MYTID(); asm volatile("" : "+v"(tid)); const int lane = tid & 63, wave = __builtin_amdgcn_readfirstlane(tid >> 6);
        unsigned char* ws = kws(); float* out = kout(); const float* ssq0 = (const float*)(ws + WS_SSQ); const bf16_t* XBa = (const bf16_t*)(ws + WS_XB0);
        const float* gfin = kin(34);
        for (int m = bid() * 8 + wave; m < M; m += gdim() * 8) {
            float t = (lane < 16) ? ssq0[(size_t)m * 16 + lane] : 0.f; t = wave_sum(t);
            const float rs = __builtin_amdgcn_rsqf(t * (1.f / 1024.f) + 1e-6f);
#pragma unroll
            for (int j = 0; j < 2; ++j) {
                const int c = 512 * j + 8 * lane; const u32x4 xw = *(const u32x4*)(XBa + (size_t)m * D + c);
                const f32x4 g0 = *(const f32x4*)(gfin + c), g1 = *(const f32x4*)(gfin + c + 4);
                f32x4 y0 = {bflo(xw.x), bfhi(xw.x), bflo(xw.y), bfhi(xw.y)}, y1 = {bflo(xw.z), bfhi(xw.z), bflo(xw.w), bfhi(xw.w)};
                y0 = y0 * rs * g0; y1 = y1 * rs * g1;
                *(f32x4*)(out + (size_t)m * D + c) = y0; *(f32x4*)(out + (size_t)m * D + c + 4) = y1;
            }
        }
    }
}

extern "C" void kernel_launch(void* const* d_in, const int* in_sizes, int n_in, void* d_out, int out_size, void* d_ws, size_t ws_size, hipStream_t stream) {
    static int grid_blocks = 0;
    if (!grid_blocks) {
        int dev = 0, cus = 0, per_cu = 0;
        hipGetDevice(&dev);
        hipDeviceGetAttribute(&cus, hipDeviceAttributeMultiprocessorCount, dev);
        hipFuncSetAttribute((const void*)mega_fwd, hipFuncAttributeMaxDynamicSharedMemorySize, LDS_BYTES);
        hipOccupancyMaxActiveBlocksPerMultiprocessor(&per_cu, (const void*)mega_fwd, 512, LDS_BYTES);
        if (per_cu < 1) per_cu = 1;
        if (cus < 1) cus = 256;
        grid_blocks = cus * per_cu;
        if (ws_size < WS_END) fprintf(stderr, "kernel_launch: workspace too small: %zu < %zu\n", ws_size, (size_t)WS_END);
    }
    if (hipMemsetAsync((char*)d_ws + WS_BAR, 0, 16384, stream) != hipSuccess) fprintf(stderr, "memset failed\n");
    Args a{};
    for (int i = 0; i < NIN; ++i) a.in[i] = (const float*)d_in[i];
    a.out = (float*)d_out; a.ws = (unsigned char*)d_ws;
    void* args[] = {&a};
    hipError_t e = hipLaunchCooperativeKernel((const void*)mega_fwd, dim3(grid_blocks), dim3(512), args, LDS_BYTES, stream);
    if (e != hipSuccess) fprintf(stderr, "cooperative launch failed: %s (grid %d)\n", hipGetErrorString(e), grid_blocks);
}
```

```cpp
#include <hip/hip_runtime.h>
#include <hip/hip_cooperative_groups.h>
#include <cstdio>
#include <cstdint>
namespace pg8 {
#define PG8_LAS __attribute__((address_space(3)))
typedef unsigned short bf16_t;
typedef short bf16x8 __attribute__((ext_vector_type(8)));
typedef float f32x4 __attribute__((ext_vector_type(4)));
typedef unsigned u32x4 __attribute__((ext_vector_type(4)));
constexpr int BM = 256, BK = 64, HALF = 128, HTB = HALF * BK * 2  , STAGE_BYTES = 8 * HTB, NXCD = 8, WGM = 8;

__host__ __device__ __forceinline__ int lds_byte(int r, int c) { const int st = (r >> 4) * 2 + (c >> 5), rr = r & 15, cc = c & 31, ob = rr * 64 + cc * 2; return st * 1024 + (ob ^ (((ob >> 9) & 1) << 5)); }
__host__ __device__ __forceinline__ void stage_rc(int b, int& R, int& C) { const int st = b / 1024, sb = b % 1024, swz = sb ^ (((sb >> 9) & 1) << 5); R = (st >> 1) * 16 + swz / 64; C = (st & 1) * 32 + (swz % 64) / 2; }
__host__ __device__ __forceinline__ int perm32(int rho) { const int n = rho >> 4, i = rho & 15; return 8 * (i >> 2) + 4 * n + (i & 3); }

struct Unit { int pm, pn, seg; };
struct Gemm { const bf16_t* A; const bf16_t* Bt; int M, N, K; const bf16_t* A2; const bf16_t* Bt2; };

struct StaticOrder {
    int nM, nN, nwg, G, c;
    __host__ __device__ void init(int M, int N, int G_, int c_) { nM = M / BM; nN = N / BM; nwg = nM * nN; G = G_; c = c_; }
    __host__ __device__ bool next(int i, Unit& u) const {
        const long L = (long)i * G + c; if (L >= nwg) return false;
        int wgid = (int)L; { const int q = nwg / NXCD, r = nwg % NXCD, xcd = wgid % NXCD, off = wgid / NXCD; wgid = (xcd < r ? xcd * (q + 1) : r * (q + 1) + (xcd - r) * q) + off; }
        const int nig = WGM * nN, gid = wgid / nig, fm = gid * WGM, gsz = (nM - fm) < WGM ? (nM - fm) : WGM;
        u.pm = fm + ((wgid % nig) % gsz); u.pn = (wgid % nig) / gsz; u.seg = 0; return true;
    }
    __device__ __forceinline__ void a_ready(const Unit&) const {}
    __device__ __forceinline__ void done(const Unit&) const {}
};
__device__ __forceinline__ unsigned cvt_pk_bf16(float lo, float hi) { unsigned r; asm volatile("v_cvt_pk_bf16_f32 %0, %1, %2" : "=v"(r) : "v"(lo), "v"(hi)); return r; }
typedef float f32x2 __attribute__((ext_vector_type(2)));
__device__ __forceinline__ int tid_from_lds(const volatile PG8_LAS unsigned* tidtab) {
    const unsigned slot = (unsigned)__builtin_amdgcn_s_getreg((5 << 11) | 4) & 63u;
    const int w = __builtin_amdgcn_readfirstlane((int)tidtab[slot]);
    int ln; asm volatile("v_mbcnt_lo_u32_b32 %0, -1, 0\n\tv_mbcnt_hi_u32_b32 %0, -1, %0" : "=v"(ln));
    return w * 64 + ln;
}
constexpr int TIDTAB_OFF = 131072 + 4096 + 16;
struct TwoSegOrder : StaticOrder {
    __host__ __device__ bool next(int i, Unit& u) const { if (!StaticOrder::next(i >> 1, u)) return false; u.seg = i & 1; return true; }
};
template <class Epi, class Sched, bool STAMP = false>
__device__ __forceinline__ void gemm_phase(PG8_LAS unsigned char* lds, const Gemm g, const Sched& S, const Epi& E, unsigned long long* stamps) {
    int tid_l = tid_from_lds((const volatile PG8_LAS unsigned*)(lds + TIDTAB_OFF)); asm volatile("" : "+v"(tid_l)); const int tid = tid_l, wid = __builtin_amdgcn_readfirstlane(tid >> 6), lane = tid & 63, wr = wid >> 2, wc = wid & 3, fr = lane & 15, fq = lane >> 4;
    const int K = g.K, nt = K / BK;
    int ts_lo = 0, ts_hi = 0, nts = 0; const unsigned long long rt_entry = STAMP ? (unsigned long long)wall_clock64() : 0ull;
#define PG8_STAMP() do { if (STAMP && wid == 0 && nts < 64) { const unsigned long long _c = (unsigned long long)clock64(); \
        ts_lo = (lane == nts) ? (int)(unsigned)_c : ts_lo; ts_hi = (lane == nts) ? (int)(unsigned)(_c >> 32) : ts_hi; ++nts; } } while (0)
    PG8_STAMP();
    unsigned voffA[2], voffB[2];
#pragma unroll
    for (int i = 0; i < 2; ++i) { int R, C; stage_rc(tid * 16 + i * 8192, R, C); const int Rb = Epi::PERM ? ((R & ~31) + perm32(R & 31)) : R;
        voffA[i] = (unsigned)(R * K + C) * 2u; voffB[i] = (unsigned)(Rb * K + C) * 2u; }
    const size_t kstep = (size_t)(BK * 2);
    const size_t hstep = (size_t)HALF * K * 2;
    const size_t tstep = 2 * hstep;
    const unsigned ldsw = (unsigned)wid * 1024u;
    const int aoff = lds_byte(wr * 64 + fr, fq * 8), boff = lds_byte(wc * 32 + fr, fq * 8);
#define PG8_SA(b, h) (((b) * 2 + (h)) * HTB)
#define PG8_SB(b, h) ((4 + (b) * 2 + (h)) * HTB)
#define PG8_STAGE(bufoff, gbase, voff) do { _Pragma("unroll") for (int _i = 0; _i < 2; ++_i) \
        __builtin_amdgcn_global_load_lds((const unsigned*)((const char*)(gbase) + (voff)[_i]), (PG8_LAS unsigned*)(lds + (bufoff) + ldsw + _i * 8192), 16, 0, 0); } while (0)
#define PG8_LDA(dst, b, h) do { _Pragma("unroll") for (int m = 0; m < 4; ++m) _Pragma("unroll") for (int k = 0; k < 2; ++k) dst[m][k] = *(const PG8_LAS bf16x8*)(lds + PG8_SA(b, h) + aoff + m * 2048 + k * 1024); } while (0)
#define PG8_LDB(dst, b, h) do { _Pragma("unroll") for (int n = 0; n < 2; ++n) _Pragma("unroll") for (int k = 0; k < 2; ++k) dst[n][k] = *(const PG8_LAS bf16x8*)(lds + PG8_SB(b, h) + boff + n * 2048 + k * 1024); } while (0)
#define PG8_MMA(ai, bj, At, Bt) do { __builtin_amdgcn_s_setprio(1); _Pragma("unroll") for (int m = 0; m < 4; ++m) _Pragma("unroll") for (int n = 0; n < 2; ++n) _Pragma("unroll") for (int k = 0; k < 2; ++k) \
        acc[ai][bj][m][n] = __builtin_amdgcn_mfma_f32_16x16x32_bf16(Bt[n][k], At[m][k], acc[ai][bj][m][n], 0, 0, 0); __builtin_amdgcn_s_setprio(0); } while (0)
#define PG8_WAIT_V(n) asm volatile("s_waitcnt vmcnt(" #n ")" ::: "memory")
#define PG8_WAIT_L(n) asm volatile("s_waitcnt lgkmcnt(" #n ")" ::: "memory")
#define PG8_BAR __builtin_amdgcn_s_barrier()
#define PG8_SCHED __builtin_amdgcn_sched_barrier(0)
    Unit cur, nxt; int ui = 0;
    if (!S.next(0, cur)) return;
    f32x4 acc[2][2][4][2];
#pragma unroll
    for (int a = 0; a < 2; ++a)
#pragma unroll
        for (int b = 0; b < 2; ++b)
#pragma unroll
            for (int m = 0; m < 4; ++m)
#pragma unroll
                for (int n = 0; n < 2; ++n) acc[a][b][m][n] = (f32x4){0.f, 0.f, 0.f, 0.f};
    bf16x8 At[4][2], B0[2][2], B1[2][2];
    const char* cA = (const char*)(cur.seg ? g.A2 : g.A) + (size_t)cur.pm * tstep; const char* cB = (const char*)(cur.seg ? g.Bt2 : g.Bt) + (size_t)cur.pn * tstep;
    S.a_ready(cur);
    PG8_STAGE(PG8_SB(0, 0), cB, voffB); PG8_STAGE(PG8_SB(0, 1), cB + hstep, voffB); PG8_STAGE(PG8_SA(0, 0), cA, voffA); PG8_STAGE(PG8_SA(0, 1), cA + hstep, voffA);
    if (wr == 1) PG8_BAR;
    PG8_WAIT_V(2); PG8_BAR;
    PG8_STAGE(PG8_SB(1, 0), cB + kstep, voffB); PG8_STAGE(PG8_SA(1, 0), cA + kstep, voffA); PG8_STAGE(PG8_SB(1, 1), cB + hstep + kstep, voffB);
    PG8_WAIT_V(6); PG8_BAR;
    PG8_STAMP();
    for (;;) {
        const bool has_next = S.next(ui + 1, nxt);
        const char* nA = has_next ? (const char*)(nxt.seg ? g.A2 : g.A) + (size_t)nxt.pm * tstep : cA; const char* nB = has_next ? (const char*)(nxt.seg ? g.Bt2 : g.Bt) + (size_t)nxt.pn * tstep : cB;
        for (int t = 0; t < nt; t += 2) {
            const bool last = (t == nt - 2);
            const char* a1 = cA + (size_t)(t + 1) * kstep;
            const char* a2 = last ? nA : cA + (size_t)(t + 2) * kstep; const char* b2 = last ? nB : cB + (size_t)(t + 2) * kstep;
            const char* a3 = a2 + kstep; const char* b3 = b2 + kstep;
            if (last && has_next) S.a_ready(nxt);
            PG8_LDB(B0, 0, 0); PG8_LDB(B1, 0, 1); PG8_SCHED; PG8_LDA(At, 0, 0); PG8_STAGE(PG8_SA(1, 1), a1 + hstep, voffA);
            PG8_WAIT_V(8); PG8_WAIT_L(0); PG8_BAR; PG8_MMA(0, 0, At, B0); PG8_MMA(0, 1, At, B1); PG8_BAR; PG8_SCHED;
            PG8_LDA(At, 0, 1); PG8_STAGE(PG8_SB(0, 0), b2, voffB); PG8_STAGE(PG8_SB(0, 1), b2 + hstep, voffB); PG8_STAGE(PG8_SA(0, 0), a2, voffA);
            PG8_WAIT_V(8); PG8_WAIT_L(0); PG8_BAR; PG8_MMA(1, 0, At, B0); PG8_MMA(1, 1, At, B1); PG8_BAR; PG8_SCHED;
            PG8_LDB(B0, 1, 0); PG8_LDB(B1, 1, 1); PG8_SCHED; PG8_LDA(At, 1, 0); PG8_STAGE(PG8_SA(0, 1), a2 + hstep, voffA);
            PG8_WAIT_V(8); PG8_WAIT_L(0); PG8_BAR; PG8_MMA(0, 0, At, B0); PG8_MMA(0, 1, At, B1); PG8_BAR; PG8_SCHED;
            PG8_LDA(At, 1, 1); PG8_STAGE(PG8_SB(1, 0), b3, voffB); PG8_STAGE(PG8_SB(1, 1), b3 + hstep, voffB); PG8_STAGE(PG8_SA(1, 0), a3, voffA);
            PG8_WAIT_V(8); PG8_WAIT_L(0); PG8_BAR; PG8_MMA(1, 0, At, B0); PG8_MMA(1, 1, At, B1); PG8_BAR; PG8_SCHED;
        }
        PG8_STAMP();
        if (wr == 0) PG8_BAR;
        bool keep = false;
        int t2 = tid_from_lds((const volatile PG8_LAS unsigned*)(lds + TIDTAB_OFF)); asm volatile("" : "+v"(t2));
        const int wid2 = __builtin_amdgcn_readfirstlane(t2 >> 6), ln2 = t2 & 63, wr2 = wid2 >> 2, wc2 = wid2 & 3, fr2 = ln2 & 15, fq2 = ln2 >> 4;
        if constexpr (Epi::TWOSEG) { if (cur.seg == 0) { E.between(acc, cur, wr2, wc2, fr2, fq2); keep = true; } }
        if constexpr (!Epi::AFTER_DRAIN) { if (!keep) { E(acc, cur, wr2, wc2, fr2, fq2); S.done(cur); } }
        PG8_STAMP();
        if (!has_next) break;
        if (!keep) {
#pragma unroll
        for (int a = 0; a < 2; ++a)
#pragma unroll
            for (int b = 0; b < 2; ++b)
#pragma unroll
                for (int m = 0; m < 4; ++m)
#pragma unroll
                    for (int n = 0; n < 2; ++n) acc[a][b][m][n] = (f32x4){0.f, 0.f, 0.f, 0.f};
        }
        cur = nxt; cA = nA; cB = nB; ++ui;
        if (wr == 1) PG8_BAR;
    }
    PG8_WAIT_V(0);
    PG8_BAR;
    if constexpr (Epi::AFTER_DRAIN) { E.fused(acc, cur, wr, wc, fr, fq, lds, wid, lane); S.done(cur); }
    PG8_STAMP();
    if (STAMP && wid == 0) { stamps[lane] = lane < nts ? (((unsigned long long)(unsigned)ts_hi << 32) | (unsigned)ts_lo) : 0ull;
        if (lane == 62) stamps[62] = rt_entry; if (lane == 63) stamps[63] = (unsigned long long)wall_clock64(); }
#undef PG8_STAMP
#undef PG8_SA
#undef PG8_SB
#undef PG8_STAGE
#undef PG8_LDA
#undef PG8_LDB
#undef PG8_MMA
#undef PG8_WAIT_V
#undef PG8_WAIT_L
#undef PG8_BAR
#undef PG8_SCHED
}
}

namespace cg = cooperative_groups;
using pg8::bf16_t; using pg8::bf16x8; using pg8::f32x4; using pg8::u32x4; using pg8::Unit; using pg8::cvt_pk_bf16;
typedef float f32x16 __attribute__((ext_vector_type(16)));
typedef unsigned u32x2 __attribute__((ext_vector_type(2)));
typedef float f32x2s __attribute__((ext_vector_type(2)));

constexpr int D = 1024, MP = 16384, MSM = 1024, M = MP + MSM, FF = 2816, INW = 1280;
constexpr int NL = 2, SEQ = 2048, NB = 8, DB = 128;
constexpr int ST_OFF = 131072 + 4096, LDS_BYTES = ST_OFF + 16 + 256;
static_assert(pg8::TIDTAB_OFF == ST_OFF + 16, "tid table offset");
#define MYTID() pg8::tid_from_lds((const volatile LAS unsigned*)(lds + ST_OFF + 16))
constexpr int NIN = 35;

constexpr size_t E_WGU = (size_t)2 * FF * D, E_WD = (size_t)D * FF, E_WIN = (size_t)INW * D, E_WGLU = 512 * 512, E_WO = 1024 * 512, E_WPG = 1024 * 1024, E_WPP = 1024 * 256;
constexpr size_t OW_GU1 = 0, OW_D1 = OW_GU1 + E_WGU, OW_IN = OW_D1 + E_WD, OW_GLU = OW_IN + E_WIN, OW_OA = OW_GLU + E_WGLU, OW_OB = OW_OA + E_WO,
                 OW_GU2 = OW_OB + E_WO, OW_D2 = OW_GU2 + E_WGU, OW_PG = OW_D2 + E_WD, OW_PP = OW_PG + E_WPG, E_WLAYER = OW_PP + E_WPP;
constexpr size_t WS_W = 0;
constexpr size_t WS_XB0 = WS_W + 2 * E_WLAYER * 2;
constexpr size_t WS_XB1 = WS_XB0 + (size_t)M * D * 2;
constexpr size_t WS_HB = WS_XB1 + (size_t)M * D * 2;
constexpr size_t SZ_512 = (size_t)M * 512 * 2;
constexpr size_t WS_KP = WS_HB + (size_t)M * FF * 2;
constexpr size_t WS_VTP = WS_KP + (size_t)MP * 128 * 2;
constexpr size_t WS_KS = WS_VTP + (size_t)MP * 128 * 2;
constexpr size_t WS_VTS = WS_KS + (size_t)NL * DB * 160 * 128 * 2;
constexpr size_t WS_PB = WS_VTS + (size_t)NL * DB * 160 * 128 * 2;
constexpr size_t WS_SSQ = WS_PB + (size_t)NL * M * 256 * 2;
constexpr size_t SZ_SSQ16 = (size_t)M * 16 * 4, SZ_SSQ8 = (size_t)M * 8 * 4;
constexpr size_t WS_TAB = WS_SSQ + 4 * SZ_SSQ16 + 2 * SZ_SSQ8;
constexpr size_t TAB_BB = 0, TAB_CM = 131072, TAB_AR = 262144, TAB_AI = TAB_AR + 8192, TAB_A2R = TAB_AI + 8192, TAB_A2I = TAB_A2R + 8192, TAB_LAYER = TAB_A2I + 8192;
constexpr size_t WS_BAR = WS_TAB + NL * TAB_LAYER;
constexpr size_t WS_END = WS_BAR + 16384;

constexpr size_t O_Y = 0, O_KP = (size_t)M * D, O_VP = O_KP + (size_t)NL * NB * 128 * 128, O_HPR = O_VP + (size_t)NL * NB * 128 * 128, O_HPI = O_HPR + (size_t)NL * NB * 32 * 64,
                 O_KS = O_HPI + (size_t)NL * NB * 32 * 64, O_VS = O_KS + (size_t)NL * DB * 128 * 128, O_HSR = O_VS + (size_t)NL * DB * 128 * 128, O_HSI = O_HSR + (size_t)NL * DB * 32 * 64;

struct Args { const float* in[NIN]; float* out; unsigned char* ws; };
typedef const __attribute__((address_space(4))) unsigned long long* kargp_t;
__device__ __forceinline__ kargp_t kbase() { kargp_t p = (kargp_t)__builtin_amdgcn_kernarg_segment_ptr(); asm volatile("" : "+s"(p)); return p; }
__device__ __forceinline__ const float* kin(int i) { return (const float*)kbase()[i]; }
__device__ __forceinline__ float* kout() { return (float*)kbase()[NIN]; }
__device__ __forceinline__ unsigned char* kws() { return (unsigned char*)kbase()[NIN + 1]; }

__device__ __forceinline__ int bid() { int b = (int)blockIdx.x; asm volatile("" : "+s"(b)); return b; }
__device__ __forceinline__ int gdim() { int g = (int)gridDim.x; asm volatile("" : "+s"(g)); return g; }
__device__ __forceinline__ float wave_sum(float v) {
#pragma unroll
    for (int o = 1; o < 64; o <<= 1) v += __shfl_xor(v, o);
    return v;
}
__device__ __forceinline__ float sigm(float x) { return __builtin_amdgcn_rcpf(1.0f + __builtin_amdgcn_exp2f(-1.44269504f * x)); }
__device__ __forceinline__ float silu_f(float x) { return x * sigm(x); }
__device__ __forceinline__ float gelu_tanh(float x) { return x * sigm(1.5957691216f * (x + 0.044715f * x * x * x)); }
__device__ __forceinline__ float bf2f(unsigned short b) { return __uint_as_float(((unsigned)b) << 16); }
__device__ __forceinline__ float bflo(unsigned w) { return __uint_as_float(w << 16); }
__device__ __forceinline__ float bfhi(unsigned w) { return __uint_as_float(w & 0xffff0000u); }
__device__ __forceinline__ unsigned short f2bf(float f) { return (unsigned short)(cvt_pk_bf16(f, 0.f) & 0xffffu); }
__device__ __forceinline__ int vt_idx(int t, int d) { const int u = t & 15; return (t >> 4) * 1024 + d * 16 + (((u >> 2) & 1) << 3) + ((u >> 3) << 2) + (u & 3); }
__device__ __forceinline__ float rs16(const float* ssq, int row) {
    const f32x4* p = (const f32x4*)(ssq + (size_t)row * 16); const f32x4 a = p[0], b = p[1], c = p[2], d = p[3]; const f32x4 s = (a + b) + (c + d);
    return __builtin_amdgcn_rsqf(((s.x + s.y) + (s.z + s.w)) * (1.f / 1024.f) + 1e-6f);
}
__device__ __forceinline__ float rs16c(const float* ssq, int row, int fq) {
    const f32x4 a = *(const f32x4*)(ssq + (size_t)row * 16 + 4 * fq); float s = (a.x + a.y) + (a.z + a.w); s += __shfl_xor(s, 16); s += __shfl_xor(s, 32);
    return __builtin_amdgcn_rsqf(s * (1.f / 1024.f) + 1e-6f);
}
__device__ __forceinline__ float rs8(const float* ssq, int row) {
    const f32x4* p = (const f32x4*)(ssq + (size_t)row * 8); const f32x4 a = p[0], b = p[1]; const f32x4 s = a + b;
    return __builtin_amdgcn_rsqf(((s.x + s.y) + (s.z + s.w)) * (1.f / 512.f) + 1e-6f);
}


struct EpiSwiglu {
    static constexpr bool PERM = true, AFTER_DRAIN = false, TWOSEG = false;
    bf16_t* H; const float* ssq;
    __device__ __forceinline__ void operator()(const f32x4 (&acc)[2][2][4][2], const Unit& u, int wr, int wc, int fr, int fq) const {
        const int row0 = u.pm * 256 + wr * 64 + fr, col0 = u.pn * 128 + wc * 32 + 8 * fq;
#pragma unroll
        for (int ai = 0; ai < 2; ++ai)
#pragma unroll
            for (int m = 0; m < 4; ++m) {
                const int row = row0 + ai * 128 + m * 16; const float rs = rs16c(ssq, row, fq);
                const float c1 = -1.44269504f * rs, c2 = rs * rs;
                unsigned wq[4];
#pragma unroll
                for (int n = 0; n < 2; ++n)
#pragma unroll
                    for (int jp = 0; jp < 2; ++jp) {
                        const f32x2s g = {acc[ai][0][m][n][2 * jp], acc[ai][0][m][n][2 * jp + 1]}, up = {acc[ai][1][m][n][2 * jp], acc[ai][1][m][n][2 * jp + 1]};
                        const f32x2s t = g * c1;
                        f32x2s d = {__builtin_amdgcn_exp2f(t.x), __builtin_amdgcn_exp2f(t.y)}; d = d + 1.0f;
                        const float r = __builtin_amdgcn_rcpf(d.x * d.y);
                        const f32x2s inv = (f32x2s){d.y, d.x} * r;
                        const f32x2s hh = ((g * up) * c2) * inv;
                        wq[n * 2 + jp] = cvt_pk_bf16(hh.x, hh.y);
                    }
                u32x4 w; w.x = wq[0]; w.y = wq[1]; w.z = wq[2]; w.w = wq[3];
                *(u32x4*)(H + (size_t)row * FF + col0) = w;
            }
    }
};

template <int MODE, bool WXB> struct EpiRes {
    static constexpr bool PERM = true, AFTER_DRAIN = false, TWOSEG = (MODE == 1);
    const bf16_t* xin; bf16_t* xb; float* ssq_out; const float* ssq_in; const bf16_t* pp;
    __device__ __forceinline__ void between(f32x4 (&acc)[2][2][4][2], const Unit& u, int wr, int wc, int fr, int fq) const {
        const int row0 = u.pm * 256 + wr * 64 + fr;
#pragma unroll
        for (int ai = 0; ai < 2; ++ai)
#pragma unroll
            for (int m = 0; m < 4; ++m) { const int row = row0 + ai * 128 + m * 16; const float ratio = rs8((const float*)pp, row) / rs8(ssq_in, row);
#pragma unroll
                for (int bj = 0; bj < 2; ++bj)
#pragma unroll
                    for (int n = 0; n < 2; ++n) acc[ai][bj][m][n] *= ratio; }
    }
    __device__ __forceinline__ void operator()(const f32x4 (&acc)[2][2][4][2], const Unit& u, int wr, int wc, int fr, int fq) const {
        const int row0 = u.pm * 256 + wr * 64 + fr, col0 = u.pn * 256 + wc * 32 + 8 * fq;
#pragma unroll
        for (int ai = 0; ai < 2; ++ai)
#pragma unroll
            for (int m = 0; m < 4; ++m) {
                const int row = row0 + ai * 128 + m * 16; float rs = 0.5f;
                if (MODE == 1) rs = rs8(ssq_in, row);
                if (MODE == 2) rs = rs16c(ssq_in, row, fq);
                float s = 0.f;
#pragma unroll
                for (int bj = 0; bj < 2; ++bj) {
                    const size_t off = (size_t)row * D + col0 + bj * 128;
                    const u32x4 xw = *(const u32x4*)(xin + off); const f32x4 a0 = acc[ai][bj][m][0], a1 = acc[ai][bj][m][1];
                    float xv[8] = {bflo(xw.x), bfhi(xw.x), bflo(xw.y), bfhi(xw.y), bflo(xw.z), bfhi(xw.z), bflo(xw.w), bfhi(xw.w)};
                    const float av[8] = {a0.x, a0.y, a0.z, a0.w, a1.x, a1.y, a1.z, a1.w};
                    if (MODE == 2) {
                        const u32x4 pw = *(const u32x4*)(pp + off);
                        const float pv[8] = {bflo(pw.x), bfhi(pw.x), bflo(pw.y), bfhi(pw.y), bflo(pw.z), bfhi(pw.z), bflo(pw.w), bfhi(pw.w)};
#pragma unroll
                        for (int q = 0; q < 8; ++q) xv[q] += pv[q] * sigm(rs * av[q]);
                    } else {
#pragma unroll
                        for (int q = 0; q < 8; ++q) xv[q] += av[q] * rs;
                    }
                    u32x4 w; w.x = cvt_pk_bf16(xv[0], xv[1]); w.y = cvt_pk_bf16(xv[2], xv[3]); w.z = cvt_pk_bf16(xv[4], xv[5]); w.w = cvt_pk_bf16(xv[6], xv[7]);
                    *(u32x4*)(xb + off) = w;
#pragma unroll
                    for (int q = 0; q < 8; ++q) s += xv[q] * xv[q];
                }
                if (WXB) { s += __shfl_xor(s, 16); s += __shfl_xor(s, 32); if (fq == 0) ssq_out[(size_t)row * 16 + u.pn * 4 + wc] = s; }
            }
    }
};

struct EpiIn {
    static constexpr bool PERM = true, AFTER_DRAIN = false, TWOSEG = false;
    bf16_t *UB, *QB, *KP, *VTP, *KS, *VTS; const float* ssq; float *okp, *ovp, *oks, *ovs; int l;
    __device__ __forceinline__ void operator()(const f32x4 (&acc)[2][2][4][2], const Unit& u, int wr, int wc, int fr, int fq) const {
        const int row0 = u.pm * 256 + wr * 64 + fr, cw = wc * 32 + 8 * fq;
#pragma unroll
        for (int ai = 0; ai < 2; ++ai)
#pragma unroll
            for (int m = 0; m < 4; ++m) {
                const int row = row0 + ai * 128 + m * 16; const float rs = rs16c(ssq, row, fq);
                if (u.pn < 4) {
                    const float sc = (u.pn < 2) ? rs : rs * 0.125f; bf16_t* dst = ((u.pn < 2) ? UB : QB) + (size_t)row * 512 + (u.pn & 1) * 256 + cw;
#pragma unroll
                    for (int bj = 0; bj < 2; ++bj) { const f32x4 v0 = acc[ai][bj][m][0] * sc, v1 = acc[ai][bj][m][1] * sc;
                        u32x4 w; w.x = cvt_pk_bf16(v0.x, v0.y); w.y = cvt_pk_bf16(v0.z, v0.w); w.z = cvt_pk_bf16(v1.x, v1.y); w.w = cvt_pk_bf16(v1.z, v1.w);
                        *(u32x4*)(dst + bj * 128) = w; }
                } else {
                    const f32x4 k0 = acc[ai][0][m][0] * rs, k1 = acc[ai][0][m][1] * rs, v0 = acc[ai][1][m][0] * rs, v1 = acc[ai][1][m][1] * rs;
                    u32x4 kw; kw.x = cvt_pk_bf16(k0.x, k0.y); kw.y = cvt_pk_bf16(k0.z, k0.w); kw.z = cvt_pk_bf16(k1.x, k1.y); kw.w = cvt_pk_bf16(k1.z, k1.w);
                    const float vv[8] = {v0.x, v0.y, v0.z, v0.w, v1.x, v1.y, v1.z, v1.w};
                    const int kvh = cw >> 6, d0 = cw & 63;
                    if (row < MP) {
                        const int b = row >> 11, t = row & 2047;
                        *(u32x4*)(KP + (size_t)row * 128 + cw) = kw;
                        bf16_t* vt = VTP + (size_t)(b * 2 + kvh) * 131072;
#pragma unroll
                        for (int j = 0; j < 8; ++j) vt[vt_idx(t, d0 + j)] = f2bf(vv[j]);
                        if (t >= 1920) { const size_t o = ((size_t)(l * NB + b) * 128 + (t - 1920)) * 128 + cw;
                            *(f32x4*)(okp + o) = k0; *(f32x4*)(okp + o + 4) = k1; *(f32x4*)(ovp + o) = v0; *(f32x4*)(ovp + o + 4) = v1; }
                    } else {
                        const int r = row - MP, b = r >> 3, s = r & 7;
                        *(u32x4*)(KS + ((size_t)(l * DB + b) * 160 + 128 + s) * 128 + cw) = kw;
                        bf16_t* vt = VTS + (size_t)((l * DB + b) * 2 + kvh) * 10240;
#pragma unroll
                        for (int j = 0; j < 8; ++j) vt[vt_idx(128 + s, d0 + j)] = f2bf(vv[j]);
                        const size_t o = ((size_t)(l * DB + b) * 128 + 120 + s) * 128 + cw;
                        *(f32x4*)(oks + o) = k0; *(f32x4*)(oks + o + 4) = k1; *(f32x4*)(ovs + o) = v0; *(f32x4*)(ovs + o + 4) = v1;
                    }
                }
            }
    }
};

struct EpiGlu {
    static constexpr bool PERM = true, AFTER_DRAIN = false, TWOSEG = false;
    const bf16_t* YG; bf16_t* YS; float* ssq_out;
    __device__ __forceinline__ void operator()(const f32x4 (&acc)[2][2][4][2], const Unit& u, int wr, int wc, int fr, int fq) const {
        const int row0 = u.pm * 256 + wr * 64 + fr, col0 = u.pn * 256 + wc * 32 + 8 * fq;
#pragma unroll
        for (int ai = 0; ai < 2; ++ai)
#pragma unroll
            for (int m = 0; m < 4; ++m) {
                const int row = row0 + ai * 128 + m * 16; float s = 0.f;
#pragma unroll
                for (int bj = 0; bj < 2; ++bj) {
                    const size_t off = (size_t)row * 512 + col0 + bj * 128; const u32x4 yw = *(const u32x4*)(YG + off);
                    const f32x4 a0 = acc[ai][bj][m][0], a1 = acc[ai][bj][m][1];
                    float o[8];
                    o[0] = bflo(yw.x) * sigm(a0.x); o[1] = bfhi(yw.x) * sigm(a0.y); o[2] = bflo(yw.y) * sigm(a0.z); o[3] = bfhi(yw.y) * sigm(a0.w);
                    o[4] = bflo(yw.z) * sigm(a1.x); o[5] = bfhi(yw.z) * sigm(a1.y); o[6] = bflo(yw.w) * sigm(a1.z); o[7] = bfhi(yw.w) * sigm(a1.w);
#pragma unroll
                    for (int j = 0; j < 8; ++j) s += o[j] * o[j];
                    u32x4 w; w.x = cvt_pk_bf16(o[0], o[1]); w.y = cvt_pk_bf16(o[2], o[3]); w.z = cvt_pk_bf16(o[4], o[5]); w.w = cvt_pk_bf16(o[6], o[7]);
                    *(u32x4*)(YS + off) = w;
                }
                s += __shfl_xor(s, 16); s += __shfl_xor(s, 32); if (fq == 0) ssq_out[(size_t)row * 8 + u.pn * 4 + wc] = s;
            }
    }
};

struct EpiBf {
    static constexpr bool PERM = true, AFTER_DRAIN = false, TWOSEG = false;
    bf16_t* O; int ldc;
    __device__ __forceinline__ void operator()(const f32x4 (&acc)[2][2][4][2], const Unit& u, int wr, int wc, int fr, int fq) const {
        const int row0 = u.pm * 256 + wr * 64 + fr, col0 = u.pn * 256 + wc * 32 + 8 * fq;
#pragma unroll
        for (int ai = 0; ai < 2; ++ai)
#pragma unroll
            for (int m = 0; m < 4; ++m) {
                const int row = row0 + ai * 128 + m * 16;
#pragma unroll
                for (int bj = 0; bj < 2; ++bj) { const f32x4 v0 = acc[ai][bj][m][0], v1 = acc[ai][bj][m][1];
                    u32x4 w; w.x = cvt_pk_bf16(v0.x, v0.y); w.y = cvt_pk_bf16(v0.z, v0.w); w.z = cvt_pk_bf16(v1.x, v1.y); w.w = cvt_pk_bf16(v1.z, v1.w);
                    *(u32x4*)(O + (size_t)row * ldc + col0 + bj * 128) = w; }
            }
    }
};

template <class Epi> __device__ __forceinline__ void run_gemm(unsigned char* lds, const bf16_t* A, const bf16_t* Bt, int N, int K, const Epi& E, int MR = MP, int skip = 0) {
    pg8::Gemm g{A, Bt, MR, N, K}; pg8::StaticOrder S; S.init(MR, N, gdim() - skip, bid() - skip);
    pg8::gemm_phase<Epi, pg8::StaticOrder, false>((PG8_LAS unsigned char*)lds, g, S, E, nullptr);
}

#ifndef MFMA16
#ifndef MFMA16
#define MFMA16(a, b, c) __builtin_amdgcn_mfma_f32_16x16x32_bf16((a), (b), (c), 0, 0, 0)
#endif
#endif

template <class Epi> __device__ __forceinline__ void run_gemm2(unsigned char* lds, const bf16_t* A, const bf16_t* Bt, const bf16_t* A2, const bf16_t* Bt2, int N, int K, const Epi& E, int MR = MP) {
    pg8::Gemm g{A, Bt, MR, N, K, A2, Bt2}; pg8::TwoSegOrder S; S.init(MR, N, gdim(), bid());
    pg8::gemm_phase<Epi, pg8::TwoSegOrder, false>((PG8_LAS unsigned char*)lds, g, S, E, nullptr);
}

template <class BRow>
__device__ __forceinline__ void small_gemm_item(unsigned char* lds, const bf16_t* Arows, int lda, const bf16_t* Bt, int K, const BRow& brow, int wave, int lane) {
    const int fr = lane & 15, fq = lane >> 4, kw = K >> 3, k0 = wave * kw;
    f32x4 acc[4][4];
#pragma unroll
    for (int a = 0; a < 4; ++a)
#pragma unroll
        for (int b = 0; b < 4; ++b) acc[a][b] = (f32x4){0.f, 0.f, 0.f, 0.f};
    const bf16_t* ap = Arows + (size_t)fr * lda + k0 + fq * 8;
    const bf16_t* bp[4];
#pragma unroll
    for (int nb = 0; nb < 4; ++nb) bp[nb] = Bt + (size_t)brow(nb * 16 + fr) * K + k0 + fq * 8;
    for (int kc = 0; kc < kw; kc += 128) {
        bf16x8 a[4][4], b[4][4];
#pragma unroll
        for (int s = 0; s < 4; ++s) {
            if (kc + 32 * s < kw) {
#pragma unroll
                for (int i = 0; i < 4; ++i) { a[s][i] = *(const bf16x8*)(ap + (size_t)i * 16 * lda + kc + 32 * s); b[s][i] = *(const bf16x8*)(bp[i] + kc + 32 * s); }
            }
        }
#pragma unroll
        for (int s = 0; s < 4; ++s) {
            if (kc + 32 * s < kw) {
#pragma unroll
                for (int mb = 0; mb < 4; ++mb)
#pragma unroll
                    for (int nb = 0; nb < 4; ++nb) acc[mb][nb] = MFMA16(b[s][nb], a[s][mb], acc[mb][nb]);
            }
        }
    }
    float* P = (float*)(lds + wave * 16384);
#pragma unroll
    for (int mb = 0; mb < 4; ++mb)
#pragma unroll
        for (int nb = 0; nb < 4; ++nb) { const int mm = mb * 16 + fr; *(f32x4*)(P + mm * 64 + (((nb * 4 + fq) ^ (mm & 7)) << 2)) = acc[mb][nb]; }
}
__device__ __forceinline__ f32x4 small_read(const unsigned char* lds, int mm, int cg) {
    const int o = mm * 64 + ((cg ^ (mm & 7)) << 2);
    f32x4 s = *(const f32x4*)((const float*)lds + o);
#pragma unroll
    for (int w = 1; w < 8; ++w) s += *(const f32x4*)((const float*)(lds + w * 16384) + o);
    return s;
}
struct BRowLin { int base; __device__ __forceinline__ int operator()(int c) const { return base + c; } };
struct BRowGU { int gbase; __device__ __forceinline__ int operator()(int c) const { return gbase + (c & 31) + ((c >> 5) << 7); } };

struct SmallArgs { const bf16_t* A; int lda; const bf16_t* Bt; int K; int l; int xsel, so, si, mode, src; };
template <int KIND>
__device__ __forceinline__ void small_phase(unsigned char* lds, const SmallArgs& sa, int ncb, int skip, int wave, int lane) {
    const int nvb = gdim() - skip, vb = bid() - skip;
    if (vb < 0) return;
    const int tid = wave * 64 + lane, mm = tid >> 3, j = tid & 7;
    for (int id = vb; id < 16 * ncb; id += nvb) {
        int rg = id & 15, cb = id >> 4;
        if (ncb == 16 && skip == 0 && nvb == 256) { const int xcd = id & 7, jj = id >> 3; rg = (xcd >> 1) * 4 + (jj & 3); cb = (xcd & 1) * 8 + (jj >> 2); }
        const bf16_t* Arows = sa.A + (size_t)(MP + rg * 64) * sa.lda;
        if (KIND == 0) { BRowGU br{((cb * 32) >> 7) * 256 + ((cb * 32) & 127)}; small_gemm_item(lds, Arows, sa.lda, sa.Bt, sa.K, br, wave, lane); }
        else { BRowLin br{cb * 64}; small_gemm_item(lds, Arows, sa.lda, sa.Bt, sa.K, br, wave, lane); }
        __syncthreads();
        unsigned char* ws = kws(); float* out = kout();
        const int row = MP + rg * 64 + mm;
        if (KIND == 0) {
            const float rs = rs16((const float*)(ws + WS_SSQ + (size_t)sa.si * SZ_SSQ16), row);
            const f32x4 g = small_read(lds, mm, j) * rs, u = small_read(lds, mm, 8 + j) * rs;
            u32x2 w; w.x = cvt_pk_bf16(silu_f(g.x) * u.x, silu_f(g.y) * u.y); w.y = cvt_pk_bf16(silu_f(g.z) * u.z, silu_f(g.w) * u.w);
            *(u32x2*)((bf16_t*)(ws + WS_HB) + (size_t)row * FF + cb * 32 + 4 * j) = w;
        } else {
            const f32x4 v0 = small_read(lds, mm, 2 * j), v1 = small_read(lds, mm, 2 * j + 1);
            const int col = cb * 64 + 8 * j;
            if (KIND == 1) {
                const bf16_t* xi = (const bf16_t*)(ws + (sa.src ? WS_XB1 : WS_XB0)) + (size_t)row * D + col; bf16_t* xb = (bf16_t*)(ws + (sa.xsel ? WS_XB1 : WS_XB0)) + (size_t)row * D + col;
                const u32x4 xw = *(const u32x4*)xi;
                f32x4 x0 = {bflo(xw.x), bfhi(xw.x), bflo(xw.y), bfhi(xw.y)}, x1 = {bflo(xw.z), bfhi(xw.z), bflo(xw.w), bfhi(xw.w)};
                if (sa.mode == 0) { x0 += v0 * 0.5f; x1 += v1 * 0.5f; }
                else if (sa.mode == 1) { const float rs = rs8((const float*)(ws + WS_SSQ + 4 * SZ_SSQ16 + (size_t)sa.si * SZ_SSQ8), row); x0 += v0 * rs; x1 += v1 * rs; }
                else { const float rs = rs16((const float*)(ws + WS_SSQ + (size_t)sa.si * SZ_SSQ16), row); const u32x4 pw = *(const u32x4*)((const bf16_t*)out + (size_t)row * D + col);
                    x0.x += bflo(pw.x) * sigm(rs * v0.x); x0.y += bfhi(pw.x) * sigm(rs * v0.y); x0.z += bflo(pw.y) * sigm(rs * v0.z); x0.w += bfhi(pw.y) * sigm(rs * v0.w);
                    x1.x += bflo(pw.z) * sigm(rs * v1.x); x1.y += bfhi(pw.z) * sigm(rs * v1.y); x1.z += bflo(pw.w) * sigm(rs * v1.z); x1.w += bfhi(pw.w) * sigm(rs * v1.w); }
                { u32x4 w; w.x = cvt_pk_bf16(x0.x, x0.y); w.y = cvt_pk_bf16(x0.z, x0.w); w.z = cvt_pk_bf16(x1.x, x1.y); w.w = cvt_pk_bf16(x1.z, x1.w); *(u32x4*)xb = w; }
                if (sa.so >= 0) {
                    float s = ((x0.x * x0.x + x0.y * x0.y) + (x0.z * x0.z + x0.w * x0.w)) + ((x1.x * x1.x + x1.y * x1.y) + (x1.z * x1.z + x1.w * x1.w));
                    s += __shfl_xor(s, 1); s += __shfl_xor(s, 2); s += __shfl_xor(s, 4);
                    if (j == 0) ((float*)(ws + WS_SSQ + (size_t)sa.so * SZ_SSQ16))[(size_t)row * 16 + cb] = s;
                }
            } else if (KIND == 2) {
                const float rs = rs16((const float*)(ws + WS_SSQ + SZ_SSQ16), row); const int l = sa.l;
                const int r = row - MP, b = r >> 3, s = r & 7;
                if (cb < 16) { const float sc = (cb < 8) ? rs : rs * 0.125f; const f32x4 a0 = v0 * sc, a1 = v1 * sc;
                    u32x4 w; w.x = cvt_pk_bf16(a0.x, a0.y); w.y = cvt_pk_bf16(a0.z, a0.w); w.z = cvt_pk_bf16(a1.x, a1.y); w.w = cvt_pk_bf16(a1.z, a1.w);
                    *(u32x4*)((bf16_t*)(ws + WS_HB + (cb < 8 ? 0 : SZ_512)) + (size_t)row * 512 + (col & 511)) = w;
                } else { const f32x4 a0 = v0 * rs, a1 = v1 * rs; const int ck = col & 127; const size_t o = ((size_t)(l * DB + b) * 128 + 120 + s) * 128 + ck;
                    if (cb < 18) { u32x4 w; w.x = cvt_pk_bf16(a0.x, a0.y); w.y = cvt_pk_bf16(a0.z, a0.w); w.z = cvt_pk_bf16(a1.x, a1.y); w.w = cvt_pk_bf16(a1.z, a1.w);
                        *(u32x4*)((bf16_t*)(ws + WS_KS) + ((size_t)(l * DB + b) * 160 + 128 + s) * 128 + ck) = w;
                        *(f32x4*)(out + O_KS + o) = a0; *(f32x4*)(out + O_KS + o + 4) = a1;
                    } else { const float vv[8] = {a0.x, a0.y, a0.z, a0.w, a1.x, a1.y, a1.z, a1.w}; const int kvh = ck >> 6, d0 = ck & 63;
                        bf16_t* vt = (bf16_t*)(ws + WS_VTS) + (size_t)((l * DB + b) * 2 + kvh) * 10240;
#pragma unroll
                        for (int q = 0; q < 8; ++q) vt[vt_idx(128 + s, d0 + q)] = f2bf(vv[q]);
                        *(f32x4*)(out + O_VS + o) = a0; *(f32x4*)(out + O_VS + o + 4) = a1; }
                }
            } else if (KIND == 3) {
                const size_t off = (size_t)row * 512 + col; const u32x4 yw = *(const u32x4*)((const bf16_t*)(ws + WS_HB + 2 * SZ_512) + off);
                float o[8];
                o[0] = bflo(yw.x) * sigm(v0.x); o[1] = bfhi(yw.x) * sigm(v0.y); o[2] = bflo(yw.y) * sigm(v0.z); o[3] = bfhi(yw.y) * sigm(v0.w);
                o[4] = bflo(yw.z) * sigm(v1.x); o[5] = bfhi(yw.z) * sigm(v1.y); o[6] = bflo(yw.w) * sigm(v1.z); o[7] = bfhi(yw.w) * sigm(v1.w);
                float s = 0.f;
#pragma unroll
                for (int q = 0; q < 8; ++q) s += o[q] * o[q];
                u32x4 w; w.x = cvt_pk_bf16(o[0], o[1]); w.y = cvt_pk_bf16(o[2], o[3]); w.z = cvt_pk_bf16(o[4], o[5]); w.w = cvt_pk_bf16(o[6], o[7]);
                *(u32x4*)((bf16_t*)(ws + WS_HB + 3 * SZ_512) + off) = w;
                s += __shfl_xor(s, 1); s += __shfl_xor(s, 2); s += __shfl_xor(s, 4);
                if (j == 0) ((float*)(ws + WS_SSQ + 4 * SZ_SSQ16))[(size_t)row * 8 + cb] = s;
            } else {
                u32x4 w; w.x = cvt_pk_bf16(v0.x, v0.y); w.y = cvt_pk_bf16(v0.z, v0.w); w.z = cvt_pk_bf16(v1.x, v1.y); w.w = cvt_pk_bf16(v1.z, v1.w);
                *(u32x4*)((bf16_t*)out + (size_t)row * D + col) = w;
            }
        }
        __syncthreads();
    }
}
#define SMALL(KIND, NCB, SKIP, ...) { int tid_ = MYTID(); asm volatile("" : "+v"(tid_)); const int lane_ = tid_ & 63, wave_ = __builtin_amdgcn_readfirstlane(tid_ >> 6); \
    unsigned char* ws_ = kws(); (void)ws_; SmallArgs sa_ = __VA_ARGS__; small_phase<KIND>(lds, sa_, NCB, SKIP, wave_, lane_); }

__device__ __forceinline__ void tr_item(const float* W, int ldw, const float* gain, bf16_t* WT, int Kd, int k0, int n0, int drow0, float* scr, int lane) {
    float tv[32];
#pragma unroll
    for (int i = 0; i < 32; ++i) { const int kk = 2 * i + (lane >> 5); tv[i] = W[(size_t)(k0 + kk) * ldw + n0 + (lane & 31)]; }
    if (gain) {
#pragma unroll
        for (int i = 0; i < 32; ++i) tv[i] *= gain[k0 + 2 * i + (lane >> 5)]; }
#pragma unroll
    for (int i = 0; i < 32; ++i) scr[(2 * i + (lane >> 5)) * 33 + (lane & 31)] = tv[i];
    asm volatile("s_waitcnt lgkmcnt(0)" ::: "memory");
    const int c = lane & 7;
#pragma unroll
    for (int j = 0; j < 4; ++j) { const int n = (lane >> 3) + 8 * j; const float* s = scr + (8 * c) * 33 + n;
        u32x4 o; o.x = cvt_pk_bf16(s[0 * 33], s[1 * 33]); o.y = cvt_pk_bf16(s[2 * 33], s[3 * 33]); o.z = cvt_pk_bf16(s[4 * 33], s[5 * 33]); o.w = cvt_pk_bf16(s[6 * 33], s[7 * 33]);
        *(u32x4*)(WT + (size_t)(drow0 + n) * Kd + k0 + 8 * c) = o; }
    asm volatile("s_waitcnt lgkmcnt(0)" ::: "memory");
}

__device__ __forceinline__ void cexp_i(double th, double& c, double& s) {
    const double TWO_PI_HI = 6.283185307179586232, TWO_PI_LO = 2.4492935982947064e-16;
    const double k = rint(th * 0.15915494309189534561);
    double r = fma(-k, TWO_PI_HI, th); r = fma(-k, TWO_PI_LO, r);
    const double h = r * 0.125;
    double cr = 1.0, ci = 0.0, tr = 1.0, ti = 0.0;
    for (int n = 1; n <= 16; ++n) { const double nr = -ti * h / n, ni = tr * h / n; tr = nr; ti = ni; cr += tr; ci += ti; }
    for (int q = 0; q < 3; ++q) { const double nr = cr * cr - ci * ci, ni = 2.0 * cr * ci; cr = nr; ci = ni; }
    c = cr; s = ci;
}

constexpr int I_LAYER_ALL = 6 * (16 * 88) + 16 * 40 + 8 * 16 + 2 * (8 * 32) + 16 * 32 + 4 * 32;
__device__ __forceinline__ void conv_weights(unsigned char* lds, int wave, int lane, int l, int it_begin, int it_end, int vgw, int VNGW) {
    unsigned char* ws = kws(); float* scr = (float*)(lds + wave * 16384);
    constexpr int I_FU = 16 * 88, I_FD = 44 * 32, I_IN = 16 * 40, I_GLU = 8 * 16, I_O = 8 * 32, I_PG = 16 * 32, I_PPJ = 4 * 32;
    constexpr int I_LAYER = 6 * I_FU + I_IN + I_GLU + 2 * I_O + I_PG + I_PPJ;
    static_assert(I_FU == I_FD && I_LAYER == I_LAYER_ALL, "items");
    for (int it = it_begin + vgw; it < it_end; it += VNGW) {
        int r = it;
        bf16_t* WL = (bf16_t*)(ws + WS_W) + (size_t)l * E_WLAYER;
#define TRM(SRC, LDW, GAIN, DST, KD, KROWS, NCOLS, ROWEXPR) { constexpr int nit = ((KROWS) / 64) * ((NCOLS) / 32); if (r < nit) { constexpr int nblk = (NCOLS) / 32; const int kb = r / nblk, nb = r % nblk, k0 = kb * 64, n0 = nb * 32; \
            tr_item(SRC, LDW, GAIN, DST, KD, k0, n0, ROWEXPR, scr, lane); continue; } r -= nit; }
        TRM(kin(9) + (size_t)l * D * FF, FF, kin(8) + l * D, WL + OW_GU1, D, D, FF, ((n0 >> 7) * 256 + (n0 & 127)))
        TRM(kin(10) + (size_t)l * D * FF, FF, kin(8) + l * D, WL + OW_GU1, D, D, FF, ((n0 >> 7) * 256 + 128 + (n0 & 127)))
        TRM(kin(11) + (size_t)l * FF * D, D, (const float*)nullptr, WL + OW_D1, FF, FF, D, n0)
        TRM(kin(13) + (size_t)l * D * INW, INW, kin(12) + l * D, WL + OW_IN, D, D, INW, n0)
        TRM(kin(22) + (size_t)l * 512 * 512, 512, (const float*)nullptr, WL + OW_GLU, 512, 512, 512, n0)
        TRM(kin(26) + (size_t)l * D * D, D, kin(23) + l * 512, WL + OW_OA, 512, 512, D, n0)
        TRM(kin(26) + (size_t)l * D * D + (size_t)512 * D, D, kin(25) + l * 512, WL + OW_OB, 512, 512, D, n0)
        TRM(kin(28) + (size_t)l * D * FF, FF, kin(27) + l * D, WL + OW_GU2, D, D, FF, ((n0 >> 7) * 256 + (n0 & 127)))
        TRM(kin(29) + (size_t)l * D * FF, FF, kin(27) + l * D, WL + OW_GU2, D, D, FF, ((n0 >> 7) * 256 + 128 + (n0 & 127)))
        TRM(kin(30) + (size_t)l * FF * D, D, (const float*)nullptr, WL + OW_D2, FF, FF, D, n0)
        TRM(kin(32) + (size_t)l * D * D, D, kin(31) + l * D, WL + OW_PG, D, D, D, n0)
        TRM(kin(33) + (size_t)l * 256 * D, D, (const float*)nullptr, WL + OW_PP, 256, 256, D, n0)
#undef TRM
    }
}

__device__ __forceinline__ void p0_phase(unsigned char* lds, int wave, int lane) {
    unsigned char* ws = kws(); float* out = kout();
    const int G = gridDim.x, gw = blockIdx.x * 8 + wave, NGW = G * 8;
    conv_weights(lds, wave, lane, 0, 0, 2 * 16 * 88, gw, NGW);
    {
        bf16_t* XB0 = (bf16_t*)(ws + WS_XB0); float* ssq0 = (float*)(ws + WS_SSQ);
        for (int m = gw; m < M; m += NGW) {
            const float* src = (m < MP) ? kin(0) + (size_t)m * D : kin(1) + (size_t)(m - MP) * D;
            float s = 0.f;
#pragma unroll
            for (int j = 0; j < 4; ++j) { const f32x4 v = ((const f32x4*)src)[lane + 64 * j];
                u32x2 w; w.x = cvt_pk_bf16(v.x, v.y); w.y = cvt_pk_bf16(v.z, v.w); ((u32x2*)(XB0 + (size_t)m * D))[lane + 64 * j] = w; s += (v.x * v.x + v.y * v.y) + (v.z * v.z + v.w * v.w); }
            s = wave_sum(s);
            if (lane < 16) ssq0[(size_t)m * 16 + lane] = (lane == 0) ? s : 0.f;
        }
    }
    const size_t gt = (size_t)blockIdx.x * 512 + wave * 64 + lane, NGT = (size_t)G * 512;
    for (size_t i = gt; i < (size_t)NL * 32 * 64; i += NGT) {
        const int n = (int)(i & 63), lg = (int)(i >> 6), l = lg >> 5, g = lg & 31;
        unsigned char* tab = ws + WS_TAB + (size_t)l * TAB_LAYER;
        const double lr = (double)kin(14)[i], li = (double)kin(15)[i], dt = exp((double)kin(16)[lg]);
        const double zr = lr * dt, zi = li * dt; double c1, s1; cexp_i(zi, c1, s1); const double ea = exp(zr); const double ar = ea * c1, ai = ea * s1;
        double c2, s2; cexp_i(256.0 * zi, c2, s2); const double e2 = exp(256.0 * zr);
        ((float*)(tab + TAB_AR))[g * 64 + n] = (float)ar; ((float*)(tab + TAB_AI))[g * 64 + n] = (float)ai;
        ((float*)(tab + TAB_A2R))[g * 64 + n] = (float)(e2 * c2); ((float*)(tab + TAB_A2I))[g * 64 + n] = (float)(e2 * s2);
        const double nr = ar - 1.0, ni = ai, den = lr * lr + li * li; const double cr = (nr * lr + ni * li) / den, ci = (ni * lr - nr * li) / den;
        bf16_t* bb = (bf16_t*)(tab + TAB_BB) + (size_t)g * 128 * 16; bf16_t* cm = (bf16_t*)(tab + TAB_CM) + (size_t)g * 16 * 128;
        for (int p = 0; p < 16; ++p) {
            const double br = (double)kin(17)[i * 16 + p], bi = (double)kin(18)[i * 16 + p];
            bb[n * 16 + p] = f2bf((float)(cr * br - ci * bi)); bb[(64 + n) * 16 + p] = f2bf((float)(cr * bi + ci * br));
            cm[p * 128 + n] = f2bf(kin(19)[((size_t)lg * 16 + p) * 64 + n]); cm[p * 128 + 64 + n] = f2bf(-kin(20)[((size_t)lg * 16 + p) * 64 + n]);
        }
    }
}
__device__ __forceinline__ void p0_misc(int wave, int lane, int vb, int NVB) {
    unsigned char* ws = kws(); float* out = kout();
    const size_t gt = (size_t)vb * 512 + wave * 64 + lane, NGT = (size_t)NVB * 512;
    {
        bf16_t* PB = (bf16_t*)(ws + WS_PB);
        for (size_t i = gt; i < (size_t)NL * M * 64; i += NGT) { const int l = (int)(i / ((size_t)M * 64)); const size_t rem = i % ((size_t)M * 64); const int row = (int)(rem >> 6), c4 = (int)(rem & 63);
            const float* src = (row < MP) ? kin(6) + ((size_t)l * MP + row) * 256 + c4 * 4 : kin(7) + ((size_t)l * MSM + (row - MP)) * 256 + c4 * 4;
            const f32x4 v = *(const f32x4*)src; u32x2 w; w.x = cvt_pk_bf16(v.x, v.y); w.y = cvt_pk_bf16(v.z, v.w); ((u32x2*)PB)[i] = w; }
    }
    {
        bf16_t* KS = (bf16_t*)(ws + WS_KS); bf16_t* VTS = (bf16_t*)(ws + WS_VTS);
        for (size_t i = gt; i < (size_t)NL * DB * 160 * 32; i += NGT) { const int c4 = (int)(i & 31); const size_t t1 = i >> 5; const int key = (int)(t1 % 160); const size_t lb = t1 / 160;
            u32x2 w; w.x = 0u; w.y = 0u;
            if (key < 128) { const f32x4 v = *(const f32x4*)(kin(2) + (lb * 128 + key) * 128 + c4 * 4); w.x = cvt_pk_bf16(v.x, v.y); w.y = cvt_pk_bf16(v.z, v.w); }
            ((u32x2*)KS)[i] = w; }
        for (size_t i = gt; i < (size_t)NL * DB * 32 * 160; i += NGT) { const int t = (int)(i % 160); const size_t t1 = i / 160; const int c4 = (int)(t1 & 31); const size_t lb = t1 >> 5;
            f32x4 v = {0.f, 0.f, 0.f, 0.f}; if (t < 128) v = *(const f32x4*)(kin(3) + (lb * 128 + t) * 128 + c4 * 4);
            const int c = c4 * 4; bf16_t* d = VTS + (lb * 2 + (c >> 6)) * 10240; const int i0 = vt_idx(t, c & 63); d[i0] = f2bf(v.x); d[i0 + 16] = f2bf(v.y); d[i0 + 32] = f2bf(v.z); d[i0 + 48] = f2bf(v.w); }
        for (size_t i = gt; i < (size_t)NL * DB * 120 * 32; i += NGT) { const int c4 = (int)(i & 31); const size_t t1 = i >> 5; const int j = (int)(t1 % 120); const size_t lb = t1 / 120;
            const size_t so = (lb * 128 + j + 8) * 128 + c4 * 4, dofs = (lb * 128 + j) * 128 + c4 * 4;
            *(f32x4*)(out + O_KS + dofs) = *(const f32x4*)(kin(2) + so); *(f32x4*)(out + O_VS + dofs) = *(const f32x4*)(kin(3) + so); }
    }
}

#define MFMA32(a, b, c) __builtin_amdgcn_mfma_f32_32x32x16_bf16((a), (b), (c), 0, 0, 0)
#ifndef MFMA16
#define MFMA16(a, b, c) __builtin_amdgcn_mfma_f32_16x16x32_bf16((a), (b), (c), 0, 0, 0)
#endif

template <bool PASS2, int SEG>
__device__ __forceinline__ void ssm_sub(unsigned char* wl, const bf16_t* urow0, const bf16x8 ua, const bf16x8 (&bfr)[4], const bf16x8 (&cfr)[4], float ar, float ai, float& hr, float& hi, int lane,
                                        const float* h0re, const float* h0im, float* ofre, float* ofim, int segstride, bf16_t* ygrow0, f32x4 dv) {
    float* BU = (float*)wl; unsigned short* HB = (unsigned short*)wl;
    const int r = lane & 31, hf = lane >> 5;
    u32x2 uu[2] = {{0u, 0u}, {0u, 0u}};
    if (PASS2) {
#pragma unroll
        for (int tb = 0; tb < 2; ++tb) uu[tb] = *(const u32x2*)(urow0 + (size_t)(tb * 16 + (lane & 15)) * 512 + 4 * (lane >> 4)); }
    asm volatile("" ::: "memory");
    {
#pragma unroll
        for (int cb = 0; cb < 4; ++cb) {
            f32x16 acc;
#pragma unroll
            for (int i = 0; i < 16; ++i) acc[i] = 0.f;
            acc = MFMA32(ua, bfr[cb], acc);
#pragma unroll
            for (int i = 0; i < 16; ++i) BU[((i & 3) + 8 * (i >> 2) + 4 * hf) * 128 + cb * 32 + r] = acc[i];
        }
    }
    asm volatile("" ::: "memory");
#pragma unroll 8
    for (int t = 0; t < 32; ++t) {
        if (SEG < 32 && (t % SEG) == 0) { hr = h0re[(size_t)(t / SEG) * segstride + lane]; hi = h0im[(size_t)(t / SEG) * segstride + lane]; }
        const float br = BU[t * 128 + lane], bi = BU[t * 128 + 64 + lane];
        const float nr = fmaf(ar, hr, fmaf(-ai, hi, br)), ni = fmaf(ar, hi, fmaf(ai, hr, bi));
        hr = nr; hi = ni;
        if (PASS2) { HB[t * 136 + lane] = f2bf(hr); HB[t * 136 + 64 + lane] = f2bf(hi); }
        if (SEG < 32 && (t % SEG) == SEG - 1) { ofre[(size_t)(t / SEG) * segstride + lane] = hr; ofim[(size_t)(t / SEG) * segstride + lane] = hi; }
    }
    asm volatile("" ::: "memory");
    if (PASS2) {
        const int tk = lane & 15, q4 = lane >> 4;
#pragma unroll
        for (int tb = 0; tb < 2; ++tb) {
            f32x4 acc = {0.f, 0.f, 0.f, 0.f};
#pragma unroll
            for (int ks = 0; ks < 4; ++ks) { const bf16x8 hfrag = *(const bf16x8*)(wl + (tb * 16 + tk) * 272 + (ks * 32 + q4 * 8) * 2); acc = MFMA16(cfr[ks], hfrag, acc); }
            const size_t ro = (size_t)(tb * 16 + tk) * 512 + 4 * q4;
            const float y0 = gelu_tanh(acc.x + dv.x * bflo(uu[tb].x)), y1 = gelu_tanh(acc.y + dv.y * bfhi(uu[tb].x)), y2 = gelu_tanh(acc.z + dv.z * bflo(uu[tb].y)), y3 = gelu_tanh(acc.w + dv.w * bfhi(uu[tb].y));
            u32x2 w; w.x = cvt_pk_bf16(y0, y1); w.y = cvt_pk_bf16(y2, y3); *(u32x2*)(ygrow0 + ro) = w;
        }
    }
    asm volatile("" ::: "memory");
}


struct Cx { float r, i; };
__device__ __forceinline__ Cx cmul(Cx a, Cx b) { return Cx{a.r * b.r - a.i * b.i, a.r * b.i + a.i * b.r}; }
__device__ __forceinline__ Cx cfma(Cx x, Cx a, Cx b) { return Cx{fmaf(x.r, a.r, fmaf(-x.i, a.i, b.r)), fmaf(x.r, a.i, fmaf(x.i, a.r, b.i))}; }
__device__ __forceinline__ void ssm_p1_sub(const bf16x8 ua, const bf16x8 (&bfr)[4], Cx aA, Cx aB, Cx a8A, Cx a8B, Cx a4own, Cx a32own, int hf, float& hr, float& hi) {
    f32x16 acc[4];
#pragma unroll
    for (int cb = 0; cb < 4; ++cb) {
#pragma unroll
        for (int i = 0; i < 16; ++i) acc[cb][i] = 0.f;
        acc[cb] = MFMA32(ua, bfr[cb], acc[cb]);
    }
    Cx SA = {0.f, 0.f}, SB = {0.f, 0.f};
#pragma unroll
    for (int j = 0; j < 4; ++j) {
        Cx sa = {acc[0][4 * j], acc[2][4 * j]}, sb = {acc[1][4 * j], acc[3][4 * j]};
#pragma unroll
        for (int q = 1; q < 4; ++q) { sa = cfma(sa, aA, Cx{acc[0][4 * j + q], acc[2][4 * j + q]}); sb = cfma(sb, aB, Cx{acc[1][4 * j + q], acc[3][4 * j + q]}); }
        if (j == 0) { SA = sa; SB = sb; } else { SA = cfma(SA, a8A, sa); SB = cfma(SB, a8B, sb); }
    }
    const float sr = hf ? SA.r : SB.r, si = hf ? SA.i : SB.i;
    const Cx other = {__shfl_xor(sr, 32), __shfl_xor(si, 32)}, own = hf ? SB : SA;
    const Cx S = hf ? cfma(other, a4own, own) : cfma(own, a4own, other);
    const Cx h = cfma(Cx{hr, hi}, a32own, S);
    hr = h.r; hi = h.i;
}
__device__ __forceinline__ void ssm_phase(unsigned char* lds, int l, int wave, int lane) {
    unsigned char* ws = kws(); float* out = kout();
    const unsigned char* tab = ws + WS_TAB + (size_t)l * TAB_LAYER;
    const bf16_t* UB = (const bf16_t*)(ws + WS_HB); bf16_t* YG = (bf16_t*)(ws + WS_HB + 2 * SZ_512);
    unsigned char* wl = lds + wave * 16384; float* xch = (float*)(lds + 131072);
    const int r = lane & 31, hf = lane >> 5, tk = lane & 15, q4 = lane >> 4;
    for (int unit = blockIdx.x; unit < NB * 32; unit += gridDim.x) {
        const int b = unit >> 5, g = unit & 31;
        bf16x8 bfr[4], cfr[4];
#pragma unroll
        for (int cb = 0; cb < 4; ++cb) bfr[cb] = *(const bf16x8*)((const bf16_t*)(tab + TAB_BB) + ((size_t)g * 128 + cb * 32 + r) * 16 + hf * 8);
#pragma unroll
        for (int ks = 0; ks < 4; ++ks) cfr[ks] = *(const bf16x8*)((const bf16_t*)(tab + TAB_CM) + ((size_t)g * 16 + tk) * 128 + ks * 32 + q4 * 8);
        const float ar = ((const float*)(tab + TAB_AR))[g * 64 + lane], ai = ((const float*)(tab + TAB_AI))[g * 64 + lane];
        const float a2r = ((const float*)(tab + TAB_A2R))[g * 64 + lane], a2i = ((const float*)(tab + TAB_A2I))[g * 64 + lane];
        const f32x4 dv = *(const f32x4*)(kin(21) + l * 512 + g * 16 + 4 * q4);
        const size_t row0 = (size_t)b * SEQ + wave * 256;
        float hr = 0.f, hi = 0.f;
        const bf16_t* ub0 = UB + row0 * 512 + g * 16 + (size_t)r * 512 + hf * 8;
        bf16x8 ua = *(const bf16x8*)ub0;
        {
            const float* TAR = (const float*)(tab + TAB_AR) + g * 64; const float* TAI = (const float*)(tab + TAB_AI) + g * 64;
            const Cx aA = {TAR[r], TAI[r]}, aB = {TAR[32 + r], TAI[32 + r]};
            const Cx a2A = cmul(aA, aA), a4A = cmul(a2A, a2A), a8A = cmul(a4A, a4A), a2B = cmul(aB, aB), a4B = cmul(a2B, a2B), a8B = cmul(a4B, a4B);
            const Cx a8o = hf ? a8B : a8A, a16o = cmul(a8o, a8o), a32o = cmul(a16o, a16o), a4o = hf ? a4B : a4A;
            for (int sc = 0; sc < 8; ++sc) { const bf16x8 uc = ua; ua = *(const bf16x8*)(ub0 + (size_t)((sc + 1) & 7) * 32 * 512);
                ssm_p1_sub(uc, bfr, aA, aB, a8A, a8B, a4o, a32o, hf, hr, hi); }
        }
        xch[wave * 128 + lane] = hr; xch[wave * 128 + 64 + lane] = hi;
        __syncthreads();
        float cr = 0.f, ci = 0.f;
        for (int j = 0; j < wave; ++j) { const float sr = xch[j * 128 + lane], si = xch[j * 128 + 64 + lane];
            const float nr = fmaf(a2r, cr, fmaf(-a2i, ci, sr)), ni = fmaf(a2r, ci, fmaf(a2i, cr, si)); cr = nr; ci = ni; }
        hr = cr; hi = ci;
        for (int sc = 0; sc < 8; ++sc) { const bf16x8 uc = ua; ua = *(const bf16x8*)(ub0 + (size_t)((sc + 1) & 7) * 32 * 512);
            ssm_sub<true, 32>(wl, UB + (row0 + sc * 32) * 512 + g * 16, uc, bfr, cfr, ar, ai, hr, hi, lane, nullptr, nullptr, nullptr, nullptr, 0, YG + (row0 + sc * 32) * 512 + g * 16, dv); }
        if (wave == 7) { out[O_HPR + ((size_t)(l * NB + b) * 32 + g) * 64 + lane] = hr; out[O_HPI + ((size_t)(l * NB + b) * 32 + g) * 64 + lane] = hi; }
        __syncthreads();
    }
    for (int wu = blockIdx.x * 8 + wave; wu < 32 * 32; wu += gridDim.x * 8) {
        const int g = wu & 31, bq = wu >> 5;
        bf16x8 bfr[4], cfr[4];
#pragma unroll
        for (int cb = 0; cb < 4; ++cb) bfr[cb] = *(const bf16x8*)((const bf16_t*)(tab + TAB_BB) + ((size_t)g * 128 + cb * 32 + r) * 16 + hf * 8);
#pragma unroll
        for (int ks = 0; ks < 4; ++ks) cfr[ks] = *(const bf16x8*)((const bf16_t*)(tab + TAB_CM) + ((size_t)g * 16 + tk) * 128 + ks * 32 + q4 * 8);
        const float ar = ((const float*)(tab + TAB_AR))[g * 64 + lane], ai = ((const float*)(tab + TAB_AI))[g * 64 + lane];
        const f32x4 dv = *(const f32x4*)(kin(21) + l * 512 + g * 16 + 4 * q4);
        const size_t row0 = (size_t)MP + bq * 32; const size_t so = ((size_t)(l * DB + bq * 4) * 32 + g) * 64;
        float hr = 0.f, hi = 0.f;
        ssm_sub<true, 8>(wl, UB + row0 * 512 + g * 16, *(const bf16x8*)(UB + row0 * 512 + g * 16 + (size_t)r * 512 + hf * 8), bfr, cfr, ar, ai, hr, hi, lane, kin(4) + so, kin(5) + so, out + O_HSR + so, out + O_HSI + so, 32 * 64, YG + row0 * 512 + g * 16, dv);
    }
}

__device__ __forceinline__ void attn_wave(const bf16_t* QB, const bf16_t* Kseq, const bf16_t* Vseq, int tstride, int qrow_base, int nq, int q0, float sink, bf16_t* YA, float* ssqT, int h, int lane) {
    const int r = lane & 31, hf = lane >> 5;
    const int qrow = qrow_base + (r < nq ? r : nq - 1);
    bf16x8 qf[4];
#pragma unroll
    for (int ks = 0; ks < 4; ++ks) qf[ks] = *(const bf16x8*)(QB + (size_t)qrow * 512 + h * 64 + ks * 16 + hf * 8);
    f32x16 s[5];
    const int kb0 = q0 - 128;
#pragma unroll
    for (int jb = 0; jb < 5; ++jb) {
#pragma unroll
        for (int i = 0; i < 16; ++i) s[jb][i] = 0.f;
        const int kp0 = kb0 + 32 * jb;
        if (kp0 >= 0) {
            const bf16_t* kptr = Kseq + (size_t)(kp0 + r) * 128 + hf * 8;
#pragma unroll
            for (int ks = 0; ks < 4; ++ks) { const bf16x8 kf = *(const bf16x8*)(kptr + ks * 16); s[jb] = MFMA32(kf, qf[ks], s[jb]); }
        }
    }
    bf16x8 vfr[5][2][2];
#pragma unroll
    for (int jb = 0; jb < 5; ++jb) {
        const int kp0 = kb0 + 32 * jb;
#pragma unroll
        for (int st = 0; st < 2; ++st)
#pragma unroll
            for (int db = 0; db < 2; ++db) {
                if (kp0 >= 0) vfr[jb][st][db] = *(const bf16x8*)(Vseq + (size_t)((kp0 + 16 * st) >> 4) * 1024 + (db * 32 + r) * 16 + hf * 8);
                else vfr[jb][st][db] = (bf16x8){0, 0, 0, 0, 0, 0, 0, 0}; }
    }
    const int qp = q0 + r;
    float mx = sink;
#pragma unroll
    for (int jb = 0; jb < 5; ++jb)
#pragma unroll
        for (int i = 0; i < 16; ++i) { const int kp = kb0 + 32 * jb + (i & 3) + 8 * (i >> 2) + 4 * hf; const bool ok = (kp >= 0) && (kp <= qp) && (qp - kp < 128);
            s[jb][i] = ok ? s[jb][i] : -1e30f; mx = fmaxf(mx, s[jb][i]); }
    mx = fmaxf(mx, __shfl_xor(mx, 32));
    float sum = 0.f;
#pragma unroll
    for (int jb = 0; jb < 5; ++jb)
#pragma unroll
        for (int i = 0; i < 16; ++i) { const float p = (s[jb][i] > -1e29f) ? __builtin_amdgcn_exp2f((s[jb][i] - mx) * 1.44269504f) : 0.f; s[jb][i] = p; sum += p; }
    sum += __shfl_xor(sum, 32);
    sum += __builtin_amdgcn_exp2f((sink - mx) * 1.44269504f);
    const float inv = 1.0f / sum;
    f32x16 o[2];
#pragma unroll
    for (int i = 0; i < 16; ++i) { o[0][i] = 0.f; o[1][i] = 0.f; }
#pragma unroll
    for (int jb = 0; jb < 5; ++jb) {
        const int kp0 = kb0 + 32 * jb;
        if (kp0 >= 0) {
#pragma unroll
            for (int st = 0; st < 2; ++st) {
                union { bf16x8 v; unsigned u[4]; } pf;
#pragma unroll
                for (int j = 0; j < 4; ++j) pf.u[j] = cvt_pk_bf16(s[jb][8 * st + 2 * j], s[jb][8 * st + 2 * j + 1]);
#pragma unroll
                for (int db = 0; db < 2; ++db) {
                    o[db] = MFMA32(vfr[jb][st][db], pf.v, o[db]);
                }
            }
        }
    }
    float sq = 0.f;
#pragma unroll
    for (int db = 0; db < 2; ++db)
#pragma unroll
        for (int ig = 0; ig < 4; ++ig) {
            const float v0 = o[db][4 * ig] * inv, v1 = o[db][4 * ig + 1] * inv, v2 = o[db][4 * ig + 2] * inv, v3 = o[db][4 * ig + 3] * inv;
            sq += (v0 * v0 + v1 * v1) + (v2 * v2 + v3 * v3);
            if (r < nq) { u32x2 w; w.x = cvt_pk_bf16(v0, v1); w.y = cvt_pk_bf16(v2, v3); *(u32x2*)(YA + (size_t)qrow * 512 + h * 64 + db * 32 + 8 * ig + 4 * hf) = w; }
        }
    sq += __shfl_xor(sq, 32);
    if (hf == 0 && r < nq) ssqT[(size_t)qrow * 8 + h] = sq;
}

__device__ __forceinline__ void attn_phase(int l, int wave, int lane) {
    unsigned char* ws = kws();
    const bf16_t* QB = (const bf16_t*)(ws + WS_HB + SZ_512); bf16_t* YA = (bf16_t*)(ws + WS_HB + 4 * SZ_512);
    const bf16_t* KP = (const bf16_t*)(ws + WS_KP); const bf16_t* VTP = (const bf16_t*)(ws + WS_VTP);
    const bf16_t* KS = (const bf16_t*)(ws + WS_KS); const bf16_t* VTS = (const bf16_t*)(ws + WS_VTS);
    float* ssqT = (float*)(ws + WS_SSQ + 4 * SZ_SSQ16 + SZ_SSQ8);
    const int h = wave, kvh = h >> 2; const float sink = kin(24)[l * 8 + h];
    const int c = (int)blockIdx.x; const bool deal = (gridDim.x == 256);
    for (int k = 0; k < 640; ++k) {
        int bu;
        if (deal) { if (c >= 128) { if (k < 3) bu = 3 * (c - 128) + k; else break; } else { if (k < 2) bu = 384 + 2 * c + k; else break; } }
        else { bu = c + k * (int)gridDim.x; if (bu >= 512 + DB) break; }
        if (bu < 512) { const int b = bu >> 6, q0 = (bu & 63) * 32;
            attn_wave(QB, KP + (size_t)b * SEQ * 128 + kvh * 64, VTP + (size_t)(b * 2 + kvh) * 64 * 2048, 2048, b * SEQ + q0, 32, q0, sink, YA, ssqT, h, lane);
        } else { const int sb = bu - 512;
            attn_wave(QB, KS + (size_t)(l * DB + sb) * 160 * 128 + kvh * 64, VTS + (size_t)((l * DB + sb) * 2 + kvh) * 64 * 160, 160, MP + sb * 8, 8, 128, sink, YA, ssqT, h, lane);
        }
    }
}

#define XB_TMO      128
#define XB_XCNT(j)  (256  + 64 * (j))
#define XB_XSUB(j)  (1280 + 64 * (j))
#define XB_XGEN(j)  (2304 + 64 * (j))
#define XB_TOP      3328
#define XB_TOPGEN   3392
#define XCD_BAR_WORDS 3456
#define XB_SPIN_CAP (1u << 18)
#define LAS __attribute__((address_space(3)))

__device__ __forceinline__ unsigned xb_ld(unsigned* p)              { return __hip_atomic_load(p, __ATOMIC_RELAXED, __HIP_MEMORY_SCOPE_AGENT); }
__device__ __forceinline__ unsigned xb_add(unsigned* p, unsigned v) { return __hip_atomic_fetch_add(p, v, __ATOMIC_RELAXED, __HIP_MEMORY_SCOPE_AGENT); }
__device__ __forceinline__ unsigned xb_xcc_id() { return (unsigned)__builtin_amdgcn_s_getreg((3 << 11) | 20) & 0xFu; }
#define XB_SPIN(cond, bar) do { unsigned _sp = 0; while (cond) { __builtin_amdgcn_s_sleep(1); \
    if ((++_sp & 255u) == 0u) { if (xb_ld(&(bar)[XB_TMO])) break; if (_sp > XB_SPIN_CAP) { atomicAdd(&(bar)[XB_TMO], 1u); break; } } } } while (0)

struct XcdBarrier {
    unsigned* bar; unsigned x;
    volatile LAS unsigned* st;
};

__device__ __forceinline__ XcdBarrier xcd_barrier_post(unsigned* bar, volatile LAS unsigned* st) {
    XcdBarrier b; b.bar = bar; b.x = xb_xcc_id(); b.st = st;
    if (threadIdx.x == 0) (void)xb_add(&bar[XB_XCNT(b.x)], 1u);
    return b;
}
__device__ __forceinline__ void xcd_barrier_complete(unsigned* bar, unsigned x, unsigned& nloc, unsigned& nx) {
    const unsigned G = gridDim.x * gridDim.y * gridDim.z;
    unsigned sum, cnt, mine, sp = 0u;
    for (;;) {
        sum = 0u; cnt = 0u; mine = 0u;
#pragma unroll
        for (unsigned j = 0; j < 16; ++j) { const unsigned c = xb_ld(&bar[XB_XCNT(j)]); sum += c; cnt += (c > 0u) ? 1u : 0u; mine = (j == x) ? c : mine; }
        if (sum == G) break;
        __builtin_amdgcn_s_sleep(1);
        if ((++sp & 255u) == 0u) { if (xb_ld(&bar[XB_TMO])) break; if (sp > XB_SPIN_CAP) { atomicAdd(&bar[XB_TMO], 1u); break; } }
    }
    nloc = mine > 0u ? mine : 1u; nx = cnt > 0u ? cnt : 1u;
}

__device__ __forceinline__ void xcd_barrier(const XcdBarrier& b) {
    asm volatile("s_waitcnt vmcnt(0)" ::: "memory");
    __syncthreads();
    if (pg8::tid_from_lds((const volatile LAS unsigned*)(b.st + 4)) == 0) {
        unsigned* bar = b.bar;
        __builtin_amdgcn_s_waitcnt(0);
        unsigned nloc = b.st[0], nx = b.st[1];
        if (nloc == 0u) { xcd_barrier_complete(bar, b.x, nloc, nx); b.st[0] = nloc; b.st[1] = nx; }
        const unsigned old = xb_add(&bar[XB_XSUB(b.x)], 1u);
        const unsigned gen = old / nloc;
        if (old + 1u == (gen + 1u) * nloc) {
            __builtin_amdgcn_fence(__ATOMIC_RELEASE, "agent");
            asm volatile("s_waitcnt vmcnt(0)" ::: "memory");
            const unsigned og = xb_add(&bar[XB_TOP], 1u);
            const unsigned tg = og / nx;
            if (og + 1u == (tg + 1u) * nx) xb_add(&bar[XB_TOPGEN], 1u);
            else XB_SPIN(xb_ld(&bar[XB_TOPGEN]) == tg, bar);
            __builtin_amdgcn_fence(__ATOMIC_ACQUIRE, "agent");
            xb_add(&bar[XB_XGEN(b.x)], 1u);
            asm volatile("s_waitcnt vmcnt(0)" ::: "memory");
        } else {
            XB_SPIN(xb_ld(&bar[XB_XGEN(b.x)]) == gen, bar);
            __builtin_amdgcn_fence(__ATOMIC_ACQUIRE, "agent");
            asm volatile("s_waitcnt vmcnt(0)" ::: "memory");
        }
    }
    __syncthreads();
}

__device__ __forceinline__ void gbar(unsigned char* lds) {
    XcdBarrier b; b.bar = (unsigned*)(kws() + WS_BAR); b.x = xb_xcc_id(); b.st = (volatile LAS unsigned*)(lds + ST_OFF);
    xcd_barrier(b);
}
#define PH_BEGIN unsigned char* ws = kws(); float* out = kout(); (void)out; \
    bf16_t* XBa = (bf16_t*)(ws + WS_XB0); bf16_t* XBb = (bf16_t*)(ws + WS_XB1); bf16_t* HB = (bf16_t*)(ws + WS_HB); (void)XBa; (void)XBb; (void)HB; \
    const bf16_t* WL = (const bf16_t*)(ws + WS_W) + (size_t)l * E_WLAYER; (void)WL; \
    float* ssq0 = (float*)(ws + WS_SSQ); float* ssq1 = (float*)(ws + WS_SSQ + SZ_SSQ16); float* ssq2 = (float*)(ws + WS_SSQ + 2 * SZ_SSQ16); float* ssq3 = (float*)(ws + WS_SSQ + 3 * SZ_SSQ16); \
    float* ssqS = (float*)(ws + WS_SSQ + 4 * SZ_SSQ16); float* ssqT = (float*)(ws + WS_SSQ + 4 * SZ_SSQ16 + SZ_SSQ8); (void)ssq0; (void)ssq1; (void)ssq2; (void)ssq3; (void)ssqS; (void)ssqT;

__global__ void __launch_bounds__(512, 2) mega_fwd(Args a_unused) {
    extern __shared__ __attribute__((aligned(16))) unsigned char lds[];
    cg::grid_group grid = cg::this_grid();
    if (gridDim.x == 0x7fffffffu) grid.sync();
    if (threadIdx.x < 4) ((volatile LAS unsigned*)(lds + ST_OFF))[threadIdx.x] = 0u;
    if ((threadIdx.x & 63) == 0) ((volatile LAS unsigned*)(lds + ST_OFF + 16))[(unsigned)__builtin_amdgcn_s_getreg((5 << 11) | 4) & 63u] = threadIdx.x >> 6;
    __syncthreads();
    (void)xcd_barrier_post((unsigned*)(kws() + WS_BAR), (volatile LAS unsigned*)(lds + ST_OFF));
    {
        int tid = MYTID(); asm volatile("" : "+v"(tid)); const int lane = tid & 63, wave = __builtin_amdgcn_readfirstlane(tid >> 6);
        p0_phase(lds, wave, lane);
    }
    gbar(lds);
#pragma nounroll
    for (int l = 0; l < NL; ++l) {
        { PH_BEGIN EpiSwiglu E{HB, ssq0}; run_gemm(lds, XBa, WL + OW_GU1, 2 * FF, D, E, M); }
        if (l == 0 && bid() >= 216) { int tid = MYTID(); asm volatile("" : "+v"(tid)); const int lane = tid & 63, wave = __builtin_amdgcn_readfirstlane(tid >> 6);
            conv_weights(lds, wave, lane, 0, 2 * 16 * 88, 3 * 16 * 88, (bid() - 216) * 8 + wave, (gdim() - 216) * 8); }
        gbar(lds);
        { PH_BEGIN EpiRes<0, true> E{XBa, XBb, ssq1, nullptr, nullptr}; run_gemm(lds, HB, WL + OW_D1, D, FF, E); }
        { PH_BEGIN SMALL(1, 16, 0, {HB, FF, WL + OW_D1, FF, l, 1, 1, 0, 0, 0}) }
        { int tid = MYTID(); asm volatile("" : "+v"(tid)); const int lane = tid & 63, wave = __builtin_amdgcn_readfirstlane(tid >> 6);
          if (l == 0) { conv_weights(lds, wave, lane, 0, 3 * 16 * 88, I_LAYER_ALL, bid() * 8 + wave, gdim() * 8); p0_misc(wave, lane, bid(), gdim()); }
        }
        gbar(lds);
        { PH_BEGIN EpiIn E{HB, (bf16_t*)(ws + WS_HB + SZ_512), (bf16_t*)(ws + WS_KP), (bf16_t*)(ws + WS_VTP), (bf16_t*)(ws + WS_KS), (bf16_t*)(ws + WS_VTS), ssq1, out + O_KP, out + O_VP, out + O_KS, out + O_VS, l};
          run_gemm(lds, XBb, WL + OW_IN, INW, D, E, M); }
        if (l + 1 < NL && bid() >= 84) { int tid = MYTID(); asm volatile("" : "+v"(tid)); const int lane = tid & 63, wave = __builtin_amdgcn_readfirstlane(tid >> 6);
            conv_weights(lds, wave, lane, l + 1, 0, I_LAYER_ALL, (bid() - 84) * 8 + wave, (gdim() - 84) * 8); }
        if (l + 1 == NL && bid() >= 84) {
            { PH_BEGIN EpiBf E{(bf16_t*)out, D}; run_gemm(lds, (const bf16_t*)(ws + WS_PB) + (size_t)l * M * 256, WL + OW_PP, D, 256, E, MP, 84); }
            { PH_BEGIN SMALL(4, 16, 84, {(const bf16_t*)(ws + WS_PB) + (size_t)l * M * 256, 256, WL + OW_PP, 256, l, 0, 0, 0, 0, 0}) } }
        gbar(lds);
        {
            int tid = MYTID(); asm volatile("" : "+v"(tid)); const int lane = tid & 63, wave = __builtin_amdgcn_readfirstlane(tid >> 6);
            ssm_phase(lds, l, wave, lane);
        }
        gbar(lds);
        { PH_BEGIN const bf16_t* YG = (const bf16_t*)(ws + WS_HB + 2 * SZ_512); EpiGlu E{YG, (bf16_t*)(ws + WS_HB + 3 * SZ_512), ssqS}; run_gemm(lds, YG, WL + OW_GLU, 512, 512, E); }
        { PH_BEGIN SMALL(3, 8, 128, {(const bf16_t*)(ws + WS_HB + 2 * SZ_512), 512, WL + OW_GLU, 512, l, 0, 0, 0, 0, 0}) }
        {
            int tid = MYTID(); asm volatile("" : "+v"(tid)); const int lane = tid & 63, wave = __builtin_amdgcn_readfirstlane(tid >> 6);
            attn_phase(l, wave, lane);
        }
        gbar(lds);
        { PH_BEGIN SMALL(1, 16, 0, {(const bf16_t*)(ws + WS_HB + 3 * SZ_512), 512, WL + OW_OA, 512, l, 0, -1, 0, 1, 1}) }
        { PH_BEGIN EpiRes<1, true> E{XBb, XBa, ssq2, ssqT, (const bf16_t*)ssqS};
          run_gemm2(lds, (const bf16_t*)(ws + WS_HB + 3 * SZ_512), WL + OW_OA, (const bf16_t*)(ws + WS_HB + 4 * SZ_512), WL + OW_OB, D, 512, E); }
        { PH_BEGIN SMALL(1, 16, 0, {(const bf16_t*)(ws + WS_HB + 4 * SZ_512), 512, WL + OW_OB, 512, l, 0, 2, 1, 1, 0}) }
        gbar(lds);
        { PH_BEGIN EpiSwiglu E{HB, ssq2}; run_gemm(lds, XBa, WL + OW_GU2, 2 * FF, D, E, M); }
        gbar(lds);
        { PH_BEGIN EpiRes<0, true> E{XBa, XBb, ssq3, nullptr, nullptr}; run_gemm(lds, HB, WL + OW_D2, D, FF, E); }
        { PH_BEGIN SMALL(1, 16, 0, {HB, FF, WL + OW_D2, FF, l, 1, 3, 0, 0, 0}) }
        if (l + 1 < NL) {
            { PH_BEGIN EpiBf E{(bf16_t*)out, D}; run_gemm(lds, (const bf16_t*)(ws + WS_PB) + (size_t)l * M * 256, WL + OW_PP, D, 256, E); }
            { PH_BEGIN SMALL(4, 16, 0, {(const bf16_t*)(ws + WS_PB) + (size_t)l * M * 256, 256, WL + OW_PP, 256, l, 0, 0, 0, 0, 0}) } }
        gbar(lds);
        { PH_BEGIN EpiRes<2, true> E{XBb, XBa, ssq0, ssq3, (const bf16_t*)out}; run_gemm(lds, XBb, WL + OW_PG, D, D, E); }
        { PH_BEGIN SMALL(1, 16, 0, {XBb, D, WL + OW_PG, D, l, 0, 0, 3, 2, 1}) }
        gbar(lds);
    }
    {
        int tid = MYTID(); asm volatile("" : "+v"(tid)); const int lane = tid & 63, wave = __builtin_amdgcn_readfirstlane(tid >> 6);
        unsigned char* ws = kws(); float* out = kout(); const float* ssq0 = (const float*)(ws + WS_SSQ); const bf16_t* XBa = (const bf16_t*)(ws + WS_XB0);
        const float* gfin = kin(34);
        for (int m = bid() * 8 + wave; m < M; m += gdim() * 8) {
            float t = (lane < 16) ? ssq0[(size_t)m * 16 + lane] : 0.f; t = wave_sum(t);
            const float rs = __builtin_amdgcn_rsqf(t * (1.f / 1024.f) + 1e-6f);
#pragma unroll
            for (int j = 0; j < 2; ++j) {
                const int c = 512 * j + 8 * lane; const u32x4 xw = *(const u32x4*)(XBa + (size_t)m * D + c);
                const f32x4 g0 = *(const f32x4*)(gfin + c), g1 = *(const f32x4*)(gfin + c + 4);
                f32x4 y0 = {bflo(xw.x), bfhi(xw.x), bflo(xw.y), bfhi(xw.y)}, y1 = {bflo(xw.z), bfhi(xw.z), bflo(xw.w), bfhi(xw.w)};
                y0 = y0 * rs * g0; y1 = y1 * rs * g1;
                *(f32x4*)(out + (size_t)m * D + c) = y0; *(f32x4*)(out + (size_t)m * D + c + 4) = y1;
            }
        }
    }
}

extern "C" void kernel_launch(void* const* d_in, const int* in_sizes, int n_in, void* d_out, int out_size, void* d_ws, size_t ws_size, hipStream_t stream) {
    static int grid_blocks = 0;
    if (!grid_blocks) {
        int dev = 0, cus = 0, per_cu = 0;
        hipGetDevice(&dev);
        hipDeviceGetAttribute(&cus, hipDeviceAttributeMultiprocessorCount, dev);
        hipFuncSetAttribute((const void*)mega_fwd, hipFuncAttributeMaxDynamicSharedMemorySize, LDS_BYTES);
        hipOccupancyMaxActiveBlocksPerMultiprocessor(&per_cu, (const void*)mega_fwd, 512, LDS_BYTES);
        if (per_cu < 1) per_cu = 1;
        if (cus < 1) cus = 256;
        grid_blocks = cus * per_cu;
        if (ws_size < WS_END) fprintf(stderr, "kernel_launch: workspace too small: %zu < %zu\n", ws_size, (size_t)WS_END);
    }
    if (hipMemsetAsync((char*)d_ws + WS_BAR, 0, 16384, stream) != hipSuccess) fprintf(stderr, "memset failed\n");
    Args a{};
    for (int i = 0; i < NIN; ++i) a.in[i] = (const float*)d_in[i];
    a.out = (float*)d_out; a.ws = (unsigned char*)d_ws;
    void* args[] = {&a};
    hipError_t e = hipLaunchCooperativeKernel((const void*)mega_fwd, dim3(grid_blocks), dim3(512), args, LDS_BYTES, stream);
    if (e != hipSuccess) fprintf(stderr, "cooperative launch failed: %s (grid %d)\n", hipGetErrorString(e), grid_blocks);
}
```

```cpp
#include <hip/hip_runtime.h>
#include <hip/hip_cooperative_groups.h>
#include <cstdio>
#include <cstdint>
namespace pg8 {
#define PG8_LAS __attribute__((address_space(3)))
typedef unsigned short bf16_t;
typedef short bf16x8 __attribute__((ext_vector_type(8)));
typedef float f32x4 __attribute__((ext_vector_type(4)));
typedef unsigned u32x4 __attribute__((ext_vector_type(4)));
constexpr int BM = 256, BK = 64, HALF = 128, HTB = HALF * BK * 2  , STAGE_BYTES = 8 * HTB, NXCD = 8, WGM = 8;

__host__ __device__ __forceinline__ int lds_byte(int r, int c) { const int st = (r >> 4) * 2 + (c >> 5), rr = r & 15, cc = c & 31, ob = rr * 64 + cc * 2; return st * 1024 + (ob ^ (((ob >> 9) & 1) << 5)); }
__host__ __device__ __forceinline__ void stage_rc(int b, int& R, int& C) { const int st = b / 1024, sb = b % 1024, swz = sb ^ (((sb >> 9) & 1) << 5); R = (st >> 1) * 16 + swz / 64; C = (st & 1) * 32 + (swz % 64) / 2; }
__host__ __device__ __forceinline__ int perm32(int rho) { const int n = rho >> 4, i = rho & 15; return 8 * (i >> 2) + 4 * n + (i & 3); }

struct Unit { int pm, pn, seg; };
struct Gemm { const bf16_t* A; const bf16_t* Bt; int M, N, K; const bf16_t* A2; const bf16_t* Bt2; };

struct StaticOrder {
    int nM, nN, nwg, G, c;
    __host__ __device__ void init(int M, int N, int G_, int c_) { nM = M / BM; nN = N / BM; nwg = nM * nN; G = G_; c = c_; }
    __host__ __device__ bool next(int i, Unit& u) const {
        const long L = (long)i * G + c; if (L >= nwg) return false;
        int wgid = (int)L; { const int q = nwg / NXCD, r = nwg % NXCD, xcd = wgid % NXCD, off = wgid / NXCD; wgid = (xcd < r ? xcd * (q + 1) : r * (q + 1) + (xcd - r) * q) + off; }
        const int nig = WGM * nN, gid = wgid / nig, fm = gid * WGM, gsz = (nM - fm) < WGM ? (nM - fm) : WGM;
        u.pm = fm + ((wgid % nig) % gsz); u.pn = (wgid % nig) / gsz; u.seg = 0; return true;
    }
    __device__ __forceinline__ void a_ready(const Unit&) const {}
    __device__ __forceinline__ void done(const Unit&) const {}
};
__device__ __forceinline__ unsigned cvt_pk_bf16(float lo, float hi) { unsigned r; asm volatile("v_cvt_pk_bf16_f32 %0, %1, %2" : "=v"(r) : "v"(lo), "v"(hi)); return r; }
typedef float f32x2 __attribute__((ext_vector_type(2)));
__device__ __forceinline__ int tid_from_lds(const volatile PG8_LAS unsigned* tidtab) {
    const unsigned slot = (unsigned)__builtin_amdgcn_s_getreg((5 << 11) | 4) & 63u;
    const int w = __builtin_amdgcn_readfirstlane((int)tidtab[slot]);
    int ln; asm volatile("v_mbcnt_lo_u32_b32 %0, -1, 0\n\tv_mbcnt_hi_u32_b32 %0, -1, %0" : "=v"(ln));
    return w * 64 + ln;
}
constexpr int TIDTAB_OFF = 131072 + 4096 + 16;
struct TwoSegOrder : StaticOrder {
    __host__ __device__ bool next(int i, Unit& u) const { if (!StaticOrder::next(i >> 1, u)) return false; u.seg = i & 1; return true; }
};
template <class Epi, class Sched, bool STAMP = false>
__device__ __forceinline__ void gemm_phase(PG8_LAS unsigned char* lds, const Gemm g, const Sched& S, const Epi& E, unsigned long long* stamps) {
    int tid_l = tid_from_lds((const volatile PG8_LAS unsigned*)(lds + TIDTAB_OFF)); asm volatile("" : "+v"(tid_l)); const int tid = tid_l, wid = __builtin_amdgcn_readfirstlane(tid >> 6), lane = tid & 63, wr = wid >> 2, wc = wid & 3, fr = lane & 15, fq = lane >> 4;
    const int K = g.K, nt = K / BK;
    int ts_lo = 0, ts_hi = 0, nts = 0; const unsigned long long rt_entry = STAMP ? (unsigned long long)wall_clock64() : 0ull;
#define PG8_STAMP() do { if (STAMP && wid == 0 && nts < 64) { const unsigned long long _c = (unsigned long long)clock64(); \
        ts_lo = (lane == nts) ? (int)(unsigned)_c : ts_lo; ts_hi = (lane == nts) ? (int)(unsigned)(_c >> 32) : ts_hi; ++nts; } } while (0)
    PG8_STAMP();
    unsigned voffA[2], voffB[2];
#pragma unroll
    for (int i = 0; i < 2; ++i) { int R, C; stage_rc(tid * 16 + i * 8192, R, C); const int Rb = Epi::PERM ? ((R & ~31) + perm32(R & 31)) : R;
        voffA[i] = (unsigned)(R * K + C) * 2u; voffB[i] = (unsigned)(Rb * K + C) * 2u; }
    const size_t kstep = (size_t)(BK * 2);
    const size_t hstep = (size_t)HALF * K * 2;
    const size_t tstep = 2 * hstep;
    const unsigned ldsw = (unsigned)wid * 1024u;
    const int aoff = lds_byte(wr * 64 + fr, fq * 8), boff = lds_byte(wc * 32 + fr, fq * 8);
#define PG8_SA(b, h) (((b) * 2 + (h)) * HTB)
#define PG8_SB(b, h) ((4 + (b) * 2 + (h)) * HTB)
#define PG8_STAGE(bufoff, gbase, voff) do { _Pragma("unroll") for (int _i = 0; _i < 2; ++_i) \
        __builtin_amdgcn_global_load_lds((const unsigned*)((const char*)(gbase) + (voff)[_i]), (PG8_LAS unsigned*)(lds + (bufoff) + ldsw + _i * 8192), 16, 0, 0); } while (0)
#define PG8_LDA(dst, b, h) do { _Pragma("unroll") for (int m = 0; m < 4; ++m) _Pragma("unroll") for (int k = 0; k < 2; ++k) dst[m][k] = *(const PG8_LAS bf16x8*)(lds + PG8_SA(b, h) + aoff + m * 2048 + k * 1024); } while (0)
#define PG8_LDB(dst, b, h) do { _Pragma("unroll") for (int n = 0; n < 2; ++n) _Pragma("unroll") for (int k = 0; k < 2; ++k) dst[n][k] = *(const PG8_LAS bf16x8*)(lds + PG8_SB(b, h) + boff + n * 2048 + k * 1024); } while (0)
#define PG8_MMA(ai, bj, At, Bt) do { __builtin_amdgcn_s_setprio(1); _Pragma("unroll") for (int m = 0; m < 4; ++m) _Pragma("unroll") for (int n = 0; n < 2; ++n) _Pragma("unroll") for (int k = 0; k < 2; ++k) \
        acc[ai][bj][m][n] = __builtin_amdgcn_mfma_f32_16x16x32_bf16(Bt[n][k], At[m][k], acc[ai][bj][m][n], 0, 0, 0); __builtin_amdgcn_s_setprio(0); } while (0)
#define PG8_WAIT_V(n) asm volatile("s_waitcnt vmcnt(" #n ")" ::: "memory")
#define PG8_WAIT_L(n) asm volatile("s_waitcnt lgkmcnt(" #n ")" ::: "memory")
#define PG8_BAR __builtin_amdgcn_s_barrier()
#define PG8_SCHED __builtin_amdgcn_sched_barrier(0)
    Unit cur, nxt; int ui = 0;
    if (!S.next(0, cur)) return;
    f32x4 acc[2][2][4][2];
#pragma unroll
    for (int a = 0; a < 2; ++a)
#pragma unroll
        for (int b = 0; b < 2; ++b)
#pragma unroll
            for (int m = 0; m < 4; ++m)
#pragma unroll
                for (int n = 0; n < 2; ++n) acc[a][b][m][n] = (f32x4){0.f, 0.f, 0.f, 0.f};
    bf16x8 At[4][2], B0[2][2], B1[2][2];
    const char* cA = (const char*)(cur.seg ? g.A2 : g.A) + (size_t)cur.pm * tstep; const char* cB = (const char*)(cur.seg ? g.Bt2 : g.Bt) + (size_t)cur.pn * tstep;
    S.a_ready(cur);
    PG8_STAGE(PG8_SB(0, 0), cB, voffB); PG8_STAGE(PG8_SB(0, 1), cB + hstep, voffB); PG8_STAGE(PG8_SA(0, 0), cA, voffA); PG8_STAGE(PG8_SA(0, 1), cA + hstep, voffA);
    if (wr == 1) PG8_BAR;
    PG8_WAIT_V(2); PG8_BAR;
    PG8_STAGE(PG8_SB(1, 0), cB + kstep, voffB); PG8_STAGE(PG8_SA(1, 0), cA + kstep, voffA); PG8_STAGE(PG8_SB(1, 1), cB + hstep + kstep, voffB);
    PG8_WAIT_V(6); PG8_BAR;
    PG8_STAMP();
    for (;;) {
        const bool has_next = S.next(ui + 1, nxt);
        const char* nA = has_next ? (const char*)(nxt.seg ? g.A2 : g.A) + (size_t)nxt.pm * tstep : cA; const char* nB = has_next ? (const char*)(nxt.seg ? g.Bt2 : g.Bt) + (size_t)nxt.pn * tstep : cB;
        for (int t = 0; t < nt; t += 2) {
            const bool last = (t == nt - 2);
            const char* a1 = cA + (size_t)(t + 1) * kstep;
            const char* a2 = last ? nA : cA + (size_t)(t + 2) * kstep; const char* b2 = last ? nB : cB + (size_t)(t + 2) * kstep;
            const char* a3 = a2 + kstep; const char* b3 = b2 + kstep;
            if (last && has_next) S.a_ready(nxt);
            PG8_LDB(B0, 0, 0); PG8_LDB(B1, 0, 1); PG8_SCHED; PG8_LDA(At, 0, 0); PG8_STAGE(PG8_SA(1, 1), a1 + hstep, voffA);
            PG8_WAIT_V(8); PG8_WAIT_L(0); PG8_BAR; PG8_MMA(0, 0, At, B0); PG8_MMA(0, 1, At, B1); PG8_BAR; PG8_SCHED;
            PG8_LDA(At, 0, 1); PG8_STAGE(PG8_SB(0, 0), b2, voffB); PG8_STAGE(PG8_SB(0, 1), b2 + hstep, voffB); PG8_STAGE(PG8_SA(0, 0), a2, voffA);
            PG8_WAIT_V(8); PG8_WAIT_L(0); PG8_BAR; PG8_MMA(1, 0, At, B0); PG8_MMA(1, 1, At, B1); PG8_BAR; PG8_SCHED;
            PG8_LDB(B0, 1, 0); PG8_LDB(B1, 1, 1); PG8_SCHED; PG8_LDA(At, 1, 0); PG8_STAGE(PG8_SA(0, 1), a2 + hstep, voffA);
            PG8_WAIT_V(8); PG8_WAIT_L(0); PG8_BAR; PG8_MMA(0, 0, At, B0); PG8_MMA(0, 1, At, B1); PG8_BAR; PG8_SCHED;
            PG8_LDA(At, 1, 1); PG8_STAGE(PG8_SB(1, 0), b3, voffB); PG8_STAGE(PG8_SB(1, 1), b3 + hstep, voffB); PG8_STAGE(PG8_SA(1, 0), a3, voffA);
            PG8_WAIT_V(8); PG8_WAIT_L(0); PG8_BAR; PG8_MMA(1, 0, At, B0); PG8_MMA(1, 1, At, B1); PG8_BAR; PG8_SCHED;
        }
        PG8_STAMP();
        if (wr == 0) PG8_BAR;
        bool keep = false;
        int t2 = tid_from_lds((const volatile PG8_LAS unsigned*)(lds + TIDTAB_OFF)); asm volatile("" : "+v"(t2));
        const int wid2 = __builtin_amdgcn_readfirstlane(t2 >> 6), ln2 = t2 & 63, wr2 = wid2 >> 2, wc2 = wid2 & 3, fr2 = ln2 & 15, fq2 = ln2 >> 4;
        if constexpr (Epi::TWOSEG) { if (cur.seg == 0) { E.between(acc, cur, wr2, wc2, fr2, fq2); keep = true; } }
        if constexpr (!Epi::AFTER_DRAIN) { if (!keep) { E(acc, cur, wr2, wc2, fr2, fq2); S.done(cur); } }
        PG8_STAMP();
        if (!has_next) break;
        if (!keep) {
#pragma unroll
        for (int a = 0; a < 2; ++a)
#pragma unroll
            for (int b = 0; b < 2; ++b)
#pragma unroll
                for (int m = 0; m < 4; ++m)
#pragma unroll
                    for (int n = 0; n < 2; ++n) acc[a][b][m][n] = (f32x4){0.f, 0.f, 0.f, 0.f};
        }
        cur = nxt; cA = nA; cB = nB; ++ui;
        if (wr == 1) PG8_BAR;
    }
    PG8_WAIT_V(0);
    PG8_BAR;
    if constexpr (Epi::AFTER_DRAIN) { E.fused(acc, cur, wr, wc, fr, fq, lds, wid, lane); S.done(cur); }
    PG8_STAMP();
    if (STAMP && wid == 0) { stamps[lane] = lane < nts ? (((unsigned long long)(unsigned)ts_hi << 32) | (unsigned)ts_lo) : 0ull;
        if (lane == 62) stamps[62] = rt_entry; if (lane == 63) stamps[63] = (unsigned long long)wall_clock64(); }
#undef PG8_STAMP
#undef PG8_SA
#undef PG8_SB
#undef PG8_STAGE
#undef PG8_LDA
#undef PG8_LDB
#undef PG8_MMA
#undef PG8_WAIT_V
#undef PG8_WAIT_L
#undef PG8_BAR
#undef PG8_SCHED
}
}

namespace cg = cooperative_groups;
using pg8::bf16_t; using pg8::bf16x8; using pg8::f32x4; using pg8::u32x4; using pg8::Unit; using pg8::cvt_pk_bf16;
typedef float f32x16 __attribute__((ext_vector_type(16)));
typedef unsigned u32x2 __attribute__((ext_vector_type(2)));
typedef float f32x2s __attribute__((ext_vector_type(2)));

constexpr int D = 1024, MP = 16384, MSM = 1024, M = MP + MSM, FF = 2816, INW = 1280;
constexpr int NL = 2, SEQ = 2048, NB = 8, DB = 128;
constexpr int ST_OFF = 131072 + 4096, LDS_BYTES = ST_OFF + 16 + 256;
static_assert(pg8::TIDTAB_OFF == ST_OFF + 16, "tid table offset");
#define MYTID() pg8::tid_from_lds((const volatile LAS unsigned*)(lds + ST_OFF + 16))
constexpr int NIN = 35;

constexpr size_t E_WGU = (size_t)2 * FF * D, E_WD = (size_t)D * FF, E_WIN = (size_t)INW * D, E_WGLU = 512 * 512, E_WO = 1024 * 512, E_WPG = 1024 * 1024, E_WPP = 1024 * 256;
constexpr size_t OW_GU1 = 0, OW_D1 = OW_GU1 + E_WGU, OW_IN = OW_D1 + E_WD, OW_GLU = OW_IN + E_WIN, OW_OA = OW_GLU + E_WGLU, OW_OB = OW_OA + E_WO,
                 OW_GU2 = OW_OB + E_WO, OW_D2 = OW_GU2 + E_WGU, OW_PG = OW_D2 + E_WD, OW_PP = OW_PG + E_WPG, E_WLAYER = OW_PP + E_WPP;
constexpr size_t WS_W = 0;
constexpr size_t WS_XB0 = WS_W + 2 * E_WLAYER * 2;
constexpr size_t WS_XB1 = WS_XB0 + (size_t)M * D * 2;
constexpr size_t WS_HB = WS_XB1 + (size_t)M * D * 2;
constexpr size_t SZ_512 = (size_t)M * 512 * 2;
constexpr size_t WS_KP = WS_HB + (size_t)M * FF * 2;
constexpr size_t WS_VTP = WS_KP + (size_t)MP * 128 * 2;
constexpr size_t WS_KS = WS_VTP + (size_t)MP * 128 * 2;
constexpr size_t WS_VTS = WS_KS + (size_t)NL * DB * 160 * 128 * 2;
constexpr size_t WS_PB = WS_VTS + (size_t)NL * DB * 160 * 128 * 2;
constexpr size_t WS_SSQ = WS_PB + (size_t)NL * M * 256 * 2;
constexpr size_t SZ_SSQ16 = (size_t)M * 16 * 4, SZ_SSQ8 = (size_t)M * 8 * 4;
constexpr size_t WS_TAB = WS_SSQ + 4 * SZ_SSQ16 + 2 * SZ_SSQ8;
constexpr size_t TAB_BB = 0, TAB_CM = 131072, TAB_AR = 262144, TAB_AI = TAB_AR + 8192, TAB_A2R = TAB_AI + 8192, TAB_A2I = TAB_A2R + 8192, TAB_LAYER = TAB_A2I + 8192;
constexpr size_t WS_BAR = WS_TAB + NL * TAB_LAYER;
constexpr size_t WS_END = WS_BAR + 16384;

constexpr size_t O_Y = 0, O_KP = (size_t)M * D, O_VP = O_KP + (size_t)NL * NB * 128 * 128, O_HPR = O_VP + (size_t)NL * NB * 128 * 128, O_HPI = O_HPR + (size_t)NL * NB * 32 * 64,
                 O_KS = O_HPI + (size_t)NL * NB * 32 * 64, O_VS = O_KS + (size_t)NL * DB * 128 * 128, O_HSR = O_VS + (size_t)NL * DB * 128 * 128, O_HSI = O_HSR + (size_t)NL * DB * 32 * 64;

struct Args { const float* in[NIN]; float* out; unsigned char* ws; };
typedef const __attribute__((address_space(4))) unsigned long long* kargp_t;
__device__ __forceinline__ kargp_t kbase() { kargp_t p = (kargp_t)__builtin_amdgcn_kernarg_segment_ptr(); asm volatile("" : "+s"(p)); return p; }
__device__ __forceinline__ const float* kin(int i) { return (const float*)kbase()[i]; }
__device__ __forceinline__ float* kout() { return (float*)kbase()[NIN]; }
__device__ __forceinline__ unsigned char* kws() { return (unsigned char*)kbase()[NIN + 1]; }

__device__ __forceinline__ int bid() { int b = (int)blockIdx.x; asm volatile("" : "+s"(b)); return b; }
__device__ __forceinline__ int gdim() { int g = (int)gridDim.x; asm volatile("" : "+s"(g)); return g; }
__device__ __forceinline__ float wave_sum(float v) {
#pragma unroll
    for (int o = 1; o < 64; o <<= 1) v += __shfl_xor(v, o);
    return v;
}
__device__ __forceinline__ float sigm(float x) { return __builtin_amdgcn_rcpf(1.0f + __builtin_amdgcn_exp2f(-1.44269504f * x)); }
__device__ __forceinline__ float silu_f(float x) { return x * sigm(x); }
__device__ __forceinline__ float gelu_tanh(float x) { return x * sigm(1.5957691216f * (x + 0.044715f * x * x * x)); }
__device__ __forceinline__ float bf2f(unsigned short b) { return __uint_as_float(((unsigned)b) << 16); }
__device__ __forceinline__ float bflo(unsigned w) { return __uint_as_float(w << 16); }
__device__ __forceinline__ float bfhi(unsigned w) { return __uint_as_float(w & 0xffff0000u); }
__device__ __forceinline__ unsigned short f2bf(float f) { return (unsigned short)(cvt_pk_bf16(f, 0.f) & 0xffffu); }
__device__ __forceinline__ int vt_idx(int t, int d) { const int u = t & 15; return (t >> 4) * 1024 + d * 16 + (((u >> 2) & 1) << 3) + ((u >> 3) << 2) + (u & 3); }
__device__ __forceinline__ float rs16(const float* ssq, int row) {
    const f32x4* p = (const f32x4*)(ssq + (size_t)row * 16); const f32x4 a = p[0], b = p[1], c = p[2], d = p[3]; const f32x4 s = (a + b) + (c + d);
    return __builtin_amdgcn_rsqf(((s.x + s.y) + (s.z + s.w)) * (1.f / 1024.f) + 1e-6f);
}
__device__ __forceinline__ float rs16c(const float* ssq, int row, int fq) {
    const f32x4 a = *(const f32x4*)(ssq + (size_t)row * 16 + 4 * fq); float s = (a.x + a.y) + (a.z + a.w); s += __shfl_xor(s, 16); s += __shfl_xor(s, 32);
    return __builtin_amdgcn_rsqf(s * (1.f / 1024.f) + 1e-6f);
}
__device__ __forceinline__ float rs8(const float* ssq, int row) {
    const f32x4* p = (const f32x4*)(ssq + (size_t)row * 8); const f32x4 a = p[0], b = p[1]; const f32x4 s = a + b;
    return __builtin_amdgcn_rsqf(((s.x + s.y) + (s.z + s.w)) * (1.f / 512.f) + 1e-6f);
}


struct EpiSwiglu {
    static constexpr bool PERM = true, AFTER_DRAIN = false, TWOSEG = false;
    bf16_t* H; const float* ssq;
    __device__ __forceinline__ void operator()(const f32x4 (&acc)[2][2][4][2], const Unit& u, int wr, int wc, int fr, int fq) const {
        const int row0 = u.pm * 256 + wr * 64 + fr, col0 = u.pn * 128 + wc * 32 + 8 * fq;
#pragma unroll
        for (int ai = 0; ai < 2; ++ai)
#pragma unroll
            for (int m = 0; m < 4; ++m) {
                const int row = row0 + ai * 128 + m * 16; const float rs = rs16c(ssq, row, fq);
                const float c1 = -1.44269504f * rs, c2 = rs * rs;
                unsigned wq[4];
#pragma unroll
                for (int n = 0; n < 2; ++n)
#pragma unroll
                    for (int jp = 0; jp < 2; ++jp) {
                        const f32x2s g = {acc[ai][0][m][n][2 * jp], acc[ai][0][m][n][2 * jp + 1]}, up = {acc[ai][1][m][n][2 * jp], acc[ai][1][m][n][2 * jp + 1]};
                        const f32x2s t = g * c1;
                        f32x2s d = {__builtin_amdgcn_exp2f(t.x), __builtin_amdgcn_exp2f(t.y)}; d = d + 1.0f;
                        const float r = __builtin_amdgcn_rcpf(d.x * d.y);
                        const f32x2s inv = (f32x2s){d.y, d.x} * r;
                        const f32x2s hh = ((g * up) * c2) * inv;
                        wq[n * 2 + jp] = cvt_pk_bf16(hh.x, hh.y);
                    }
                u32x4 w; w.x = wq[0]; w.y = wq[1]; w.z = wq[2]; w.w = wq[3];
                *(u32x4*)(H + (size_t)row * FF + col0) = w;
            }
    }
};

template <int MODE, bool WXB> struct EpiRes {
    static constexpr bool PERM = true, AFTER_DRAIN = false, TWOSEG = (MODE == 1);
    const bf16_t* xin; bf16_t* xb; float* ssq_out; const float* ssq_in; const bf16_t* pp;
    __device__ __forceinline__ void between(f32x4 (&acc)[2][2][4][2], const Unit& u, int wr, int wc, int fr, int fq) const {
        const int row0 = u.pm * 256 + wr * 64 + fr;
#pragma unroll
        for (int ai = 0; ai < 2; ++ai)
#pragma unroll
            for (int m = 0; m < 4; ++m) { const int row = row0 + ai * 128 + m * 16; const float ratio = rs8((const float*)pp, row) / rs8(ssq_in, row);
#pragma unroll
                for (int bj = 0; bj < 2; ++bj)
#pragma unroll
                    for (int n = 0; n < 2; ++n) acc[ai][bj][m][n] *= ratio; }
    }
    __device__ __forceinline__ void operator()(const f32x4 (&acc)[2][2][4][2], const Unit& u, int wr, int wc, int fr, int fq) const {
        const int row0 = u.pm * 256 + wr * 64 + fr, col0 = u.pn * 256 + wc * 32 + 8 * fq;
#pragma unroll
        for (int ai = 0; ai < 2; ++ai)
#pragma unroll
            for (int m = 0; m < 4; ++m) {
                const int row = row0 + ai * 128 + m * 16; float rs = 0.5f;
                if (MODE == 1) rs = rs8(ssq_in, row);
                if (MODE == 2) rs = rs16c(ssq_in, row, fq);
                float s = 0.f;
#pragma unroll
                for (int bj = 0; bj < 2; ++bj) {
                    const size_t off = (size_t)row * D + col0 + bj * 128;
                    const u32x4 xw = *(const u32x4*)(xin + off); const f32x4 a0 = acc[ai][bj][m][0], a1 = acc[ai][bj][m][1];
                    float xv[8] = {bflo(xw.x), bfhi(xw.x), bflo(xw.y), bfhi(xw.y), bflo(xw.z), bfhi(xw.z), bflo(xw.w), bfhi(xw.w)};
                    const float av[8] = {a0.x, a0.y, a0.z, a0.w, a1.x, a1.y, a1.z, a1.w};
                    if (MODE == 2) {
                        const u32x4 pw = *(const u32x4*)(pp + off);
                        const float pv[8] = {bflo(pw.x), bfhi(pw.x), bflo(pw.y), bfhi(pw.y), bflo(pw.z), bfhi(pw.z), bflo(pw.w), bfhi(pw.w)};
#pragma unroll
                        for (int q = 0; q < 8; ++q) xv[q] += pv[q] * sigm(rs * av[q]);
                    } else {
#pragma unroll
                        for (int q = 0; q < 8; ++q) xv[q] += av[q] * rs;
                    }
                    u32x4 w; w.x = cvt_pk_bf16(xv[0], xv[1]); w.y = cvt_pk_bf16(xv[2], xv[3]); w.z = cvt_pk_bf16(xv[4], xv[5]); w.w = cvt_pk_bf16(xv[6], xv[7]);
                    *(u32x4*)(xb + off) = w;
#pragma unroll
                    for (int q = 0; q < 8; ++q) s += xv[q] * xv[q];
                }
                if (WXB) { s += __shfl_xor(s, 16); s += __shfl_xor(s, 32); if (fq == 0) ssq_out[(size_t)row * 16 + u.pn * 4 + wc] = s; }
            }
    }
};

struct EpiIn {
    static constexpr bool PERM = true, AFTER_DRAIN = false, TWOSEG = false;
    bf16_t *UB, *QB, *KP, *VTP, *KS, *VTS; const float* ssq; float *okp, *ovp, *oks, *ovs; int l;
    __device__ __forceinline__ void operator()(const f32x4 (&acc)[2][2][4][2], const Unit& u, int wr, int wc, int fr, int fq) const {
        const int row0 = u.pm * 256 + wr * 64 + fr, cw = wc * 32 + 8 * fq;
#pragma unroll
        for (int ai = 0; ai < 2; ++ai)
#pragma unroll
            for (int m = 0; m < 4; ++m) {
                const int row = row0 + ai * 128 + m * 16; const float rs = rs16c(ssq, row, fq);
                if (u.pn < 4) {
                    const float sc = (u.pn < 2) ? rs : rs * 0.125f; bf16_t* dst = QB + (size_t)row * 512 + (u.pn & 1) * 256 + cw;
#pragma unroll
                    for (int bj = 0; bj < 2; ++bj) { const f32x4 v0 = acc[ai][bj][m][0] * sc, v1 = acc[ai][bj][m][1] * sc;
                        u32x4 w; w.x = cvt_pk_bf16(v0.x, v0.y); w.y = cvt_pk_bf16(v0.z, v0.w); w.z = cvt_pk_bf16(v1.x, v1.y); w.w = cvt_pk_bf16(v1.z, v1.w);
                        if (u.pn < 2) { const int c = (u.pn & 1) * 256 + cw + bj * 128;
                            *(u32x4*)(UB + ((size_t)(row >> 5) * 32 + (c >> 4)) * 512 + (row & 31) * 16 + (c & 15)) = w; }
                        else *(u32x4*)(dst + bj * 128) = w; }
                } else {
                    const f32x4 k0 = acc[ai][0][m][0] * rs, k1 = acc[ai][0][m][1] * rs, v0 = acc[ai][1][m][0] * rs, v1 = acc[ai][1][m][1] * rs;
                    u32x4 kw; kw.x = cvt_pk_bf16(k0.x, k0.y); kw.y = cvt_pk_bf16(k0.z, k0.w); kw.z = cvt_pk_bf16(k1.x, k1.y); kw.w = cvt_pk_bf16(k1.z, k1.w);
                    const float vv[8] = {v0.x, v0.y, v0.z, v0.w, v1.x, v1.y, v1.z, v1.w};
                    const int kvh = cw >> 6, d0 = cw & 63;
                    if (row < MP) {
                        const int b = row >> 11, t = row & 2047;
                        *(u32x4*)(KP + (size_t)row * 128 + cw) = kw;
                        bf16_t* vt = VTP + (size_t)(b * 2 + kvh) * 131072;
#pragma unroll
                        for (int j = 0; j < 8; ++j) vt[vt_idx(t, d0 + j)] = f2bf(vv[j]);
                        if (t >= 1920) { const size_t o = ((size_t)(l * NB + b) * 128 + (t - 1920)) * 128 + cw;
                            *(f32x4*)(okp + o) = k0; *(f32x4*)(okp + o + 4) = k1; *(f32x4*)(ovp + o) = v0; *(f32x4*)(ovp + o + 4) = v1; }
                    } else {
                        const int r = row - MP, b = r >> 3, s = r & 7;
                        *(u32x4*)(KS + ((size_t)(l * DB + b) * 160 + 128 + s) * 128 + cw) = kw;
                        bf16_t* vt = VTS + (size_t)((l * DB + b) * 2 + kvh) * 10240;
#pragma unroll
                        for (int j = 0; j < 8; ++j) vt[vt_idx(128 + s, d0 + j)] = f2bf(vv[j]);
                        const size_t o = ((size_t)(l * DB + b) * 128 + 120 + s) * 128 + cw;
                        *(f32x4*)(oks + o) = k0; *(f32x4*)(oks + o + 4) = k1; *(f32x4*)(ovs + o) = v0; *(f32x4*)(ovs + o + 4) = v1;
                    }
                }
            }
    }
};

struct EpiGlu {
    static constexpr bool PERM = true, AFTER_DRAIN = false, TWOSEG = false;
    const bf16_t* YG; bf16_t* YS; float* ssq_out;
    __device__ __forceinline__ void operator()(const f32x4 (&acc)[2][2][4][2], const Unit& u, int wr, int wc, int fr, int fq) const {
        const int row0 = u.pm * 256 + wr * 64 + fr, col0 = u.pn * 256 + wc * 32 + 8 * fq;
#pragma unroll
        for (int ai = 0; ai < 2; ++ai)
#pragma unroll
            for (int m = 0; m < 4; ++m) {
                const int row = row0 + ai * 128 + m * 16; float s = 0.f;
#pragma unroll
                for (int bj = 0; bj < 2; ++bj) {
                    const size_t off = (size_t)row * 512 + col0 + bj * 128; const u32x4 yw = *(const u32x4*)(YG + off);
                    const f32x4 a0 = acc[ai][bj][m][0], a1 = acc[ai][bj][m][1];
                    float o[8];
                    o[0] = bflo(yw.x) * sigm(a0.x); o[1] = bfhi(yw.x) * sigm(a0.y); o[2] = bflo(yw.y) * sigm(a0.z); o[3] = bfhi(yw.y) * sigm(a0.w);
                    o[4] = bflo(yw.z) * sigm(a1.x); o[5] = bfhi(yw.z) * sigm(a1.y); o[6] = bflo(yw.w) * sigm(a1.z); o[7] = bfhi(yw.w) * sigm(a1.w);
#pragma unroll
                    for (int j = 0; j < 8; ++j) s += o[j] * o[j];
                    u32x4 w; w.x = cvt_pk_bf16(o[0], o[1]); w.y = cvt_pk_bf16(o[2], o[3]); w.z = cvt_pk_bf16(o[4], o[5]); w.w = cvt_pk_bf16(o[6], o[7]);
                    *(u32x4*)(YS + off) = w;
                }
                s += __shfl_xor(s, 16); s += __shfl_xor(s, 32); if (fq == 0) ssq_out[(size_t)row * 8 + u.pn * 4 + wc] = s;
            }
    }
};

struct EpiBf {
    static constexpr bool PERM = true, AFTER_DRAIN = false, TWOSEG = false;
    bf16_t* O; int ldc;
    __device__ __forceinline__ void operator()(const f32x4 (&acc)[2][2][4][2], const Unit& u, int wr, int wc, int fr, int fq) const {
        const int row0 = u.pm * 256 + wr * 64 + fr, col0 = u.pn * 256 + wc * 32 + 8 * fq;
#pragma unroll
        for (int ai = 0; ai < 2; ++ai)
#pragma unroll
            for (int m = 0; m < 4; ++m) {
                const int row = row0 + ai * 128 + m * 16;
#pragma unroll
                for (int bj = 0; bj < 2; ++bj) { const f32x4 v0 = acc[ai][bj][m][0], v1 = acc[ai][bj][m][1];
                    u32x4 w; w.x = cvt_pk_bf16(v0.x, v0.y); w.y = cvt_pk_bf16(v0.z, v0.w); w.z = cvt_pk_bf16(v1.x, v1.y); w.w = cvt_pk_bf16(v1.z, v1.w);
                    *(u32x4*)(O + (size_t)row * ldc + col0 + bj * 128) = w; }
            }
    }
};

template <class Epi> __device__ __forceinline__ void run_gemm(unsigned char* lds, const bf16_t* A, const bf16_t* Bt, int N, int K, const Epi& E, int MR = MP, int skip = 0) {
    pg8::Gemm g{A, Bt, MR, N, K}; pg8::StaticOrder S; S.init(MR, N, gdim() - skip, bid() - skip);
    pg8::gemm_phase<Epi, pg8::StaticOrder, false>((PG8_LAS unsigned char*)lds, g, S, E, nullptr);
}

#ifndef MFMA16
#ifndef MFMA16
#define MFMA16(a, b, c) __builtin_amdgcn_mfma_f32_16x16x32_bf16((a), (b), (c), 0, 0, 0)
#endif
#endif

template <class Epi> __device__ __forceinline__ void run_gemm2(unsigned char* lds, const bf16_t* A, const bf16_t* Bt, const bf16_t* A2, const bf16_t* Bt2, int N, int K, const Epi& E, int MR = MP) {
    pg8::Gemm g{A, Bt, MR, N, K, A2, Bt2}; pg8::TwoSegOrder S; S.init(MR, N, gdim(), bid());
    pg8::gemm_phase<Epi, pg8::TwoSegOrder, false>((PG8_LAS unsigned char*)lds, g, S, E, nullptr);
}

template <class BRow>
__device__ __forceinline__ void small_gemm_item(unsigned char* lds, const bf16_t* Arows, int lda, const bf16_t* Bt, int K, const BRow& brow, int wave, int lane) {
    const int fr = lane & 15, fq = lane >> 4, kw = K >> 3, k0 = wave * kw;
    f32x4 acc[4][4];
#pragma unroll
    for (int a = 0; a < 4; ++a)
#pragma unroll
        for (int b = 0; b < 4; ++b) acc[a][b] = (f32x4){0.f, 0.f, 0.f, 0.f};
    const bf16_t* ap = Arows + (size_t)fr * lda + k0 + fq * 8;
    const bf16_t* bp[4];
#pragma unroll
    for (int nb = 0; nb < 4; ++nb) bp[nb] = Bt + (size_t)brow(nb * 16 + fr) * K + k0 + fq * 8;
    for (int kc = 0; kc < kw; kc += 128) {
        bf16x8 a[4][4], b[4][4];
#pragma unroll
        for (int s = 0; s < 4; ++s) {
            if (kc + 32 * s < kw) {
#pragma unroll
                for (int i = 0; i < 4; ++i) { a[s][i] = *(const bf16x8*)(ap + (size_t)i * 16 * lda + kc + 32 * s); b[s][i] = *(const bf16x8*)(bp[i] + kc + 32 * s); }
            }
        }
#pragma unroll
        for (int s = 0; s < 4; ++s) {
            if (kc + 32 * s < kw) {
#pragma unroll
                for (int mb = 0; mb < 4; ++mb)
#pragma unroll
                    for (int nb = 0; nb < 4; ++nb) acc[mb][nb] = MFMA16(b[s][nb], a[s][mb], acc[mb][nb]);
            }
        }
    }
    float* P = (float*)(lds + wave * 16384);
#pragma unroll
    for (int mb = 0; mb < 4; ++mb)
#pragma unroll
        for (int nb = 0; nb < 4; ++nb) { const int mm = mb * 16 + fr; *(f32x4*)(P + mm * 64 + (((nb * 4 + fq) ^ (mm & 7)) << 2)) = acc[mb][nb]; }
}
__device__ __forceinline__ f32x4 small_read(const unsigned char* lds, int mm, int cg) {
    const int o = mm * 64 + ((cg ^ (mm & 7)) << 2);
    f32x4 s = *(const f32x4*)((const float*)lds + o);
#pragma unroll
    for (int w = 1; w < 8; ++w) s += *(const f32x4*)((const float*)(lds + w * 16384) + o);
    return s;
}
struct BRowLin { int base; __device__ __forceinline__ int operator()(int c) const { return base + c; } };
struct BRowGU { int gbase; __device__ __forceinline__ int operator()(int c) const { return gbase + (c & 31) + ((c >> 5) << 7); } };

struct SmallArgs { const bf16_t* A; int lda; const bf16_t* Bt; int K; int l; int xsel, so, si, mode, src; };
template <int KIND>
__device__ __forceinline__ void small_phase(unsigned char* lds, const SmallArgs& sa, int ncb, int skip, int wave, int lane) {
    const int nvb = gdim() - skip, vb = bid() - skip;
    if (vb < 0) return;
    const int tid = wave * 64 + lane, mm = tid >> 3, j = tid & 7;
    for (int id = vb; id < 16 * ncb; id += nvb) {
        int rg = id & 15, cb = id >> 4;
        if (ncb == 16 && skip == 0 && nvb == 256) { const int xcd = id & 7, jj = id >> 3; rg = (xcd >> 1) * 4 + (jj & 3); cb = (xcd & 1) * 8 + (jj >> 2); }
        const bf16_t* Arows = sa.A + (size_t)(MP + rg * 64) * sa.lda;
        if (KIND == 0) { BRowGU br{((cb * 32) >> 7) * 256 + ((cb * 32) & 127)}; small_gemm_item(lds, Arows, sa.lda, sa.Bt, sa.K, br, wave, lane); }
        else { BRowLin br{cb * 64}; small_gemm_item(lds, Arows, sa.lda, sa.Bt, sa.K, br, wave, lane); }
        __syncthreads();
        unsigned char* ws = kws(); float* out = kout();
        const int row = MP + rg * 64 + mm;
        if (KIND == 0) {
            const float rs = rs16((const float*)(ws + WS_SSQ + (size_t)sa.si * SZ_SSQ16), row);
            const f32x4 g = small_read(lds, mm, j) * rs, u = small_read(lds, mm, 8 + j) * rs;
            u32x2 w; w.x = cvt_pk_bf16(silu_f(g.x) * u.x, silu_f(g.y) * u.y); w.y = cvt_pk_bf16(silu_f(g.z) * u.z, silu_f(g.w) * u.w);
            *(u32x2*)((bf16_t*)(ws + WS_HB) + (size_t)row * FF + cb * 32 + 4 * j) = w;
        } else {
            const f32x4 v0 = small_read(lds, mm, 2 * j), v1 = small_read(lds, mm, 2 * j + 1);
            const int col = cb * 64 + 8 * j;
            if (KIND == 1) {
                const bf16_t* xi = (const bf16_t*)(ws + (sa.src ? WS_XB1 : WS_XB0)) + (size_t)row * D + col; bf16_t* xb = (bf16_t*)(ws + (sa.xsel ? WS_XB1 : WS_XB0)) + (size_t)row * D + col;
                const u32x4 xw = *(const u32x4*)xi;
                f32x4 x0 = {bflo(xw.x), bfhi(xw.x), bflo(xw.y), bfhi(xw.y)}, x1 = {bflo(xw.z), bfhi(xw.z), bflo(xw.w), bfhi(xw.w)};
                if (sa.mode == 0) { x0 += v0 * 0.5f; x1 += v1 * 0.5f; }
                else if (sa.mode == 1) { const float rs = rs8((const float*)(ws + WS_SSQ + 4 * SZ_SSQ16 + (size_t)sa.si * SZ_SSQ8), row); x0 += v0 * rs; x1 += v1 * rs; }
                else { const float rs = rs16((const float*)(ws + WS_SSQ + (size_t)sa.si * SZ_SSQ16), row); const u32x4 pw = *(const u32x4*)((const bf16_t*)out + (size_t)row * D + col);
                    x0.x += bflo(pw.x) * sigm(rs * v0.x); x0.y += bfhi(pw.x) * sigm(rs * v0.y); x0.z += bflo(pw.y) * sigm(rs * v0.z); x0.w += bfhi(pw.y) * sigm(rs * v0.w);
                    x1.x += bflo(pw.z) * sigm(rs * v1.x); x1.y += bfhi(pw.z) * sigm(rs * v1.y); x1.z += bflo(pw.w) * sigm(rs * v1.z); x1.w += bfhi(pw.w) * sigm(rs * v1.w); }
                { u32x4 w; w.x = cvt_pk_bf16(x0.x, x0.y); w.y = cvt_pk_bf16(x0.z, x0.w); w.z = cvt_pk_bf16(x1.x, x1.y); w.w = cvt_pk_bf16(x1.z, x1.w); *(u32x4*)xb = w; }
                if (sa.so >= 0) {
                    float s = ((x0.x * x0.x + x0.y * x0.y) + (x0.z * x0.z + x0.w * x0.w)) + ((x1.x * x1.x + x1.y * x1.y) + (x1.z * x1.z + x1.w * x1.w));
                    s += __shfl_xor(s, 1); s += __shfl_xor(s, 2); s += __shfl_xor(s, 4);
                    if (j == 0) ((float*)(ws + WS_SSQ + (size_t)sa.so * SZ_SSQ16))[(size_t)row * 16 + cb] = s;
                }
            } else if (KIND == 2) {
                const float rs = rs16((const float*)(ws + WS_SSQ + SZ_SSQ16), row); const int l = sa.l;
                const int r = row - MP, b = r >> 3, s = r & 7;
                if (cb < 16) { const float sc = (cb < 8) ? rs : rs * 0.125f; const f32x4 a0 = v0 * sc, a1 = v1 * sc;
                    u32x4 w; w.x = cvt_pk_bf16(a0.x, a0.y); w.y = cvt_pk_bf16(a0.z, a0.w); w.z = cvt_pk_bf16(a1.x, a1.y); w.w = cvt_pk_bf16(a1.z, a1.w);
                    *(u32x4*)((bf16_t*)(ws + WS_HB + (cb < 8 ? 0 : SZ_512)) + (size_t)row * 512 + (col & 511)) = w;
                } else { const f32x4 a0 = v0 * rs, a1 = v1 * rs; const int ck = col & 127; const size_t o = ((size_t)(l * DB + b) * 128 + 120 + s) * 128 + ck;
                    if (cb < 18) { u32x4 w; w.x = cvt_pk_bf16(a0.x, a0.y); w.y = cvt_pk_bf16(a0.z, a0.w); w.z = cvt_pk_bf16(a1.x, a1.y); w.w = cvt_pk_bf16(a1.z, a1.w);
                        *(u32x4*)((bf16_t*)(ws + WS_KS) + ((size_t)(l * DB + b) * 160 + 128 + s) * 128 + ck) = w;
                        *(f32x4*)(out + O_KS + o) = a0; *(f32x4*)(out + O_KS + o + 4) = a1;
                    } else { const float vv[8] = {a0.x, a0.y, a0.z, a0.w, a1.x, a1.y, a1.z, a1.w}; const int kvh = ck >> 6, d0 = ck & 63;
                        bf16_t* vt = (bf16_t*)(ws + WS_VTS) + (size_t)((l * DB + b) * 2 + kvh) * 10240;
#pragma unroll
                        for (int q = 0; q < 8; ++q) vt[vt_idx(128 + s, d0 + q)] = f2bf(vv[q]);
                        *(f32x4*)(out + O_VS + o) = a0; *(f32x4*)(out + O_VS + o + 4) = a1; }
                }
            } else if (KIND == 3) {
                const size_t off = (size_t)row * 512 + col; const u32x4 yw = *(const u32x4*)((const bf16_t*)(ws + WS_HB + 2 * SZ_512) + off);
                float o[8];
                o[0] = bflo(yw.x) * sigm(v0.x); o[1] = bfhi(yw.x) * sigm(v0.y); o[2] = bflo(yw.y) * sigm(v0.z); o[3] = bfhi(yw.y) * sigm(v0.w);
                o[4] = bflo(yw.z) * sigm(v1.x); o[5] = bfhi(yw.z) * sigm(v1.y); o[6] = bflo(yw.w) * sigm(v1.z); o[7] = bfhi(yw.w) * sigm(v1.w);
                float s = 0.f;
#pragma unroll
                for (int q = 0; q < 8; ++q) s += o[q] * o[q];
                u32x4 w; w.x = cvt_pk_bf16(o[0], o[1]); w.y = cvt_pk_bf16(o[2], o[3]); w.z = cvt_pk_bf16(o[4], o[5]); w.w = cvt_pk_bf16(o[6], o[7]);
                *(u32x4*)((bf16_t*)(ws + WS_HB + 3 * SZ_512) + off) = w;
                s += __shfl_xor(s, 1); s += __shfl_xor(s, 2); s += __shfl_xor(s, 4);
                if (j == 0) ((float*)(ws + WS_SSQ + 4 * SZ_SSQ16))[(size_t)row * 8 + cb] = s;
            } else {
                u32x4 w; w.x = cvt_pk_bf16(v0.x, v0.y); w.y = cvt_pk_bf16(v0.z, v0.w); w.z = cvt_pk_bf16(v1.x, v1.y); w.w = cvt_pk_bf16(v1.z, v1.w);
                *(u32x4*)((bf16_t*)out + (size_t)row * D + col) = w;
            }
        }
        __syncthreads();
    }
}
#define SMALL(KIND, NCB, SKIP, ...) { int tid_ = MYTID(); asm volatile("" : "+v"(tid_)); const int lane_ = tid_ & 63, wave_ = __builtin_amdgcn_readfirstlane(tid_ >> 6); \
    unsigned char* ws_ = kws(); (void)ws_; SmallArgs sa_ = __VA_ARGS__; small_phase<KIND>(lds, sa_, NCB, SKIP, wave_, lane_); }

__device__ __forceinline__ void tr_item(const float* W, int ldw, const float* gain, bf16_t* WT, int Kd, int k0, int n0, int drow0, float* scr, int lane) {
    float tv[32];
#pragma unroll
    for (int i = 0; i < 32; ++i) { const int kk = 2 * i + (lane >> 5); tv[i] = W[(size_t)(k0 + kk) * ldw + n0 + (lane & 31)]; }
    if (gain) {
#pragma unroll
        for (int i = 0; i < 32; ++i) tv[i] *= gain[k0 + 2 * i + (lane >> 5)]; }
#pragma unroll
    for (int i = 0; i < 32; ++i) scr[(2 * i + (lane >> 5)) * 33 + (lane & 31)] = tv[i];
    asm volatile("s_waitcnt lgkmcnt(0)" ::: "memory");
    const int c = lane & 7;
#pragma unroll
    for (int j = 0; j < 4; ++j) { const int n = (lane >> 3) + 8 * j; const float* s = scr + (8 * c) * 33 + n;
        u32x4 o; o.x = cvt_pk_bf16(s[0 * 33], s[1 * 33]); o.y = cvt_pk_bf16(s[2 * 33], s[3 * 33]); o.z = cvt_pk_bf16(s[4 * 33], s[5 * 33]); o.w = cvt_pk_bf16(s[6 * 33], s[7 * 33]);
        *(u32x4*)(WT + (size_t)(drow0 + n) * Kd + k0 + 8 * c) = o; }
    asm volatile("s_waitcnt lgkmcnt(0)" ::: "memory");
}

__device__ __forceinline__ void cexp_i(double th, double& c, double& s) {
    const double TWO_PI_HI = 6.283185307179586232, TWO_PI_LO = 2.4492935982947064e-16;
    const double k = rint(th * 0.15915494309189534561);
    double r = fma(-k, TWO_PI_HI, th); r = fma(-k, TWO_PI_LO, r);
    const double h = r * 0.125;
    double cr = 1.0, ci = 0.0, tr = 1.0, ti = 0.0;
    for (int n = 1; n <= 16; ++n) { const double nr = -ti * h / n, ni = tr * h / n; tr = nr; ti = ni; cr += tr; ci += ti; }
    for (int q = 0; q < 3; ++q) { const double nr = cr * cr - ci * ci, ni = 2.0 * cr * ci; cr = nr; ci = ni; }
    c = cr; s = ci;
}

constexpr int I_LAYER_ALL = 6 * (16 * 88) + 16 * 40 + 8 * 16 + 2 * (8 * 32) + 16 * 32 + 4 * 32;
__device__ __forceinline__ void conv_weights(unsigned char* lds, int wave, int lane, int l, int it_begin, int it_end, int vgw, int VNGW) {
    unsigned char* ws = kws(); float* scr = (float*)(lds + wave * 16384);
    constexpr int I_FU = 16 * 88, I_FD = 44 * 32, I_IN = 16 * 40, I_GLU = 8 * 16, I_O = 8 * 32, I_PG = 16 * 32, I_PPJ = 4 * 32;
    constexpr int I_LAYER = 6 * I_FU + I_IN + I_GLU + 2 * I_O + I_PG + I_PPJ;
    static_assert(I_FU == I_FD && I_LAYER == I_LAYER_ALL, "items");
    for (int it = it_begin + vgw; it < it_end; it += VNGW) {
        int r = it;
        bf16_t* WL = (bf16_t*)(ws + WS_W) + (size_t)l * E_WLAYER;
#define TRM(SRC, LDW, GAIN, DST, KD, KROWS, NCOLS, ROWEXPR) { constexpr int nit = ((KROWS) / 64) * ((NCOLS) / 32); if (r < nit) { constexpr int nblk = (NCOLS) / 32; const int kb = r / nblk, nb = r % nblk, k0 = kb * 64, n0 = nb * 32; \
            tr_item(SRC, LDW, GAIN, DST, KD, k0, n0, ROWEXPR, scr, lane); continue; } r -= nit; }
        TRM(kin(9) + (size_t)l * D * FF, FF, kin(8) + l * D, WL + OW_GU1, D, D, FF, ((n0 >> 7) * 256 + (n0 & 127)))
        TRM(kin(10) + (size_t)l * D * FF, FF, kin(8) + l * D, WL + OW_GU1, D, D, FF, ((n0 >> 7) * 256 + 128 + (n0 & 127)))
        TRM(kin(11) + (size_t)l * FF * D, D, (const float*)nullptr, WL + OW_D1, FF, FF, D, n0)
        TRM(kin(13) + (size_t)l * D * INW, INW, kin(12) + l * D, WL + OW_IN, D, D, INW, n0)
        TRM(kin(22) + (size_t)l * 512 * 512, 512, (const float*)nullptr, WL + OW_GLU, 512, 512, 512, n0)
        TRM(kin(26) + (size_t)l * D * D, D, kin(23) + l * 512, WL + OW_OA, 512, 512, D, n0)
        TRM(kin(26) + (size_t)l * D * D + (size_t)512 * D, D, kin(25) + l * 512, WL + OW_OB, 512, 512, D, n0)
        TRM(kin(28) + (size_t)l * D * FF, FF, kin(27) + l * D, WL + OW_GU2, D, D, FF, ((n0 >> 7) * 256 + (n0 & 127)))
        TRM(kin(29) + (size_t)l * D * FF, FF, kin(27) + l * D, WL + OW_GU2, D, D, FF, ((n0 >> 7) * 256 + 128 + (n0 & 127)))
        TRM(kin(30) + (size_t)l * FF * D, D, (const float*)nullptr, WL + OW_D2, FF, FF, D, n0)
        TRM(kin(32) + (size_t)l * D * D, D, kin(31) + l * D, WL + OW_PG, D, D, D, n0)
        TRM(kin(33) + (size_t)l * 256 * D, D, (const float*)nullptr, WL + OW_PP, 256, 256, D, n0)
#undef TRM
    }
}

__device__ __forceinline__ void p0_phase(unsigned char* lds, int wave, int lane) {
    unsigned char* ws = kws(); float* out = kout();
    const int G = gridDim.x, gw = blockIdx.x * 8 + wave, NGW = G * 8;
    conv_weights(lds, wave, lane, 0, 0, 2 * 16 * 88, gw, NGW);
    {
        bf16_t* XB0 = (bf16_t*)(ws + WS_XB0); float* ssq0 = (float*)(ws + WS_SSQ);
        for (int m = gw; m < M; m += NGW) {
            const float* src = (m < MP) ? kin(0) + (size_t)m * D : kin(1) + (size_t)(m - MP) * D;
            float s = 0.f;
#pragma unroll
            for (int j = 0; j < 4; ++j) { const f32x4 v = ((const f32x4*)src)[lane + 64 * j];
                u32x2 w; w.x = cvt_pk_bf16(v.x, v.y); w.y = cvt_pk_bf16(v.z, v.w); ((u32x2*)(XB0 + (size_t)m * D))[lane + 64 * j] = w; s += (v.x * v.x + v.y * v.y) + (v.z * v.z + v.w * v.w); }
            s = wave_sum(s);
            if (lane < 16) ssq0[(size_t)m * 16 + lane] = (lane == 0) ? s : 0.f;
        }
    }
    const size_t gt = (size_t)blockIdx.x * 512 + wave * 64 + lane, NGT = (size_t)G * 512;
    for (size_t i = gt; i < (size_t)NL * 32 * 64; i += NGT) {
        const int n = (int)(i & 63), lg = (int)(i >> 6), l = lg >> 5, g = lg & 31;
        unsigned char* tab = ws + WS_TAB + (size_t)l * TAB_LAYER;
        const double lr = (double)kin(14)[i], li = (double)kin(15)[i], dt = exp((double)kin(16)[lg]);
        const double zr = lr * dt, zi = li * dt; double c1, s1; cexp_i(zi, c1, s1); const double ea = exp(zr); const double ar = ea * c1, ai = ea * s1;
        double c2, s2; cexp_i(256.0 * zi, c2, s2); const double e2 = exp(256.0 * zr);
        ((float*)(tab + TAB_AR))[g * 64 + n] = (float)ar; ((float*)(tab + TAB_AI))[g * 64 + n] = (float)ai;
        ((float*)(tab + TAB_A2R))[g * 64 + n] = (float)(e2 * c2); ((float*)(tab + TAB_A2I))[g * 64 + n] = (float)(e2 * s2);
        const double nr = ar - 1.0, ni = ai, den = lr * lr + li * li; const double cr = (nr * lr + ni * li) / den, ci = (ni * lr - nr * li) / den;
        bf16_t* bb = (bf16_t*)(tab + TAB_BB) + (size_t)g * 128 * 16; bf16_t* cm = (bf16_t*)(tab + TAB_CM) + (size_t)g * 16 * 128;
        for (int p = 0; p < 16; ++p) {
            const double br = (double)kin(17)[i * 16 + p], bi = (double)kin(18)[i * 16 + p];
            bb[n * 16 + p] = f2bf((float)(cr * br - ci * bi)); bb[(64 + n) * 16 + p] = f2bf((float)(cr * bi + ci * br));
            cm[p * 128 + n] = f2bf(kin(19)[((size_t)lg * 16 + p) * 64 + n]); cm[p * 128 + 64 + n] = f2bf(-kin(20)[((size_t)lg * 16 + p) * 64 + n]);
        }
    }
}
__device__ __forceinline__ void p0_misc(int wave, int lane, int vb, int NVB) {
    unsigned char* ws = kws(); float* out = kout();
    const size_t gt = (size_t)vb * 512 + wave * 64 + lane, NGT = (size_t)NVB * 512;
    {
        bf16_t* PB = (bf16_t*)(ws + WS_PB);
        for (size_t i = gt; i < (size_t)NL * M * 64; i += NGT) { const int l = (int)(i / ((size_t)M * 64)); const size_t rem = i % ((size_t)M * 64); const int row = (int)(rem >> 6), c4 = (int)(rem & 63);
            const float* src = (row < MP) ? kin(6) + ((size_t)l * MP + row) * 256 + c4 * 4 : kin(7) + ((size_t)l * MSM + (row - MP)) * 256 + c4 * 4;
            const f32x4 v = *(const f32x4*)src; u32x2 w; w.x = cvt_pk_bf16(v.x, v.y); w.y = cvt_pk_bf16(v.z, v.w); ((u32x2*)PB)[i] = w; }
    }
    {
        bf16_t* KS = (bf16_t*)(ws + WS_KS); bf16_t* VTS = (bf16_t*)(ws + WS_VTS);
        for (size_t i = gt; i < (size_t)NL * DB * 160 * 32; i += NGT) { const int c4 = (int)(i & 31); const size_t t1 = i >> 5; const int key = (int)(t1 % 160); const size_t lb = t1 / 160;
            u32x2 w; w.x = 0u; w.y = 0u;
            if (key < 128) { const f32x4 v = *(const f32x4*)(kin(2) + (lb * 128 + key) * 128 + c4 * 4); w.x = cvt_pk_bf16(v.x, v.y); w.y = cvt_pk_bf16(v.z, v.w); }
            ((u32x2*)KS)[i] = w; }
        for (size_t i = gt; i < (size_t)NL * DB * 32 * 160; i += NGT) { const int t = (int)(i % 160); const size_t t1 = i / 160; const int c4 = (int)(t1 & 31); const size_t lb = t1 >> 5;
            f32x4 v = {0.f, 0.f, 0.f, 0.f}; if (t < 128) v = *(const f32x4*)(kin(3) + (lb * 128 + t) * 128 + c4 * 4);
            const int c = c4 * 4; bf16_t* d = VTS + (lb * 2 + (c >> 6)) * 10240; const int i0 = vt_idx(t, c & 63); d[i0] = f2bf(v.x); d[i0 + 16] = f2bf(v.y); d[i0 + 32] = f2bf(v.z); d[i0 + 48] = f2bf(v.w); }
        for (size_t i = gt; i < (size_t)NL * DB * 120 * 32; i += NGT) { const int c4 = (int)(i & 31); const size_t t1 = i >> 5; const int j = (int)(t1 % 120); const size_t lb = t1 / 120;
            const size_t so = (lb * 128 + j + 8) * 128 + c4 * 4, dofs = (lb * 128 + j) * 128 + c4 * 4;
            *(f32x4*)(out + O_KS + dofs) = *(const f32x4*)(kin(2) + so); *(f32x4*)(out + O_VS + dofs) = *(const f32x4*)(kin(3) + so); }
    }
}

#define MFMA32(a, b, c) __builtin_amdgcn_mfma_f32_32x32x16_bf16((a), (b), (c), 0, 0, 0)
#ifndef MFMA16
#define MFMA16(a, b, c) __builtin_amdgcn_mfma_f32_16x16x32_bf16((a), (b), (c), 0, 0, 0)
#endif

template <bool PASS2, int SEG>
__device__ __forceinline__ void ssm_sub(unsigned char* wl, const bf16_t* urow0, const bf16x8 ua, const bf16x8 (&bfr)[4], const bf16x8 (&cfr)[4], float ar, float ai, float& hr, float& hi, int lane,
                                        const float* h0re, const float* h0im, float* ofre, float* ofim, int segstride, bf16_t* ygrow0, f32x4 dv) {
    float* BU = (float*)wl; unsigned short* HB = (unsigned short*)wl;
    const int r = lane & 31, hf = lane >> 5;
    u32x2 uu[2] = {{0u, 0u}, {0u, 0u}};
    if (PASS2) {
#pragma unroll
        for (int tb = 0; tb < 2; ++tb) uu[tb] = *(const u32x2*)(urow0 + (size_t)(tb * 16 + (lane & 15)) * 16 + 4 * (lane >> 4)); }
    float h0r[32 / SEG], h0i[32 / SEG];
#pragma unroll
    for (int sgi = 0; sgi < 32 / SEG; ++sgi) { h0r[sgi] = 0.f; h0i[sgi] = 0.f; if (SEG < 32) { h0r[sgi] = h0re[(size_t)sgi * segstride + lane]; h0i[sgi] = h0im[(size_t)sgi * segstride + lane]; } }
    asm volatile("" ::: "memory");
    {
#pragma unroll
        for (int cb = 0; cb < 4; ++cb) {
            f32x16 acc;
#pragma unroll
            for (int i = 0; i < 16; ++i) acc[i] = 0.f;
            acc = MFMA32(ua, bfr[cb], acc);
#pragma unroll
            for (int i = 0; i < 16; ++i) BU[((i & 3) + 8 * (i >> 2) + 4 * hf) * 128 + cb * 32 + r] = acc[i];
        }
    }
    asm volatile("" ::: "memory");
#pragma unroll 8
    for (int t = 0; t < 32; ++t) {
        if (SEG < 32 && (t % SEG) == 0) { hr = h0r[t / SEG]; hi = h0i[t / SEG]; }
        const float br = BU[t * 128 + lane], bi = BU[t * 128 + 64 + lane];
        const float nr = fmaf(ar, hr, fmaf(-ai, hi, br)), ni = fmaf(ar, hi, fmaf(ai, hr, bi));
        hr = nr; hi = ni;
        if (PASS2) { HB[t * 136 + lane] = f2bf(hr); HB[t * 136 + 64 + lane] = f2bf(hi); }
        if (SEG < 32 && (t % SEG) == SEG - 1) { ofre[(size_t)(t / SEG) * segstride + lane] = hr; ofim[(size_t)(t / SEG) * segstride + lane] = hi; }
    }
    asm volatile("" ::: "memory");
    if (PASS2) {
        const int tk = lane & 15, q4 = lane >> 4;
#pragma unroll
        for (int tb = 0; tb < 2; ++tb) {
            f32x4 acc = {0.f, 0.f, 0.f, 0.f};
#pragma unroll
            for (int ks = 0; ks < 4; ++ks) { const bf16x8 hfrag = *(const bf16x8*)(wl + (tb * 16 + tk) * 272 + (ks * 32 + q4 * 8) * 2); acc = MFMA16(cfr[ks], hfrag, acc); }
            const size_t ro = (size_t)(tb * 16 + tk) * 512 + 4 * q4;
            const float y0 = gelu_tanh(acc.x + dv.x * bflo(uu[tb].x)), y1 = gelu_tanh(acc.y + dv.y * bfhi(uu[tb].x)), y2 = gelu_tanh(acc.z + dv.z * bflo(uu[tb].y)), y3 = gelu_tanh(acc.w + dv.w * bfhi(uu[tb].y));
            u32x2 w; w.x = cvt_pk_bf16(y0, y1); w.y = cvt_pk_bf16(y2, y3); *(u32x2*)(ygrow0 + ro) = w;
        }
    }
    asm volatile("" ::: "memory");
}


struct Cx { float r, i; };
__device__ __forceinline__ Cx cmul(Cx a, Cx b) { return Cx{a.r * b.r - a.i * b.i, a.r * b.i + a.i * b.r}; }
__device__ __forceinline__ Cx cfma(Cx x, Cx a, Cx b) { return Cx{fmaf(x.r, a.r, fmaf(-x.i, a.i, b.r)), fmaf(x.r, a.i, fmaf(x.i, a.r, b.i))}; }
__device__ __forceinline__ void ssm_p1_sub(const bf16x8 ua, const bf16x8 (&bfr)[4], Cx aA, Cx aB, Cx a8A, Cx a8B, Cx a4own, Cx a32own, int hf, float& hr, float& hi) {
    f32x16 acc[4];
#pragma unroll
    for (int cb = 0; cb < 4; ++cb) {
#pragma unroll
        for (int i = 0; i < 16; ++i) acc[cb][i] = 0.f;
        acc[cb] = MFMA32(ua, bfr[cb], acc[cb]);
    }
    Cx SA = {0.f, 0.f}, SB = {0.f, 0.f};
#pragma unroll
    for (int j = 0; j < 4; ++j) {
        Cx sa = {acc[0][4 * j], acc[2][4 * j]}, sb = {acc[1][4 * j], acc[3][4 * j]};
#pragma unroll
        for (int q = 1; q < 4; ++q) { sa = cfma(sa, aA, Cx{acc[0][4 * j + q], acc[2][4 * j + q]}); sb = cfma(sb, aB, Cx{acc[1][4 * j + q], acc[3][4 * j + q]}); }
        if (j == 0) { SA = sa; SB = sb; } else { SA = cfma(SA, a8A, sa); SB = cfma(SB, a8B, sb); }
    }
    const float sr = hf ? SA.r : SB.r, si = hf ? SA.i : SB.i;
    const Cx other = {__shfl_xor(sr, 32), __shfl_xor(si, 32)}, own = hf ? SB : SA;
    const Cx S = hf ? cfma(other, a4own, own) : cfma(own, a4own, other);
    const Cx h = cfma(Cx{hr, hi}, a32own, S);
    hr = h.r; hi = h.i;
}
__device__ __forceinline__ void ssm_phase(unsigned char* lds, int l, int wave, int lane) {
    unsigned char* ws = kws(); float* out = kout();
    const unsigned char* tab = ws + WS_TAB + (size_t)l * TAB_LAYER;
    const bf16_t* UB = (const bf16_t*)(ws + WS_HB); bf16_t* YG = (bf16_t*)(ws + WS_HB + 2 * SZ_512);
    unsigned char* wl = lds + wave * 16384; float* xch = (float*)(lds + 131072);
    const int r = lane & 31, hf = lane >> 5, tk = lane & 15, q4 = lane >> 4;
    for (int unit = blockIdx.x; unit < NB * 32; unit += gridDim.x) {
        const int b = unit >> 5, g = unit & 31;
        bf16x8 bfr[4], cfr[4];
#pragma unroll
        for (int cb = 0; cb < 4; ++cb) bfr[cb] = *(const bf16x8*)((const bf16_t*)(tab + TAB_BB) + ((size_t)g * 128 + cb * 32 + r) * 16 + hf * 8);
#pragma unroll
        for (int ks = 0; ks < 4; ++ks) cfr[ks] = *(const bf16x8*)((const bf16_t*)(tab + TAB_CM) + ((size_t)g * 16 + tk) * 128 + ks * 32 + q4 * 8);
        const float ar = ((const float*)(tab + TAB_AR))[g * 64 + lane], ai = ((const float*)(tab + TAB_AI))[g * 64 + lane];
        const float a2r = ((const float*)(tab + TAB_A2R))[g * 64 + lane], a2i = ((const float*)(tab + TAB_A2I))[g * 64 + lane];
        const f32x4 dv = *(const f32x4*)(kin(21) + l * 512 + g * 16 + 4 * q4);
        const size_t row0 = (size_t)b * SEQ + wave * 256;
        float hr = 0.f, hi = 0.f;
        const bf16_t* ublk = UB + ((row0 >> 5) * 32 + g) * 512;
        const bf16_t* ub0 = ublk + r * 16 + hf * 8;
        bf16x8 ua = *(const bf16x8*)ub0;
        {
            const float* TAR = (const float*)(tab + TAB_AR) + g * 64; const float* TAI = (const float*)(tab + TAB_AI) + g * 64;
            const Cx aA = {TAR[r], TAI[r]}, aB = {TAR[32 + r], TAI[32 + r]};
            const Cx a2A = cmul(aA, aA), a4A = cmul(a2A, a2A), a8A = cmul(a4A, a4A), a2B = cmul(aB, aB), a4B = cmul(a2B, a2B), a8B = cmul(a4B, a4B);
            const Cx a8o = hf ? a8B : a8A, a16o = cmul(a8o, a8o), a32o = cmul(a16o, a16o), a4o = hf ? a4B : a4A;
            for (int sc = 0; sc < 8; ++sc) { const bf16x8 uc = ua; ua = *(const bf16x8*)(ub0 + (size_t)((sc + 1) & 7) * 32 * 512);
                ssm_p1_sub(uc, bfr, aA, aB, a8A, a8B, a4o, a32o, hf, hr, hi); }
        }
        xch[wave * 128 + lane] = hr; xch[wave * 128 + 64 + lane] = hi;
        __syncthreads();
        float cr = 0.f, ci = 0.f;
        for (int j = 0; j < wave; ++j) { const float sr = xch[j * 128 + lane], si = xch[j * 128 + 64 + lane];
            const float nr = fmaf(a2r, cr, fmaf(-a2i, ci, sr)), ni = fmaf(a2r, ci, fmaf(a2i, cr, si)); cr = nr; ci = ni; }
        hr = cr; hi = ci;
        for (int sc = 0; sc < 8; ++sc) { const bf16x8 uc = ua; ua = *(const bf16x8*)(ub0 + (size_t)((sc + 1) & 7) * 32 * 512);
            ssm_sub<true, 32>(wl, ublk + (size_t)sc * 32 * 512, uc, bfr, cfr, ar, ai, hr, hi, lane, nullptr, nullptr, nullptr, nullptr, 0, YG + (row0 + sc * 32) * 512 + g * 16, dv); }
        if (wave == 7) { out[O_HPR + ((size_t)(l * NB + b) * 32 + g) * 64 + lane] = hr; out[O_HPI + ((size_t)(l * NB + b) * 32 + g) * 64 + lane] = hi; }
        __syncthreads();
    }
    for (int wu = blockIdx.x * 8 + wave; wu < 32 * 32; wu += gridDim.x * 8) {
        const int g = wu & 31, bq = wu >> 5;
        bf16x8 bfr[4], cfr[4];
#pragma unroll
        for (int cb = 0; cb < 4; ++cb) bfr[cb] = *(const bf16x8*)((const bf16_t*)(tab + TAB_BB) + ((size_t)g * 128 + cb * 32 + r) * 16 + hf * 8);
#pragma unroll
        for (int ks = 0; ks < 4; ++ks) cfr[ks] = *(const bf16x8*)((const bf16_t*)(tab + TAB_CM) + ((size_t)g * 16 + tk) * 128 + ks * 32 + q4 * 8);
        const float ar = ((const float*)(tab + TAB_AR))[g * 64 + lane], ai = ((const float*)(tab + TAB_AI))[g * 64 + lane];
        const f32x4 dv = *(const f32x4*)(kin(21) + l * 512 + g * 16 + 4 * q4);
        const size_t row0 = (size_t)MP + bq * 32; const size_t so = ((size_t)(l * DB + bq * 4) * 32 + g) * 64;
        float hr = 0.f, hi = 0.f;
        ssm_sub<true, 8>(wl, UB + ((row0 >> 5) * 32 + g) * 512, *(const bf16x8*)(UB + ((row0 >> 5) * 32 + g) * 512 + r * 16 + hf * 8), bfr, cfr, ar, ai, hr, hi, lane, kin(4) + so, kin(5) + so, out + O_HSR + so, out + O_HSI + so, 32 * 64, YG + row0 * 512 + g * 16, dv);
    }
}

__device__ __forceinline__ void attn_wave(const bf16_t* QB, const bf16_t* Kseq, const bf16_t* Vseq, int tstride, int qrow_base, int nq, int q0, float sink, bf16_t* YA, float* ssqT, int h, int lane) {
    const int r = lane & 31, hf = lane >> 5;
    const int qrow = qrow_base + (r < nq ? r : nq - 1);
    bf16x8 qf[4];
#pragma unroll
    for (int ks = 0; ks < 4; ++ks) qf[ks] = *(const bf16x8*)(QB + (size_t)qrow * 512 + h * 64 + ks * 16 + hf * 8);
    f32x16 s[5];
    const int kb0 = q0 - 128;
#pragma unroll
    for (int jb = 0; jb < 5; ++jb) {
#pragma unroll
        for (int i = 0; i < 16; ++i) s[jb][i] = 0.f;
        const int kp0 = kb0 + 32 * jb;
        if (kp0 >= 0) {
            const bf16_t* kptr = Kseq + (size_t)(kp0 + r) * 128 + hf * 8;
#pragma unroll
            for (int ks = 0; ks < 4; ++ks) { const bf16x8 kf = *(const bf16x8*)(kptr + ks * 16); s[jb] = MFMA32(kf, qf[ks], s[jb]); }
        }
    }
    bf16x8 vfr[5][2][2];
#pragma unroll
    for (int jb = 0; jb < 5; ++jb) {
        const int kp0 = kb0 + 32 * jb;
#pragma unroll
        for (int st = 0; st < 2; ++st)
#pragma unroll
            for (int db = 0; db < 2; ++db) {
                if (kp0 >= 0) vfr[jb][st][db] = *(const bf16x8*)(Vseq + (size_t)((kp0 + 16 * st) >> 4) * 1024 + (db * 32 + r) * 16 + hf * 8);
                else vfr[jb][st][db] = (bf16x8){0, 0, 0, 0, 0, 0, 0, 0}; }
    }
    const int qp = q0 + r;
    float mx = sink;
#pragma unroll
    for (int jb = 0; jb < 5; ++jb)
#pragma unroll
        for (int i = 0; i < 16; ++i) { const int kp = kb0 + 32 * jb + (i & 3) + 8 * (i >> 2) + 4 * hf; const bool ok = (kp >= 0) && (kp <= qp) && (qp - kp < 128);
            s[jb][i] = ok ? s[jb][i] : -1e30f; mx = fmaxf(mx, s[jb][i]); }
    mx = fmaxf(mx, __shfl_xor(mx, 32));
    float sum = 0.f;
#pragma unroll
    for (int jb = 0; jb < 5; ++jb)
#pragma unroll
        for (int i = 0; i < 16; ++i) { const float p = (s[jb][i] > -1e29f) ? __builtin_amdgcn_exp2f((s[jb][i] - mx) * 1.44269504f) : 0.f; s[jb][i] = p; sum += p; }
    sum += __shfl_xor(sum, 32);
    sum += __builtin_amdgcn_exp2f((sink - mx) * 1.44269504f);
    const float inv = 1.0f / sum;
    f32x16 o[2];
#pragma unroll
    for (int i = 0; i < 16; ++i) { o[0][i] = 0.f; o[1][i] = 0.f; }
#pragma unroll
    for (int jb = 0; jb < 5; ++jb) {
        const int kp0 = kb0 + 32 * jb;
        if (kp0 >= 0) {
#pragma unroll
            for (int st = 0; st < 2; ++st) {
                union { bf16x8 v; unsigned u[4]; } pf;
#pragma unroll
                for (int j = 0; j < 4; ++j) pf.u[j] = cvt_pk_bf16(s[jb][8 * st + 2 * j], s[jb][8 * st + 2 * j + 1]);
#pragma unroll
                for (int db = 0; db < 2; ++db) {
                    o[db] = MFMA32(vfr[jb][st][db], pf.v, o[db]);
                }
            }
        }
    }
    float sq = 0.f;
#pragma unroll
    for (int db = 0; db < 2; ++db)
#pragma unroll
        for (int ig = 0; ig < 4; ++ig) {
            const float v0 = o[db][4 * ig] * inv, v1 = o[db][4 * ig + 1] * inv, v2 = o[db][4 * ig + 2] * inv, v3 = o[db][4 * ig + 3] * inv;
            sq += (v0 * v0 + v1 * v1) + (v2 * v2 + v3 * v3);
            if (r < nq) { u32x2 w; w.x = cvt_pk_bf16(v0, v1); w.y = cvt_pk_bf16(v2, v3); *(u32x2*)(YA + (size_t)qrow * 512 + h * 64 + db * 32 + 8 * ig + 4 * hf) = w; }
        }
    sq += __shfl_xor(sq, 32);
    if (hf == 0 && r < nq) ssqT[(size_t)qrow * 8 + h] = sq;
}

__device__ __forceinline__ void attn_phase(int l, int wave, int lane) {
    unsigned char* ws = kws();
    const bf16_t* QB = (const bf16_t*)(ws + WS_HB + SZ_512); bf16_t* YA = (bf16_t*)(ws + WS_HB + 4 * SZ_512);
    const bf16_t* KP = (const bf16_t*)(ws + WS_KP); const bf16_t* VTP = (const bf16_t*)(ws + WS_VTP);
    const bf16_t* KS = (const bf16_t*)(ws + WS_KS); const bf16_t* VTS = (const bf16_t*)(ws + WS_VTS);
    float* ssqT = (float*)(ws + WS_SSQ + 4 * SZ_SSQ16 + SZ_SSQ8);
    const int h = wave, kvh = h >> 2; const float sink = kin(24)[l * 8 + h];
    const int c = (int)blockIdx.x; const bool deal = (gridDim.x == 256);
    for (int k = 0; k < 640; ++k) {
        int bu;
        if (deal) { if (c >= 128) { if (k < 3) bu = 3 * (c - 128) + k; else break; } else { if (k < 2) bu = 384 + 2 * c + k; else break; } }
        else { bu = c + k * (int)gridDim.x; if (bu >= 512 + DB) break; }
        if (bu < 512) { const int b = bu >> 6, q0 = (bu & 63) * 32;
            attn_wave(QB, KP + (size_t)b * SEQ * 128 + kvh * 64, VTP + (size_t)(b * 2 + kvh) * 64 * 2048, 2048, b * SEQ + q0, 32, q0, sink, YA, ssqT, h, lane);
        } else { const int sb = bu - 512;
            attn_wave(QB, KS + (size_t)(l * DB + sb) * 160 * 128 + kvh * 64, VTS + (size_t)((l * DB + sb) * 2 + kvh) * 64 * 160, 160, MP + sb * 8, 8, 128, sink, YA, ssqT, h, lane);
        }
    }
}

#define XB_TMO      128
#define XB_XCNT(j)  (256  + 64 * (j))
#define XB_XSUB(j)  (1280 + 64 * (j))
#define XB_XGEN(j)  (2304 + 64 * (j))
#define XB_TOP      3328
#define XB_TOPGEN   3392
#define XCD_BAR_WORDS 3456
#define XB_SPIN_CAP (1u << 18)
#define LAS __attribute__((address_space(3)))

__device__ __forceinline__ unsigned xb_ld(unsigned* p)              { return __hip_atomic_load(p, __ATOMIC_RELAXED, __HIP_MEMORY_SCOPE_AGENT); }
__device__ __forceinline__ unsigned xb_add(unsigned* p, unsigned v) { return __hip_atomic_fetch_add(p, v, __ATOMIC_RELAXED, __HIP_MEMORY_SCOPE_AGENT); }
__device__ __forceinline__ unsigned xb_xcc_id() { return (unsigned)__builtin_amdgcn_s_getreg((3 << 11) | 20) & 0xFu; }
#define XB_SPIN(cond, bar) do { unsigned _sp = 0; while (cond) { __builtin_amdgcn_s_sleep(1); \
    if ((++_sp & 255u) == 0u) { if (xb_ld(&(bar)[XB_TMO])) break; if (_sp > XB_SPIN_CAP) { atomicAdd(&(bar)[XB_TMO], 1u); break; } } } } while (0)

struct XcdBarrier {
    unsigned* bar; unsigned x;
    volatile LAS unsigned* st;
};

__device__ __forceinline__ XcdBarrier xcd_barrier_post(unsigned* bar, volatile LAS unsigned* st) {
    XcdBarrier b; b.bar = bar; b.x = xb_xcc_id(); b.st = st;
    if (threadIdx.x == 0) (void)xb_add(&bar[XB_XCNT(b.x)], 1u);
    return b;
}
__device__ __forceinline__ void xcd_barrier_complete(unsigned* bar, unsigned x, unsigned& nloc, unsigned& nx) {
    const unsigned G = gridDim.x * gridDim.y * gridDim.z;
    unsigned sum, cnt, mine, sp = 0u;
    for (;;) {
        sum = 0u; cnt = 0u; mine = 0u;
#pragma unroll
        for (unsigned j = 0; j < 16; ++j) { const unsigned c = xb_ld(&bar[XB_XCNT(j)]); sum += c; cnt += (c > 0u) ? 1u : 0u; mine = (j == x) ? c : mine; }
        if (sum == G) break;
        __builtin_amdgcn_s_sleep(1);
        if ((++sp & 255u) == 0u) { if (xb_ld(&bar[XB_TMO])) break; if (sp > XB_SPIN_CAP) { atomicAdd(&bar[XB_TMO], 1u); break; } }
    }
    nloc = mine > 0u ? mine : 1u; nx = cnt > 0u ? cnt : 1u;
}

__device__ __forceinline__ void xcd_barrier(const XcdBarrier& b) {
    asm volatile("s_waitcnt vmcnt(0)" ::: "memory");
    __syncthreads();
    if (pg8::tid_from_lds((const volatile LAS unsigned*)(b.st + 4)) == 0) {
        unsigned* bar = b.bar;
        __builtin_amdgcn_s_waitcnt(0);
        unsigned nloc = b.st[0], nx = b.st[1];
        if (nloc == 0u) { xcd_barrier_complete(bar, b.x, nloc, nx); b.st[0] = nloc; b.st[1] = nx; }
        const unsigned old = xb_add(&bar[XB_XSUB(b.x)], 1u);
        const unsigned gen = old / nloc;
        if (old + 1u == (gen + 1u) * nloc) {
            __builtin_amdgcn_fence(__ATOMIC_RELEASE, "agent");
            asm volatile("s_waitcnt vmcnt(0)" ::: "memory");
            const unsigned og = xb_add(&bar[XB_TOP], 1u);
            const unsigned tg = og / nx;
            if (og + 1u == (tg + 1u) * nx) xb_add(&bar[XB_TOPGEN], 1u);
            else XB_SPIN(xb_ld(&bar[XB_TOPGEN]) == tg, bar);
            __builtin_amdgcn_fence(__ATOMIC_ACQUIRE, "agent");
            xb_add(&bar[XB_XGEN(b.x)], 1u);
            asm volatile("s_waitcnt vmcnt(0)" ::: "memory");
        } else {
            XB_SPIN(xb_ld(&bar[XB_XGEN(b.x)]) == gen, bar);
            __builtin_amdgcn_fence(__ATOMIC_ACQUIRE, "agent");
            asm volatile("s_waitcnt vmcnt(0)" ::: "memory");
        }
    }
    __syncthreads();
}

__device__ __forceinline__ void gbar(unsigned char* lds) {
    XcdBarrier b; b.bar = (unsigned*)(kws() + WS_BAR); b.x = xb_xcc_id(); b.st = (volatile LAS unsigned*)(lds + ST_OFF);
    xcd_barrier(b);
}
#define PH_BEGIN unsigned char* ws = kws(); float* out = kout(); (void)out; \
    bf16_t* XBa = (bf16_t*)(ws + WS_XB0); bf16_t* XBb = (bf16_t*)(ws + WS_XB1); bf16_t* HB = (bf16_t*)(ws + WS_HB); (void)XBa; (void)XBb; (void)HB; \
    const bf16_t* WL = (const bf16_t*)(ws + WS_W) + (size_t)l * E_WLAYER; (void)WL; \
    float* ssq0 = (float*)(ws + WS_SSQ); float* ssq1 = (float*)(ws + WS_SSQ + SZ_SSQ16); float* ssq2 = (float*)(ws + WS_SSQ + 2 * SZ_SSQ16); float* ssq3 = (float*)(ws + WS_SSQ + 3 * SZ_SSQ16); \
    float* ssqS = (float*)(ws + WS_SSQ + 4 * SZ_SSQ16); float* ssqT = (float*)(ws + WS_SSQ + 4 * SZ_SSQ16 + SZ_SSQ8); (void)ssq0; (void)ssq1; (void)ssq2; (void)ssq3; (void)ssqS; (void)ssqT;

__global__ void __launch_bounds__(512, 2) mega_fwd(Args a_unused) {
    extern __shared__ __attribute__((aligned(16))) unsigned char lds[];
    cg::grid_group grid = cg::this_grid();
    if (gridDim.x == 0x7fffffffu) grid.sync();
    if (threadIdx.x < 4) ((volatile LAS unsigned*)(lds + ST_OFF))[threadIdx.x] = 0u;
    if ((threadIdx.x & 63) == 0) ((volatile LAS unsigned*)(lds + ST_OFF + 16))[(unsigned)__builtin_amdgcn_s_getreg((5 << 11) | 4) & 63u] = threadIdx.x >> 6;
    __syncthreads();
    (void)xcd_barrier_post((unsigned*)(kws() + WS_BAR), (volatile LAS unsigned*)(lds + ST_OFF));
    {
        int tid = MYTID(); asm volatile("" : "+v"(tid)); const int lane = tid & 63, wave = __builtin_amdgcn_readfirstlane(tid >> 6);
        p0_phase(lds, wave, lane);
    }
    gbar(lds);
#pragma nounroll
    for (int l = 0; l < NL; ++l) {
        { PH_BEGIN EpiSwiglu E{HB, ssq0}; run_gemm(lds, XBa, WL + OW_GU1, 2 * FF, D, E, M); }
        if (l == 0 && bid() >= 216) { int tid = MYTID(); asm volatile("" : "+v"(tid)); const int lane = tid & 63, wave = __builtin_amdgcn_readfirstlane(tid >> 6);
            conv_weights(lds, wave, lane, 0, 2 * 16 * 88, 3 * 16 * 88, (bid() - 216) * 8 + wave, (gdim() - 216) * 8); }
        gbar(lds);
        { PH_BEGIN EpiRes<0, true> E{XBa, XBb, ssq1, nullptr, nullptr}; run_gemm(lds, HB, WL + OW_D1, D, FF, E); }
        { PH_BEGIN SMALL(1, 16, 0, {HB, FF, WL + OW_D1, FF, l, 1, 1, 0, 0, 0}) }
        { int tid = MYTID(); asm volatile("" : "+v"(tid)); const int lane = tid & 63, wave = __builtin_amdgcn_readfirstlane(tid >> 6);
          if (l == 0) { conv_weights(lds, wave, lane, 0, 3 * 16 * 88, I_LAYER_ALL, bid() * 8 + wave, gdim() * 8); p0_misc(wave, lane, bid(), gdim()); }
        }
        gbar(lds);
        { PH_BEGIN EpiIn E{HB, (bf16_t*)(ws + WS_HB + SZ_512), (bf16_t*)(ws + WS_KP), (bf16_t*)(ws + WS_VTP), (bf16_t*)(ws + WS_KS), (bf16_t*)(ws + WS_VTS), ssq1, out + O_KP, out + O_VP, out + O_KS, out + O_VS, l};
          run_gemm(lds, XBb, WL + OW_IN, INW, D, E, M); }
        if (l + 1 < NL && bid() >= 84) { int tid = MYTID(); asm volatile("" : "+v"(tid)); const int lane = tid & 63, wave = __builtin_amdgcn_readfirstlane(tid >> 6);
            conv_weights(lds, wave, lane, l + 1, 0, I_LAYER_ALL, (bid() - 84) * 8 + wave, (gdim() - 84) * 8); }
        if (l + 1 == NL && bid() >= 84) {
            { PH_BEGIN EpiBf E{(bf16_t*)out, D}; run_gemm(lds, (const bf16_t*)(ws + WS_PB) + (size_t)l * M * 256, WL + OW_PP, D, 256, E, MP, 84); }
            { PH_BEGIN SMALL(4, 16, 84, {(const bf16_t*)(ws + WS_PB) + (size_t)l * M * 256, 256, WL + OW_PP, 256, l, 0, 0, 0, 0, 0}) } }
        gbar(lds);
        {
            int tid = MYTID(); asm volatile("" : "+v"(tid)); const int lane = tid & 63, wave = __builtin_amdgcn_readfirstlane(tid >> 6);
            ssm_phase(lds, l, wave, lane);
        }
        gbar(lds);
        { PH_BEGIN const bf16_t* YG = (const bf16_t*)(ws + WS_HB + 2 * SZ_512); EpiGlu E{YG, (bf16_t*)(ws + WS_HB + 3 * SZ_512), ssqS}; run_gemm(lds, YG, WL + OW_GLU, 512, 512, E); }
        { PH_BEGIN SMALL(3, 8, 128, {(const bf16_t*)(ws + WS_HB + 2 * SZ_512), 512, WL + OW_GLU, 512, l, 0, 0, 0, 0, 0}) }
        {
            int tid = MYTID(); asm volatile("" : "+v"(tid)); const int lane = tid & 63, wave = __builtin_amdgcn_readfirstlane(tid >> 6);
            attn_phase(l, wave, lane);
        }
        gbar(lds);
        { PH_BEGIN SMALL(1, 16, 0, {(const bf16_t*)(ws + WS_HB + 3 * SZ_512), 512, WL + OW_OA, 512, l, 0, -1, 0, 1, 1}) }
        { PH_BEGIN EpiRes<1, true> E{XBb, XBa, ssq2, ssqT, (const bf16_t*)ssqS};
          run_gemm2(lds, (const bf16_t*)(ws + WS_HB + 3 * SZ_512), WL + OW_OA, (const bf16_t*)(ws + WS_HB + 4 * SZ_512), WL + OW_OB, D, 512, E); }
        { PH_BEGIN SMALL(1, 16, 0, {(const bf16_t*)(ws + WS_HB + 4 * SZ_512), 512, WL + OW_OB, 512, l, 0, 2, 1, 1, 0}) }
        gbar(lds);
        { PH_BEGIN EpiSwiglu E{HB, ssq2}; run_gemm(lds, XBa, WL + OW_GU2, 2 * FF, D, E, M); }
        gbar(lds);
        { PH_BEGIN EpiRes<0, true> E{XBa, XBb, ssq3, nullptr, nullptr}; run_gemm(lds, HB, WL + OW_D2, D, FF, E); }
        { PH_BEGIN SMALL(1, 16, 0, {HB, FF, WL + OW_D2, FF, l, 1, 3, 0, 0, 0}) }
        if (l + 1 < NL) {
            { PH_BEGIN EpiBf E{(bf16_t*)out, D}; run_gemm(lds, (const bf16_t*)(ws + WS_PB) + (size_t)l * M * 256, WL + OW_PP, D, 256, E); }
            { PH_BEGIN SMALL(4, 16, 0, {(const bf16_t*)(ws + WS_PB) + (size_t)l * M * 256, 256, WL + OW_PP, 256, l, 0, 0, 0, 0, 0}) } }
        gbar(lds);
        { PH_BEGIN EpiRes<2, true> E{XBb, XBa, ssq0, ssq3, (const bf16_t*)out}; run_gemm(lds, XBb, WL + OW_PG, D, D, E); }
        { PH_BEGIN SMALL(1, 16, 0, {XBb, D, WL + OW_PG, D, l, 0, 0, 3, 2, 1}) }
        gbar(lds);
    }
    {
        int tid = MYTID(); asm volatile("" : "+v"(tid)); const int lane = tid & 63, wave = __builtin_amdgcn_readfirstlane(tid >> 6);
        unsigned char* ws = kws(); float* out = kout(); const float* ssq0 = (const float*)(ws + WS_SSQ); const bf16_t* XBa = (const bf16_t*)(ws + WS_XB0);
        const float* gfin = kin(34);
        for (int m = bid() * 8 + wave; m < M; m += gdim() * 8) {
            float t = (lane < 16) ? ssq0[(size_t)m * 16 + lane] : 0.f; t = wave_sum(t);
            const float rs = __builtin_amdgcn_rsqf(t * (1.f / 1024.f) + 1e-6f);
#pragma unroll
            for (int j = 0; j < 2; ++j) {
                const int c = 512 * j + 8 * lane; const u32x4 xw = *(const u32x4*)(XBa + (size_t)m * D + c);
                const f32x4 g0 = *(const f32x4*)(gfin + c), g1 = *(const f32x4*)(gfin + c + 4);
                f32x4 y0 = {bflo(xw.x), bfhi(xw.x), bflo(xw.y), bfhi(xw.y)}, y1 = {bflo(xw.z), bfhi(xw.z), bflo(xw.w), bfhi(xw.w)};
                y0 = y0 * rs * g0; y1 = y1 * rs * g1;
                *(f32x4*)(out + (size_t)m * D + c) = y0; *(f32x4*)(out + (size_t)m * D + c + 4) = y1;
            }
        }
    }
}

extern "C" void kernel_launch(void* const* d_in, const int* in_sizes, int n_in, void* d_out, int out_size, void* d_ws, size_t ws_size, hipStream_t stream) {
    static int grid_blocks = 0;
    if (!grid_blocks) {
        int dev = 0, cus = 0, per_cu = 0;
        hipGetDevice(&dev);
        hipDeviceGetAttribute(&cus, hipDeviceAttributeMultiprocessorCount, dev);
        hipFuncSetAttribute((const void*)mega_fwd, hipFuncAttributeMaxDynamicSharedMemorySize, LDS_BYTES);
        hipOccupancyMaxActiveBlocksPerMultiprocessor(&per_cu, (const void*)mega_fwd, 512, LDS_BYTES);
        if (per_cu < 1) per_cu = 1;
        if (cus < 1) cus = 256;
        grid_blocks = cus * per_cu;
        if (ws_size < WS_END) fprintf(stderr, "kernel_launch: workspace too small: %zu < %zu\n", ws_size, (size_t)WS_END);
    }
    if (hipMemsetAsync((char*)d_ws + WS_BAR, 0, 16384, stream) != hipSuccess) fprintf(stderr, "memset failed\n");
    Args a{};
    for (int i = 0; i < NIN; ++i) a.in[i] = (const float*)d_in[i];
    a.out = (float*)d_out; a.ws = (unsigned char*)d_ws;
    void* args[] = {&a};
    hipError_t e = hipLaunchCooperativeKernel((const void*)mega_fwd, dim3(grid_blocks), dim3(512), args, LDS_BYTES, stream);
    if (e != hipSuccess) fprintf(stderr, "cooperative launch failed: %s (grid %d)\n", hipGetErrorString(e), grid_blocks);
}
```

```cpp
#include <hip/hip_runtime.h>
#include <hip/hip_cooperative_groups.h>
#include <cstdio>
#include <cstdint>
namespace pg8 {
#define PG8_LAS __attribute__((address_space(3)))
typedef unsigned short bf16_t;
typedef short bf16x8 __attribute__((ext_vector_type(8)));
typedef float f32x4 __attribute__((ext_vector_type(4)));
typedef unsigned u32x4 __attribute__((ext_vector_type(4)));
constexpr int BM = 256, BK = 64, HALF = 128, HTB = HALF * BK * 2  , STAGE_BYTES = 8 * HTB, NXCD = 8, WGM = 8;

__host__ __device__ __forceinline__ int lds_byte(int r, int c) { const int st = (r >> 4) * 2 + (c >> 5), rr = r & 15, cc = c & 31, ob = rr * 64 + cc * 2; return st * 1024 + (ob ^ (((ob >> 9) & 1) << 5)); }
__host__ __device__ __forceinline__ void stage_rc(int b, int& R, int& C) { const int st = b / 1024, sb = b % 1024, swz = sb ^ (((sb >> 9) & 1) << 5); R = (st >> 1) * 16 + swz / 64; C = (st & 1) * 32 + (swz % 64) / 2; }
__host__ __device__ __forceinline__ int perm32(int rho) { const int n = rho >> 4, i = rho & 15; return 8 * (i >> 2) + 4 * n + (i & 3); }

struct Unit { int pm, pn, seg; };
struct Gemm { const bf16_t* A; const bf16_t* Bt; int M, N, K; const bf16_t* A2; const bf16_t* Bt2; };

struct StaticOrder {
    int nM, nN, nwg, G, c;
    __host__ __device__ void init(int M, int N, int G_, int c_) { nM = M / BM; nN = N / BM; nwg = nM * nN; G = G_; c = c_; }
    __host__ __device__ bool next(int i, Unit& u) const {
        const long L = (long)i * G + c; if (L >= nwg) return false;
        int wgid = (int)L; { const int q = nwg / NXCD, r = nwg % NXCD, xcd = wgid % NXCD, off = wgid / NXCD; wgid = (xcd < r ? xcd * (q + 1) : r * (q + 1) + (xcd - r) * q) + off; }
        const int nig = WGM * nN, gid = wgid / nig, fm = gid * WGM, gsz = (nM - fm) < WGM ? (nM - fm) : WGM;
        u.pm = fm + ((wgid % nig) % gsz); u.pn = (wgid % nig) / gsz; u.seg = 0; return true;
    }
    __device__ __forceinline__ void a_ready(const Unit&) const {}
    __device__ __forceinline__ void done(const Unit&) const {}
};
__device__ __forceinline__ unsigned cvt_pk_bf16(float lo, float hi) { unsigned r; asm volatile("v_cvt_pk_bf16_f32 %0, %1, %2" : "=v"(r) : "v"(lo), "v"(hi)); return r; }
typedef float f32x2 __attribute__((ext_vector_type(2)));
__device__ __forceinline__ int tid_from_lds(const volatile PG8_LAS unsigned* tidtab) {
    const unsigned slot = (unsigned)__builtin_amdgcn_s_getreg((5 << 11) | 4) & 63u;
    const int w = __builtin_amdgcn_readfirstlane((int)tidtab[slot]);
    int ln; asm volatile("v_mbcnt_lo_u32_b32 %0, -1, 0\n\tv_mbcnt_hi_u32_b32 %0, -1, %0" : "=v"(ln));
    return w * 64 + ln;
}
constexpr int TIDTAB_OFF = 131072 + 4096 + 16;
struct TwoSegOrder : StaticOrder {
    __host__ __device__ bool next(int i, Unit& u) const { if (!StaticOrder::next(i >> 1, u)) return false; u.seg = i & 1; return true; }
};
template <class Epi, class Sched, bool STAMP = false>
__device__ __forceinline__ void gemm_phase(PG8_LAS unsigned char* lds, const Gemm g, const Sched& S, const Epi& E, unsigned long long* stamps) {
    int tid_l = tid_from_lds((const volatile PG8_LAS unsigned*)(lds + TIDTAB_OFF)); asm volatile("" : "+v"(tid_l)); const int tid = tid_l, wid = __builtin_amdgcn_readfirstlane(tid >> 6), lane = tid & 63, wr = wid >> 2, wc = wid & 3, fr = lane & 15, fq = lane >> 4;
    const int K = g.K, nt = K / BK;
    int ts_lo = 0, ts_hi = 0, nts = 0; const unsigned long long rt_entry = STAMP ? (unsigned long long)wall_clock64() : 0ull;
#define PG8_STAMP() do { if (STAMP && wid == 0 && nts < 64) { const unsigned long long _c = (unsigned long long)clock64(); \
        ts_lo = (lane == nts) ? (int)(unsigned)_c : ts_lo; ts_hi = (lane == nts) ? (int)(unsigned)(_c >> 32) : ts_hi; ++nts; } } while (0)
    PG8_STAMP();
    unsigned voffA[2], voffB[2];
#pragma unroll
    for (int i = 0; i < 2; ++i) { int R, C; stage_rc(tid * 16 + i * 8192, R, C); const int Rb = Epi::PERM ? ((R & ~31) + perm32(R & 31)) : R;
        voffA[i] = (unsigned)(R * K + C) * 2u; voffB[i] = (unsigned)(Rb * K + C) * 2u; }
    const size_t kstep = (size_t)(BK * 2);
    const size_t hstep = (size_t)HALF * K * 2;
    const size_t tstep = 2 * hstep;
    const unsigned ldsw = (unsigned)wid * 1024u;
    const int aoff = lds_byte(wr * 64 + fr, fq * 8), boff = lds_byte(wc * 32 + fr, fq * 8);
#define PG8_SA(b, h) (((b) * 2 + (h)) * HTB)
#define PG8_SB(b, h) ((4 + (b) * 2 + (h)) * HTB)
#define PG8_STAGE(bufoff, gbase, voff) do { _Pragma("unroll") for (int _i = 0; _i < 2; ++_i) \
        __builtin_amdgcn_global_load_lds((const unsigned*)((const char*)(gbase) + (voff)[_i]), (PG8_LAS unsigned*)(lds + (bufoff) + ldsw + _i * 8192), 16, 0, 0); } while (0)
#define PG8_LDA(dst, b, h) do { _Pragma("unroll") for (int m = 0; m < 4; ++m) _Pragma("unroll") for (int k = 0; k < 2; ++k) dst[m][k] = *(const PG8_LAS bf16x8*)(lds + PG8_SA(b, h) + aoff + m * 2048 + k * 1024); } while (0)
#define PG8_LDB(dst, b, h) do { _Pragma("unroll") for (int n = 0; n < 2; ++n) _Pragma("unroll") for (int k = 0; k < 2; ++k) dst[n][k] = *(const PG8_LAS bf16x8*)(lds + PG8_SB(b, h) + boff + n * 2048 + k * 1024); } while (0)
#define PG8_MMA(ai, bj, At, Bt) do { __builtin_amdgcn_s_setprio(1); _Pragma("unroll") for (int m = 0; m < 4; ++m) _Pragma("unroll") for (int n = 0; n < 2; ++n) _Pragma("unroll") for (int k = 0; k < 2; ++k) \
        acc[ai][bj][m][n] = __builtin_amdgcn_mfma_f32_16x16x32_bf16(Bt[n][k], At[m][k], acc[ai][bj][m][n], 0, 0, 0); __builtin_amdgcn_s_setprio(0); } while (0)
#define PG8_WAIT_V(n) asm volatile("s_waitcnt vmcnt(" #n ")" ::: "memory")
#define PG8_WAIT_L(n) asm volatile("s_waitcnt lgkmcnt(" #n ")" ::: "memory")
#define PG8_BAR __builtin_amdgcn_s_barrier()
#define PG8_SCHED __builtin_amdgcn_sched_barrier(0)
    Unit cur, nxt; int ui = 0;
    if (!S.next(0, cur)) return;
    f32x4 acc[2][2][4][2];
#pragma unroll
    for (int a = 0; a < 2; ++a)
#pragma unroll
        for (int b = 0; b < 2; ++b)
#pragma unroll
            for (int m = 0; m < 4; ++m)
#pragma unroll
                for (int n = 0; n < 2; ++n) acc[a][b][m][n] = (f32x4){0.f, 0.f, 0.f, 0.f};
    bf16x8 At[4][2], B0[2][2], B1[2][2];
    const char* cA = (const char*)(cur.seg ? g.A2 : g.A) + (size_t)cur.pm * tstep; const char* cB = (const char*)(cur.seg ? g.Bt2 : g.Bt) + (size_t)cur.pn * tstep;
    S.a_ready(cur);
    PG8_STAGE(PG8_SB(0, 0), cB, voffB); PG8_STAGE(PG8_SB(0, 1), cB + hstep, voffB); PG8_STAGE(PG8_SA(0, 0), cA, voffA); PG8_STAGE(PG8_SA(0, 1), cA + hstep, voffA);
    if (wr == 1) PG8_BAR;
    PG8_WAIT_V(2); PG8_BAR;
    PG8_STAGE(PG8_SB(1, 0), cB + kstep, voffB); PG8_STAGE(PG8_SA(1, 0), cA + kstep, voffA); PG8_STAGE(PG8_SB(1, 1), cB + hstep + kstep, voffB);
    PG8_WAIT_V(6); PG8_BAR;
    PG8_STAMP();
    for (;;) {
        const bool has_next = S.next(ui + 1, nxt);
        const char* nA = has_next ? (const char*)(nxt.seg ? g.A2 : g.A) + (size_t)nxt.pm * tstep : cA; const char* nB = has_next ? (const char*)(nxt.seg ? g.Bt2 : g.Bt) + (size_t)nxt.pn * tstep : cB;
        for (int t = 0; t < nt; t += 2) {
            const bool last = (t == nt - 2);
            const char* a1 = cA + (size_t)(t + 1) * kstep;
            const char* a2 = last ? nA : cA + (size_t)(t + 2) * kstep; const char* b2 = last ? nB : cB + (size_t)(t + 2) * kstep;
            const char* a3 = a2 + kstep; const char* b3 = b2 + kstep;
            if (last && has_next) S.a_ready(nxt);
            PG8_LDB(B0, 0, 0); PG8_LDB(B1, 0, 1); PG8_SCHED; PG8_LDA(At, 0, 0); PG8_STAGE(PG8_SA(1, 1), a1 + hstep, voffA);
            PG8_WAIT_V(8); PG8_WAIT_L(0); PG8_BAR; PG8_MMA(0, 0, At, B0); PG8_MMA(0, 1, At, B1); PG8_BAR; PG8_SCHED;
            PG8_LDA(At, 0, 1); PG8_STAGE(PG8_SB(0, 0), b2, voffB); PG8_STAGE(PG8_SB(0, 1), b2 + hstep, voffB); PG8_STAGE(PG8_SA(0, 0), a2, voffA);
            PG8_WAIT_V(8); PG8_WAIT_L(0); PG8_BAR; PG8_MMA(1, 0, At, B0); PG8_MMA(1, 1, At, B1); PG8_BAR; PG8_SCHED;
            PG8_LDB(B0, 1, 0); PG8_LDB(B1, 1, 1); PG8_SCHED; PG8_LDA(At, 1, 0); PG8_STAGE(PG8_SA(0, 1), a2 + hstep, voffA);
            PG8_WAIT_V(8); PG8_WAIT_L(0); PG8_BAR; PG8_MMA(0, 0, At, B0); PG8_MMA(0, 1, At, B1); PG8_BAR; PG8_SCHED;
            PG8_LDA(At, 1, 1); PG8_STAGE(PG8_SB(1, 0), b3, voffB); PG8_STAGE(PG8_SB(1, 1), b3 + hstep, voffB); PG8_STAGE(PG8_SA(1, 0), a3, voffA);
            PG8_WAIT_V(8); PG8_WAIT_L(0); PG8_BAR; PG8_MMA(1, 0, At, B0); PG8_MMA(1, 1, At, B1); PG8_BAR; PG8_SCHED;
        }
        PG8_STAMP();
        if (wr == 0) PG8_BAR;
        bool keep = false;
        int t2 = tid_from_lds((const volatile PG8_LAS unsigned*)(lds + TIDTAB_OFF)); asm volatile("" : "+v"(t2));
        const int wid2 = __builtin_amdgcn_readfirstlane(t2 >> 6), ln2 = t2 & 63, wr2 = wid2 >> 2, wc2 = wid2 & 3, fr2 = ln2 & 15, fq2 = ln2 >> 4;
        if constexpr (Epi::TWOSEG) { if (cur.seg == 0) { E.between(acc, cur, wr2, wc2, fr2, fq2); keep = true; } }
        if constexpr (!Epi::AFTER_DRAIN) { if (!keep) { E(acc, cur, wr2, wc2, fr2, fq2); S.done(cur); } }
        PG8_STAMP();
        if (!has_next) break;
        if (!keep) {
#pragma unroll
        for (int a = 0; a < 2; ++a)
#pragma unroll
            for (int b = 0; b < 2; ++b)
#pragma unroll
                for (int m = 0; m < 4; ++m)
#pragma unroll
                    for (int n = 0; n < 2; ++n) acc[a][b][m][n] = (f32x4){0.f, 0.f, 0.f, 0.f};
        }
        cur = nxt; cA = nA; cB = nB; ++ui;
        if (wr == 1) PG8_BAR;
    }
    PG8_WAIT_V(0);
    PG8_BAR;
    if constexpr (Epi::AFTER_DRAIN) { E.fused(acc, cur, wr, wc, fr, fq, lds, wid, lane); S.done(cur); }
    PG8_STAMP();
    if (STAMP && wid == 0) { stamps[lane] = lane < nts ? (((unsigned long long)(unsigned)ts_hi << 32) | (unsigned)ts_lo) : 0ull;
        if (lane == 62) stamps[62] = rt_entry; if (lane == 63) stamps[63] = (unsigned long long)wall_clock64(); }
#undef PG8_STAMP
#undef PG8_SA
#undef PG8_SB
#undef PG8_STAGE
#undef PG8_LDA
#undef PG8_LDB
#undef PG8_MMA
#undef PG8_WAIT_V
#undef PG8_WAIT_L
#undef PG8_BAR
#undef PG8_SCHED
}
}

namespace cg = cooperative_groups;
using pg8::bf16_t; using pg8::bf16x8; using pg8::f32x4; using pg8::u32x4; using pg8::Unit; using pg8::cvt_pk_bf16;
typedef float f32x16 __attribute__((ext_vector_type(16)));
typedef unsigned u32x2 __attribute__((ext_vector_type(2)));
typedef float f32x2s __attribute__((ext_vector_type(2)));

constexpr int D = 1024, MP = 16384, MSM = 1024, M = MP + MSM, FF = 2816, INW = 1280;
constexpr int NL = 2, SEQ = 2048, NB = 8, DB = 128;
constexpr int ST_OFF = 131072 + 4096, LDS_BYTES = ST_OFF + 16 + 256;
static_assert(pg8::TIDTAB_OFF == ST_OFF + 16, "tid table offset");
#define MYTID() pg8::tid_from_lds((const volatile LAS unsigned*)(lds + ST_OFF + 16))
constexpr int NIN = 35;

constexpr size_t E_WGU = (size_t)2 * FF * D, E_WD = (size_t)D * FF, E_WIN = (size_t)INW * D, E_WGLU = 512 * 512, E_WO = 1024 * 512, E_WPG = 1024 * 1024, E_WPP = 1024 * 256;
constexpr size_t OW_GU1 = 0, OW_D1 = OW_GU1 + E_WGU, OW_IN = OW_D1 + E_WD, OW_GLU = OW_IN + E_WIN, OW_OA = OW_GLU + E_WGLU, OW_OB = OW_OA + E_WO,
                 OW_GU2 = OW_OB + E_WO, OW_D2 = OW_GU2 + E_WGU, OW_PG = OW_D2 + E_WD, OW_PP = OW_PG + E_WPG, E_WLAYER = OW_PP + E_WPP;
constexpr size_t WS_W = 0;
constexpr size_t WS_XB0 = WS_W + 2 * E_WLAYER * 2;
constexpr size_t WS_XB1 = WS_XB0 + (size_t)M * D * 2;
constexpr size_t WS_HB = WS_XB1 + (size_t)M * D * 2;
constexpr size_t SZ_512 = (size_t)M * 512 * 2;
constexpr size_t WS_KP = WS_HB + (size_t)M * FF * 2;
constexpr size_t WS_VTP = WS_KP + (size_t)MP * 128 * 2;
constexpr size_t WS_KS = WS_VTP + (size_t)MP * 128 * 2;
constexpr size_t WS_VTS = WS_KS + (size_t)NL * DB * 160 * 128 * 2;
constexpr size_t WS_PB = WS_VTS + (size_t)NL * DB * 160 * 128 * 2;
constexpr size_t WS_SSQ = WS_PB + (size_t)NL * M * 256 * 2;
constexpr size_t SZ_SSQ16 = (size_t)M * 16 * 4, SZ_SSQ8 = (size_t)M * 8 * 4;
constexpr size_t WS_TAB = WS_SSQ + 4 * SZ_SSQ16 + 2 * SZ_SSQ8;
constexpr size_t TAB_BB = 0, TAB_CM = 131072, TAB_AR = 262144, TAB_AI = TAB_AR + 8192, TAB_A2R = TAB_AI + 8192, TAB_A2I = TAB_A2R + 8192, TAB_LAYER = TAB_A2I + 8192;
constexpr size_t WS_BAR = WS_TAB + NL * TAB_LAYER;
constexpr size_t WS_END = WS_BAR + 16384;

constexpr size_t O_Y = 0, O_KP = (size_t)M * D, O_VP = O_KP + (size_t)NL * NB * 128 * 128, O_HPR = O_VP + (size_t)NL * NB * 128 * 128, O_HPI = O_HPR + (size_t)NL * NB * 32 * 64,
                 O_KS = O_HPI + (size_t)NL * NB * 32 * 64, O_VS = O_KS + (size_t)NL * DB * 128 * 128, O_HSR = O_VS + (size_t)NL * DB * 128 * 128, O_HSI = O_HSR + (size_t)NL * DB * 32 * 64;

struct Args { const float* in[NIN]; float* out; unsigned char* ws; };
typedef const __attribute__((address_space(4))) unsigned long long* kargp_t;
__device__ __forceinline__ kargp_t kbase() { kargp_t p = (kargp_t)__builtin_amdgcn_kernarg_segment_ptr(); asm volatile("" : "+s"(p)); return p; }
__device__ __forceinline__ const float* kin(int i) { return (const float*)kbase()[i]; }
__device__ __forceinline__ float* kout() { return (float*)kbase()[NIN]; }
__device__ __forceinline__ unsigned char* kws() { return (unsigned char*)kbase()[NIN + 1]; }

__device__ __forceinline__ int bid() { int b = (int)blockIdx.x; asm volatile("" : "+s"(b)); return b; }
__device__ __forceinline__ int gdim() { int g = (int)gridDim.x; asm volatile("" : "+s"(g)); return g; }
__device__ __forceinline__ float wave_sum(float v) {
#pragma unroll
    for (int o = 1; o < 64; o <<= 1) v += __shfl_xor(v, o);
    return v;
}
__device__ __forceinline__ float sigm(float x) { return __builtin_amdgcn_rcpf(1.0f + __builtin_amdgcn_exp2f(-1.44269504f * x)); }
__device__ __forceinline__ float silu_f(float x) { return x * sigm(x); }
__device__ __forceinline__ float gelu_tanh(float x) { return x * sigm(1.5957691216f * (x + 0.044715f * x * x * x)); }
__device__ __forceinline__ float bf2f(unsigned short b) { return __uint_as_float(((unsigned)b) << 16); }
__device__ __forceinline__ float bflo(unsigned w) { return __uint_as_float(w << 16); }
__device__ __forceinline__ float bfhi(unsigned w) { return __uint_as_float(w & 0xffff0000u); }
__device__ __forceinline__ unsigned short f2bf(float f) { return (unsigned short)(cvt_pk_bf16(f, 0.f) & 0xffffu); }
__device__ __forceinline__ int vt_idx(int t, int d) { const int u = t & 15; return (t >> 4) * 1024 + d * 16 + (((u >> 2) & 1) << 3) + ((u >> 3) << 2) + (u & 3); }
__device__ __forceinline__ float rs16(const float* ssq, int row) {
    const f32x4* p = (const f32x4*)(ssq + (size_t)row * 16); const f32x4 a = p[0], b = p[1], c = p[2], d = p[3]; const f32x4 s = (a + b) + (c + d);
    return __builtin_amdgcn_rsqf(((s.x + s.y) + (s.z + s.w)) * (1.f / 1024.f) + 1e-6f);
}
__device__ __forceinline__ float rs16c(const float* ssq, int row, int fq) {
    const f32x4 a = *(const f32x4*)(ssq + (size_t)row * 16 + 4 * fq); float s = (a.x + a.y) + (a.z + a.w); s += __shfl_xor(s, 16); s += __shfl_xor(s, 32);
    return __builtin_amdgcn_rsqf(s * (1.f / 1024.f) + 1e-6f);
}
__device__ __forceinline__ float rs8(const float* ssq, int row) {
    const f32x4* p = (const f32x4*)(ssq + (size_t)row * 8); const f32x4 a = p[0], b = p[1]; const f32x4 s = a + b;
    return __builtin_amdgcn_rsqf(((s.x + s.y) + (s.z + s.w)) * (1.f / 512.f) + 1e-6f);
}


struct EpiSwiglu {
    static constexpr bool PERM = true, AFTER_DRAIN = false, TWOSEG = false;
    bf16_t* H; const float* ssq;
    __device__ __forceinline__ void operator()(const f32x4 (&acc)[2][2][4][2], const Unit& u, int wr, int wc, int fr, int fq) const {
        const int row0 = u.pm * 256 + wr * 64 + fr, col0 = u.pn * 128 + wc * 32 + 8 * fq;
#pragma unroll
        for (int ai = 0; ai < 2; ++ai)
#pragma unroll
            for (int m = 0; m < 4; ++m) {
                const int row = row0 + ai * 128 + m * 16; const float rs = rs16c(ssq, row, fq);
                const float c1 = -1.44269504f * rs, c2 = rs * rs;
                unsigned wq[4];
#pragma unroll
                for (int n = 0; n < 2; ++n)
#pragma unroll
                    for (int jp = 0; jp < 2; ++jp) {
                        const f32x2s g = {acc[ai][0][m][n][2 * jp], acc[ai][0][m][n][2 * jp + 1]}, up = {acc[ai][1][m][n][2 * jp], acc[ai][1][m][n][2 * jp + 1]};
                        const f32x2s t = g * c1;
                        f32x2s d = {__builtin_amdgcn_exp2f(t.x), __builtin_amdgcn_exp2f(t.y)}; d = d + 1.0f;
                        const float r = __builtin_amdgcn_rcpf(d.x * d.y);
                        const f32x2s inv = (f32x2s){d.y, d.x} * r;
                        const f32x2s hh = ((g * up) * c2) * inv;
                        wq[n * 2 + jp] = cvt_pk_bf16(hh.x, hh.y);
                    }
                u32x4 w; w.x = wq[0]; w.y = wq[1]; w.z = wq[2]; w.w = wq[3];
                *(u32x4*)(H + (size_t)row * FF + col0) = w;
            }
    }
};

template <int MODE, bool WXB> struct EpiRes {
    static constexpr bool PERM = true, AFTER_DRAIN = false, TWOSEG = (MODE == 1);
    const bf16_t* xin; bf16_t* xb; float* ssq_out; const float* ssq_in; const bf16_t* pp;
    __device__ __forceinline__ void between(f32x4 (&acc)[2][2][4][2], const Unit& u, int wr, int wc, int fr, int fq) const {
        const int row0 = u.pm * 256 + wr * 64 + fr;
#pragma unroll
        for (int ai = 0; ai < 2; ++ai)
#pragma unroll
            for (int m = 0; m < 4; ++m) { const int row = row0 + ai * 128 + m * 16; const float ratio = rs8((const float*)pp, row) / rs8(ssq_in, row);
#pragma unroll
                for (int bj = 0; bj < 2; ++bj)
#pragma unroll
                    for (int n = 0; n < 2; ++n) acc[ai][bj][m][n] *= ratio; }
    }
    __device__ __forceinline__ void operator()(const f32x4 (&acc)[2][2][4][2], const Unit& u, int wr, int wc, int fr, int fq) const {
        const int row0 = u.pm * 256 + wr * 64 + fr, col0 = u.pn * 256 + wc * 32 + 8 * fq;
#pragma unroll
        for (int ai = 0; ai < 2; ++ai)
#pragma unroll
            for (int m = 0; m < 4; ++m) {
                const int row = row0 + ai * 128 + m * 16; float rs = 0.5f;
                if (MODE == 1) rs = rs8(ssq_in, row);
                if (MODE == 2) rs = rs16c(ssq_in, row, fq);
                float s = 0.f;
#pragma unroll
                for (int bj = 0; bj < 2; ++bj) {
                    const size_t off = (size_t)row * D + col0 + bj * 128;
                    const u32x4 xw = *(const u32x4*)(xin + off); const f32x4 a0 = acc[ai][bj][m][0], a1 = acc[ai][bj][m][1];
                    float xv[8] = {bflo(xw.x), bfhi(xw.x), bflo(xw.y), bfhi(xw.y), bflo(xw.z), bfhi(xw.z), bflo(xw.w), bfhi(xw.w)};
                    const float av[8] = {a0.x, a0.y, a0.z, a0.w, a1.x, a1.y, a1.z, a1.w};
                    if (MODE == 2) {
                        const u32x4 pw = *(const u32x4*)(pp + off);
                        const float pv[8] = {bflo(pw.x), bfhi(pw.x), bflo(pw.y), bfhi(pw.y), bflo(pw.z), bfhi(pw.z), bflo(pw.w), bfhi(pw.w)};
#pragma unroll
                        for (int q = 0; q < 8; ++q) xv[q] += pv[q] * sigm(rs * av[q]);
                    } else {
#pragma unroll
                        for (int q = 0; q < 8; ++q) xv[q] += av[q] * rs;
                    }
                    u32x4 w; w.x = cvt_pk_bf16(xv[0], xv[1]); w.y = cvt_pk_bf16(xv[2], xv[3]); w.z = cvt_pk_bf16(xv[4], xv[5]); w.w = cvt_pk_bf16(xv[6], xv[7]);
                    *(u32x4*)(xb + off) = w;
#pragma unroll
                    for (int q = 0; q < 8; ++q) s += xv[q] * xv[q];
                }
                if (WXB) { s += __shfl_xor(s, 16); s += __shfl_xor(s, 32); if (fq == 0) ssq_out[(size_t)row * 16 + u.pn * 4 + wc] = s; }
            }
    }
};

struct EpiIn {
    static constexpr bool PERM = true, AFTER_DRAIN = false, TWOSEG = false;
    bf16_t *UB, *QB, *KP, *VTP, *KS, *VTS; const float* ssq; float *okp, *ovp, *oks, *ovs; int l;
    __device__ __forceinline__ void operator()(const f32x4 (&acc)[2][2][4][2], const Unit& u, int wr, int wc, int fr, int fq) const {
        const int row0 = u.pm * 256 + wr * 64 + fr, cw = wc * 32 + 8 * fq;
#pragma unroll
        for (int ai = 0; ai < 2; ++ai)
#pragma unroll
            for (int m = 0; m < 4; ++m) {
                const int row = row0 + ai * 128 + m * 16; const float rs = rs16c(ssq, row, fq);
                if (u.pn < 4) {
                    const float sc = (u.pn < 2) ? rs : rs * 0.125f; bf16_t* dst = QB + (size_t)row * 512 + (u.pn & 1) * 256 + cw;
#pragma unroll
                    for (int bj = 0; bj < 2; ++bj) { const f32x4 v0 = acc[ai][bj][m][0] * sc, v1 = acc[ai][bj][m][1] * sc;
                        u32x4 w; w.x = cvt_pk_bf16(v0.x, v0.y); w.y = cvt_pk_bf16(v0.z, v0.w); w.z = cvt_pk_bf16(v1.x, v1.y); w.w = cvt_pk_bf16(v1.z, v1.w);
                        if (u.pn < 2) { const int c = (u.pn & 1) * 256 + cw + bj * 128;
                            *(u32x4*)(UB + ((size_t)(row >> 5) * 32 + (c >> 4)) * 512 + (row & 31) * 16 + (c & 15)) = w; }
                        else *(u32x4*)(dst + bj * 128) = w; }
                } else {
                    const f32x4 k0 = acc[ai][0][m][0] * rs, k1 = acc[ai][0][m][1] * rs, v0 = acc[ai][1][m][0] * rs, v1 = acc[ai][1][m][1] * rs;
                    u32x4 kw; kw.x = cvt_pk_bf16(k0.x, k0.y); kw.y = cvt_pk_bf16(k0.z, k0.w); kw.z = cvt_pk_bf16(k1.x, k1.y); kw.w = cvt_pk_bf16(k1.z, k1.w);
                    const float vv[8] = {v0.x, v0.y, v0.z, v0.w, v1.x, v1.y, v1.z, v1.w};
                    const int kvh = cw >> 6, d0 = cw & 63;
                    if (row < MP) {
                        const int b = row >> 11, t = row & 2047;
                        *(u32x4*)(KP + (size_t)row * 128 + cw) = kw;
                        bf16_t* vt = VTP + (size_t)(b * 2 + kvh) * 131072;
#pragma unroll
                        for (int j = 0; j < 8; ++j) vt[vt_idx(t, d0 + j)] = f2bf(vv[j]);
                        if (t >= 1920) { const size_t o = ((size_t)(l * NB + b) * 128 + (t - 1920)) * 128 + cw;
                            *(f32x4*)(okp + o) = k0; *(f32x4*)(okp + o + 4) = k1; *(f32x4*)(ovp + o) = v0; *(f32x4*)(ovp + o + 4) = v1; }
                    } else {
                        const int r = row - MP, b = r >> 3, s = r & 7;
                        *(u32x4*)(KS + ((size_t)(l * DB + b) * 160 + 128 + s) * 128 + cw) = kw;
                        bf16_t* vt = VTS + (size_t)((l * DB + b) * 2 + kvh) * 10240;
#pragma unroll
                        for (int j = 0; j < 8; ++j) vt[vt_idx(128 + s, d0 + j)] = f2bf(vv[j]);
                        const size_t o = ((size_t)(l * DB + b) * 128 + 120 + s) * 128 + cw;
                        *(f32x4*)(oks + o) = k0; *(f32x4*)(oks + o + 4) = k1; *(f32x4*)(ovs + o) = v0; *(f32x4*)(ovs + o + 4) = v1;
                    }
                }
            }
    }
};

struct EpiGlu {
    static constexpr bool PERM = true, AFTER_DRAIN = false, TWOSEG = false;
    const bf16_t* YG; bf16_t* YS; float* ssq_out;
    __device__ __forceinline__ void operator()(const f32x4 (&acc)[2][2][4][2], const Unit& u, int wr, int wc, int fr, int fq) const {
        const int row0 = u.pm * 256 + wr * 64 + fr, col0 = u.pn * 256 + wc * 32 + 8 * fq;
#pragma unroll
        for (int ai = 0; ai < 2; ++ai)
#pragma unroll
            for (int m = 0; m < 4; ++m) {
                const int row = row0 + ai * 128 + m * 16; float s = 0.f;
#pragma unroll
                for (int bj = 0; bj < 2; ++bj) {
                    const size_t off = (size_t)row * 512 + col0 + bj * 128; const u32x4 yw = *(const u32x4*)(YG + off);
                    const f32x4 a0 = acc[ai][bj][m][0], a1 = acc[ai][bj][m][1];
                    float o[8];
                    o[0] = bflo(yw.x) * sigm(a0.x); o[1] = bfhi(yw.x) * sigm(a0.y); o[2] = bflo(yw.y) * sigm(a0.z); o[3] = bfhi(yw.y) * sigm(a0.w);
                    o[4] = bflo(yw.z) * sigm(a1.x); o[5] = bfhi(yw.z) * sigm(a1.y); o[6] = bflo(yw.w) * sigm(a1.z); o[7] = bfhi(yw.w) * sigm(a1.w);
#pragma unroll
                    for (int j = 0; j < 8; ++j) s += o[j] * o[j];
                    u32x4 w; w.x = cvt_pk_bf16(o[0], o[1]); w.y = cvt_pk_bf16(o[2], o[3]); w.z = cvt_pk_bf16(o[4], o[5]); w.w = cvt_pk_bf16(o[6], o[7]);
                    *(u32x4*)(YS + off) = w;
                }
                s += __shfl_xor(s, 16); s += __shfl_xor(s, 32); if (fq == 0) ssq_out[(size_t)row * 8 + u.pn * 4 + wc] = s;
            }
    }
};

struct EpiBf {
    static constexpr bool PERM = true, AFTER_DRAIN = false, TWOSEG = false;
    bf16_t* O; int ldc;
    __device__ __forceinline__ void operator()(const f32x4 (&acc)[2][2][4][2], const Unit& u, int wr, int wc, int fr, int fq) const {
        const int row0 = u.pm * 256 + wr * 64 + fr, col0 = u.pn * 256 + wc * 32 + 8 * fq;
#pragma unroll
        for (int ai = 0; ai < 2; ++ai)
#pragma unroll
            for (int m = 0; m < 4; ++m) {
                const int row = row0 + ai * 128 + m * 16;
#pragma unroll
                for (int bj = 0; bj < 2; ++bj) { const f32x4 v0 = acc[ai][bj][m][0], v1 = acc[ai][bj][m][1];
                    u32x4 w; w.x = cvt_pk_bf16(v0.x, v0.y); w.y = cvt_pk_bf16(v0.z, v0.w); w.z = cvt_pk_bf16(v1.x, v1.y); w.w = cvt_pk_bf16(v1.z, v1.w);
                    *(u32x4*)(O + (size_t)row * ldc + col0 + bj * 128) = w; }
            }
    }
};

template <class Epi> __device__ __forceinline__ void run_gemm(unsigned char* lds, const bf16_t* A, const bf16_t* Bt, int N, int K, const Epi& E, int MR = MP, int skip = 0) {
    pg8::Gemm g{A, Bt, MR, N, K}; pg8::StaticOrder S; S.init(MR, N, gdim() - skip, bid() - skip);
    pg8::gemm_phase<Epi, pg8::StaticOrder, false>((PG8_LAS unsigned char*)lds, g, S, E, nullptr);
}

#ifndef MFMA16
#ifndef MFMA16
#define MFMA16(a, b, c) __builtin_amdgcn_mfma_f32_16x16x32_bf16((a), (b), (c), 0, 0, 0)
#endif
#endif

template <class Epi> __device__ __forceinline__ void run_gemm2(unsigned char* lds, const bf16_t* A, const bf16_t* Bt, const bf16_t* A2, const bf16_t* Bt2, int N, int K, const Epi& E, int MR = MP) {
    pg8::Gemm g{A, Bt, MR, N, K, A2, Bt2}; pg8::TwoSegOrder S; S.init(MR, N, gdim(), bid());
    pg8::gemm_phase<Epi, pg8::TwoSegOrder, false>((PG8_LAS unsigned char*)lds, g, S, E, nullptr);
}

template <class BRow>
__device__ __forceinline__ void small_gemm_item(unsigned char* lds, const bf16_t* Arows, int lda, const bf16_t* Bt, int K, const BRow& brow, int wave, int lane) {
    const int fr = lane & 15, fq = lane >> 4, kw = K >> 3, k0 = wave * kw;
    f32x4 acc[4][4];
#pragma unroll
    for (int a = 0; a < 4; ++a)
#pragma unroll
        for (int b = 0; b < 4; ++b) acc[a][b] = (f32x4){0.f, 0.f, 0.f, 0.f};
    const bf16_t* ap = Arows + (size_t)fr * lda + k0 + fq * 8;
    const bf16_t* bp[4];
#pragma unroll
    for (int nb = 0; nb < 4; ++nb) bp[nb] = Bt + (size_t)brow(nb * 16 + fr) * K + k0 + fq * 8;
    for (int kc = 0; kc < kw; kc += 128) {
        bf16x8 a[4][4], b[4][4];
#pragma unroll
        for (int s = 0; s < 4; ++s) {
            if (kc + 32 * s < kw) {
#pragma unroll
                for (int i = 0; i < 4; ++i) { a[s][i] = *(const bf16x8*)(ap + (size_t)i * 16 * lda + kc + 32 * s); b[s][i] = *(const bf16x8*)(bp[i] + kc + 32 * s); }
            }
        }
#pragma unroll
        for (int s = 0; s < 4; ++s) {
            if (kc + 32 * s < kw) {
#pragma unroll
                for (int mb = 0; mb < 4; ++mb)
#pragma unroll
                    for (int nb = 0; nb < 4; ++nb) acc[mb][nb] = MFMA16(b[s][nb], a[s][mb], acc[mb][nb]);
            }
        }
    }
    float* P = (float*)(lds + wave * 16384);
#pragma unroll
    for (int mb = 0; mb < 4; ++mb)
#pragma unroll
        for (int nb = 0; nb < 4; ++nb) { const int mm = mb * 16 + fr; *(f32x4*)(P + mm * 64 + (((nb * 4 + fq) ^ (mm & 7)) << 2)) = acc[mb][nb]; }
}
__device__ __forceinline__ f32x4 small_read(const unsigned char* lds, int mm, int cg) {
    const int o = mm * 64 + ((cg ^ (mm & 7)) << 2);
    f32x4 s = *(const f32x4*)((const float*)lds + o);
#pragma unroll
    for (int w = 1; w < 8; ++w) s += *(const f32x4*)((const float*)(lds + w * 16384) + o);
    return s;
}
struct BRowLin { int base; __device__ __forceinline__ int operator()(int c) const { return base + c; } };
struct BRowGU { int gbase; __device__ __forceinline__ int operator()(int c) const { return gbase + (c & 31) + ((c >> 5) << 7); } };

struct SmallArgs { const bf16_t* A; int lda; const bf16_t* Bt; int K; int l; int xsel, so, si, mode, src; };
template <int KIND>
__device__ __forceinline__ void small_phase(unsigned char* lds, const SmallArgs& sa, int ncb, int skip, int wave, int lane) {
    const int nvb = gdim() - skip, vb = bid() - skip;
    if (vb < 0) return;
    const int tid = wave * 64 + lane, mm = tid >> 3, j = tid & 7;
    for (int id = vb; id < 16 * ncb; id += nvb) {
        int rg = id & 15, cb = id >> 4;
        if (ncb == 16 && skip == 0 && nvb == 256) { const int xcd = id & 7, jj = id >> 3; rg = (xcd >> 1) * 4 + (jj & 3); cb = (xcd & 1) * 8 + (jj >> 2); }
        const bf16_t* Arows = sa.A + (size_t)(MP + rg * 64) * sa.lda;
        if (KIND == 0) { BRowGU br{((cb * 32) >> 7) * 256 + ((cb * 32) & 127)}; small_gemm_item(lds, Arows, sa.lda, sa.Bt, sa.K, br, wave, lane); }
        else { BRowLin br{cb * 64}; small_gemm_item(lds, Arows, sa.lda, sa.Bt, sa.K, br, wave, lane); }
        __syncthreads();
        unsigned char* ws = kws(); float* out = kout();
        const int row = MP + rg * 64 + mm;
        if (KIND == 0) {
            const float rs = rs16((const float*)(ws + WS_SSQ + (size_t)sa.si * SZ_SSQ16), row);
            const f32x4 g = small_read(lds, mm, j) * rs, u = small_read(lds, mm, 8 + j) * rs;
            u32x2 w; w.x = cvt_pk_bf16(silu_f(g.x) * u.x, silu_f(g.y) * u.y); w.y = cvt_pk_bf16(silu_f(g.z) * u.z, silu_f(g.w) * u.w);
            *(u32x2*)((bf16_t*)(ws + WS_HB) + (size_t)row * FF + cb * 32 + 4 * j) = w;
        } else {
            const f32x4 v0 = small_read(lds, mm, 2 * j), v1 = small_read(lds, mm, 2 * j + 1);
            const int col = cb * 64 + 8 * j;
            if (KIND == 1) {
                const bf16_t* xi = (const bf16_t*)(ws + (sa.src ? WS_XB1 : WS_XB0)) + (size_t)row * D + col; bf16_t* xb = (bf16_t*)(ws + (sa.xsel ? WS_XB1 : WS_XB0)) + (size_t)row * D + col;
                const u32x4 xw = *(const u32x4*)xi;
                f32x4 x0 = {bflo(xw.x), bfhi(xw.x), bflo(xw.y), bfhi(xw.y)}, x1 = {bflo(xw.z), bfhi(xw.z), bflo(xw.w), bfhi(xw.w)};
                if (sa.mode == 0) { x0 += v0 * 0.5f; x1 += v1 * 0.5f; }
                else if (sa.mode == 1) { const float rs = rs8((const float*)(ws + WS_SSQ + 4 * SZ_SSQ16 + (size_t)sa.si * SZ_SSQ8), row); x0 += v0 * rs; x1 += v1 * rs; }
                else { const float rs = rs16((const float*)(ws + WS_SSQ + (size_t)sa.si * SZ_SSQ16), row); const u32x4 pw = *(const u32x4*)((const bf16_t*)out + (size_t)row * D + col);
                    x0.x += bflo(pw.x) * sigm(rs * v0.x); x0.y += bfhi(pw.x) * sigm(rs * v0.y); x0.z += bflo(pw.y) * sigm(rs * v0.z); x0.w += bfhi(pw.y) * sigm(rs * v0.w);
                    x1.x += bflo(pw.z) * sigm(rs * v1.x); x1.y += bfhi(pw.z) * sigm(rs * v1.y); x1.z += bflo(pw.w) * sigm(rs * v1.z); x1.w += bfhi(pw.w) * sigm(rs * v1.w); }
                { u32x4 w; w.x = cvt_pk_bf16(x0.x, x0.y); w.y = cvt_pk_bf16(x0.z, x0.w); w.z = cvt_pk_bf16(x1.x, x1.y); w.w = cvt_pk_bf16(x1.z, x1.w); *(u32x4*)xb = w; }
                if (sa.so >= 0) {
                    float s = ((x0.x * x0.x + x0.y * x0.y) + (x0.z * x0.z + x0.w * x0.w)) + ((x1.x * x1.x + x1.y * x1.y) + (x1.z * x1.z + x1.w * x1.w));
                    s += __shfl_xor(s, 1); s += __shfl_xor(s, 2); s += __shfl_xor(s, 4);
                    if (j == 0) ((float*)(ws + WS_SSQ + (size_t)sa.so * SZ_SSQ16))[(size_t)row * 16 + cb] = s;
                }
            } else if (KIND == 2) {
                const float rs = rs16((const float*)(ws + WS_SSQ + SZ_SSQ16), row); const int l = sa.l;
                const int r = row - MP, b = r >> 3, s = r & 7;
                if (cb < 16) { const float sc = (cb < 8) ? rs : rs * 0.125f; const f32x4 a0 = v0 * sc, a1 = v1 * sc;
                    u32x4 w; w.x = cvt_pk_bf16(a0.x, a0.y); w.y = cvt_pk_bf16(a0.z, a0.w); w.z = cvt_pk_bf16(a1.x, a1.y); w.w = cvt_pk_bf16(a1.z, a1.w);
                    *(u32x4*)((bf16_t*)(ws + WS_HB + (cb < 8 ? 0 : SZ_512)) + (size_t)row * 512 + (col & 511)) = w;
                } else { const f32x4 a0 = v0 * rs, a1 = v1 * rs; const int ck = col & 127; const size_t o = ((size_t)(l * DB + b) * 128 + 120 + s) * 128 + ck;
                    if (cb < 18) { u32x4 w; w.x = cvt_pk_bf16(a0.x, a0.y); w.y = cvt_pk_bf16(a0.z, a0.w); w.z = cvt_pk_bf16(a1.x, a1.y); w.w = cvt_pk_bf16(a1.z, a1.w);
                        *(u32x4*)((bf16_t*)(ws + WS_KS) + ((size_t)(l * DB + b) * 160 + 128 + s) * 128 + ck) = w;
                        *(f32x4*)(out + O_KS + o) = a0; *(f32x4*)(out + O_KS + o + 4) = a1;
                    } else { const float vv[8] = {a0.x, a0.y, a0.z, a0.w, a1.x, a1.y, a1.z, a1.w}; const int kvh = ck >> 6, d0 = ck & 63;
                        bf16_t* vt = (bf16_t*)(ws + WS_VTS) + (size_t)((l * DB + b) * 2 + kvh) * 10240;
#pragma unroll
                        for (int q = 0; q < 8; ++q) vt[vt_idx(128 + s, d0 + q)] = f2bf(vv[q]);
                        *(f32x4*)(out + O_VS + o) = a0; *(f32x4*)(out + O_VS + o + 4) = a1; }
                }
            } else if (KIND == 3) {
                const size_t off = (size_t)row * 512 + col; const u32x4 yw = *(const u32x4*)((const bf16_t*)(ws + WS_HB + 2 * SZ_512) + off);
                float o[8];
                o[0] = bflo(yw.x) * sigm(v0.x); o[1] = bfhi(yw.x) * sigm(v0.y); o[2] = bflo(yw.y) * sigm(v0.z); o[3] = bfhi(yw.y) * sigm(v0.w);
                o[4] = bflo(yw.z) * sigm(v1.x); o[5] = bfhi(yw.z) * sigm(v1.y); o[6] = bflo(yw.w) * sigm(v1.z); o[7] = bfhi(yw.w) * sigm(v1.w);
                float s = 0.f;
#pragma unroll
                for (int q = 0; q < 8; ++q) s += o[q] * o[q];
                u32x4 w; w.x = cvt_pk_bf16(o[0], o[1]); w.y = cvt_pk_bf16(o[2], o[3]); w.z = cvt_pk_bf16(o[4], o[5]); w.w = cvt_pk_bf16(o[6], o[7]);
                *(u32x4*)((bf16_t*)(ws + WS_HB + 3 * SZ_512) + off) = w;
                s += __shfl_xor(s, 1); s += __shfl_xor(s, 2); s += __shfl_xor(s, 4);
                if (j == 0) ((float*)(ws + WS_SSQ + 4 * SZ_SSQ16))[(size_t)row * 8 + cb] = s;
            } else {
                u32x4 w; w.x = cvt_pk_bf16(v0.x, v0.y); w.y = cvt_pk_bf16(v0.z, v0.w); w.z = cvt_pk_bf16(v1.x, v1.y); w.w = cvt_pk_bf16(v1.z, v1.w);
                *(u32x4*)((bf16_t*)out + (size_t)row * D + col) = w;
            }
        }
        __syncthreads();
    }
}
#define SMALL(KIND, NCB, SKIP, ...) { int tid_ = MYTID(); asm volatile("" : "+v"(tid_)); const int lane_ = tid_ & 63, wave_ = __builtin_amdgcn_readfirstlane(tid_ >> 6); \
    unsigned char* ws_ = kws(); (void)ws_; SmallArgs sa_ = __VA_ARGS__; small_phase<KIND>(lds, sa_, NCB, SKIP, wave_, lane_); }

__device__ __forceinline__ void tr_item(const float* W, int ldw, const float* gain, bf16_t* WT, int Kd, int k0, int n0, int drow0, float* scr, int lane) {
    float tv[32];
#pragma unroll
    for (int i = 0; i < 32; ++i) { const int kk = 2 * i + (lane >> 5); tv[i] = __builtin_nontemporal_load(W + (size_t)(k0 + kk) * ldw + n0 + (lane & 31)); }
    if (gain) {
#pragma unroll
        for (int i = 0; i < 32; ++i) tv[i] *= gain[k0 + 2 * i + (lane >> 5)]; }
#pragma unroll
    for (int i = 0; i < 32; ++i) scr[(2 * i + (lane >> 5)) * 33 + (lane & 31)] = tv[i];
    asm volatile("s_waitcnt lgkmcnt(0)" ::: "memory");
    const int c = lane & 7;
#pragma unroll
    for (int j = 0; j < 4; ++j) { const int n = (lane >> 3) + 8 * j; const float* s = scr + (8 * c) * 33 + n;
        u32x4 o; o.x = cvt_pk_bf16(s[0 * 33], s[1 * 33]); o.y = cvt_pk_bf16(s[2 * 33], s[3 * 33]); o.z = cvt_pk_bf16(s[4 * 33], s[5 * 33]); o.w = cvt_pk_bf16(s[6 * 33], s[7 * 33]);
        __builtin_nontemporal_store(o, (u32x4*)(WT + (size_t)(drow0 + n) * Kd + k0 + 8 * c)); }
    asm volatile("s_waitcnt lgkmcnt(0)" ::: "memory");
}

__device__ __forceinline__ void cexp_i(double th, double& c, double& s) {
    const double TWO_PI_HI = 6.283185307179586232, TWO_PI_LO = 2.4492935982947064e-16;
    const double k = rint(th * 0.15915494309189534561);
    double r = fma(-k, TWO_PI_HI, th); r = fma(-k, TWO_PI_LO, r);
    const double h = r * 0.125;
    double cr = 1.0, ci = 0.0, tr = 1.0, ti = 0.0;
    for (int n = 1; n <= 16; ++n) { const double nr = -ti * h / n, ni = tr * h / n; tr = nr; ti = ni; cr += tr; ci += ti; }
    for (int q = 0; q < 3; ++q) { const double nr = cr * cr - ci * ci, ni = 2.0 * cr * ci; cr = nr; ci = ni; }
    c = cr; s = ci;
}

constexpr int I_LAYER_ALL = 6 * (16 * 88) + 16 * 40 + 8 * 16 + 2 * (8 * 32) + 16 * 32 + 4 * 32;
__device__ __forceinline__ void conv_weights(unsigned char* lds, int wave, int lane, int l, int it_begin, int it_end, int vgw, int VNGW) {
    unsigned char* ws = kws(); float* scr = (float*)(lds + wave * 16384);
    constexpr int I_FU = 16 * 88, I_FD = 44 * 32, I_IN = 16 * 40, I_GLU = 8 * 16, I_O = 8 * 32, I_PG = 16 * 32, I_PPJ = 4 * 32;
    constexpr int I_LAYER = 6 * I_FU + I_IN + I_GLU + 2 * I_O + I_PG + I_PPJ;
    static_assert(I_FU == I_FD && I_LAYER == I_LAYER_ALL, "items");
    for (int it = it_begin + vgw; it < it_end; it += VNGW) {
        int r = it;
        bf16_t* WL = (bf16_t*)(ws + WS_W) + (size_t)l * E_WLAYER;
#define TRM(SRC, LDW, GAIN, DST, KD, KROWS, NCOLS, ROWEXPR) { constexpr int nit = ((KROWS) / 64) * ((NCOLS) / 32); if (r < nit) { constexpr int nblk = (NCOLS) / 32; const int kb = r / nblk, nb = r % nblk, k0 = kb * 64, n0 = nb * 32; \
            tr_item(SRC, LDW, GAIN, DST, KD, k0, n0, ROWEXPR, scr, lane); continue; } r -= nit; }
        TRM(kin(9) + (size_t)l * D * FF, FF, kin(8) + l * D, WL + OW_GU1, D, D, FF, ((n0 >> 7) * 256 + (n0 & 127)))
        TRM(kin(10) + (size_t)l * D * FF, FF, kin(8) + l * D, WL + OW_GU1, D, D, FF, ((n0 >> 7) * 256 + 128 + (n0 & 127)))
        TRM(kin(11) + (size_t)l * FF * D, D, (const float*)nullptr, WL + OW_D1, FF, FF, D, n0)
        TRM(kin(13) + (size_t)l * D * INW, INW, kin(12) + l * D, WL + OW_IN, D, D, INW, n0)
        TRM(kin(22) + (size_t)l * 512 * 512, 512, (const float*)nullptr, WL + OW_GLU, 512, 512, 512, n0)
        TRM(kin(26) + (size_t)l * D * D, D, kin(23) + l * 512, WL + OW_OA, 512, 512, D, n0)
        TRM(kin(26) + (size_t)l * D * D + (size_t)512 * D, D, kin(25) + l * 512, WL + OW_OB, 512, 512, D, n0)
        TRM(kin(28) + (size_t)l * D * FF, FF, kin(27) + l * D, WL + OW_GU2, D, D, FF, ((n0 >> 7) * 256 + (n0 & 127)))
        TRM(kin(29) + (size_t)l * D * FF, FF, kin(27) + l * D, WL + OW_GU2, D, D, FF, ((n0 >> 7) * 256 + 128 + (n0 & 127)))
        TRM(kin(30) + (size_t)l * FF * D, D, (const float*)nullptr, WL + OW_D2, FF, FF, D, n0)
        TRM(kin(32) + (size_t)l * D * D, D, kin(31) + l * D, WL + OW_PG, D, D, D, n0)
        TRM(kin(33) + (size_t)l * 256 * D, D, (const float*)nullptr, WL + OW_PP, 256, 256, D, n0)
#undef TRM
    }
}

__device__ __forceinline__ void p0_phase(unsigned char* lds, int wave, int lane) {
    unsigned char* ws = kws(); float* out = kout();
    const int G = gridDim.x, gw = blockIdx.x * 8 + wave, NGW = G * 8;
    conv_weights(lds, wave, lane, 0, 0, 2 * 16 * 88, gw, NGW);
    {
        bf16_t* XB0 = (bf16_t*)(ws + WS_XB0); float* ssq0 = (float*)(ws + WS_SSQ);
        for (int m = gw; m < M; m += NGW) {
            const float* src = (m < MP) ? kin(0) + (size_t)m * D : kin(1) + (size_t)(m - MP) * D;
            float s = 0.f;
#pragma unroll
            for (int j = 0; j < 4; ++j) { const f32x4 v = ((const f32x4*)src)[lane + 64 * j];
                u32x2 w; w.x = cvt_pk_bf16(v.x, v.y); w.y = cvt_pk_bf16(v.z, v.w); ((u32x2*)(XB0 + (size_t)m * D))[lane + 64 * j] = w; s += (v.x * v.x + v.y * v.y) + (v.z * v.z + v.w * v.w); }
            s = wave_sum(s);
            if (lane < 16) ssq0[(size_t)m * 16 + lane] = (lane == 0) ? s : 0.f;
        }
    }
    const size_t gt = (size_t)blockIdx.x * 512 + wave * 64 + lane, NGT = (size_t)G * 512;
    for (size_t i = gt; i < (size_t)NL * 32 * 64; i += NGT) {
        const int n = (int)(i & 63), lg = (int)(i >> 6), l = lg >> 5, g = lg & 31;
        unsigned char* tab = ws + WS_TAB + (size_t)l * TAB_LAYER;
        const double lr = (double)kin(14)[i], li = (double)kin(15)[i], dt = exp((double)kin(16)[lg]);
        const double zr = lr * dt, zi = li * dt; double c1, s1; cexp_i(zi, c1, s1); const double ea = exp(zr); const double ar = ea * c1, ai = ea * s1;
        double c2, s2; cexp_i(256.0 * zi, c2, s2); const double e2 = exp(256.0 * zr);
        ((float*)(tab + TAB_AR))[g * 64 + n] = (float)ar; ((float*)(tab + TAB_AI))[g * 64 + n] = (float)ai;
        ((float*)(tab + TAB_A2R))[g * 64 + n] = (float)(e2 * c2); ((float*)(tab + TAB_A2I))[g * 64 + n] = (float)(e2 * s2);
        const double nr = ar - 1.0, ni = ai, den = lr * lr + li * li; const double cr = (nr * lr + ni * li) / den, ci = (ni * lr - nr * li) / den;
        bf16_t* bb = (bf16_t*)(tab + TAB_BB) + (size_t)g * 128 * 16; bf16_t* cm = (bf16_t*)(tab + TAB_CM) + (size_t)g * 16 * 128;
        for (int p = 0; p < 16; ++p) {
            const double br = (double)kin(17)[i * 16 + p], bi = (double)kin(18)[i * 16 + p];
            bb[n * 16 + p] = f2bf((float)(cr * br - ci * bi)); bb[(64 + n) * 16 + p] = f2bf((float)(cr * bi + ci * br));
            cm[p * 128 + n] = f2bf(kin(19)[((size_t)lg * 16 + p) * 64 + n]); cm[p * 128 + 64 + n] = f2bf(-kin(20)[((size_t)lg * 16 + p) * 64 + n]);
        }
    }
}
__device__ __forceinline__ void p0_misc(int wave, int lane, int vb, int NVB) {
    unsigned char* ws = kws(); float* out = kout();
    const size_t gt = (size_t)vb * 512 + wave * 64 + lane, NGT = (size_t)NVB * 512;
    {
        bf16_t* PB = (bf16_t*)(ws + WS_PB);
        for (size_t i = gt; i < (size_t)NL * M * 64; i += NGT) { const int l = (int)(i / ((size_t)M * 64)); const size_t rem = i % ((size_t)M * 64); const int row = (int)(rem >> 6), c4 = (int)(rem & 63);
            const float* src = (row < MP) ? kin(6) + ((size_t)l * MP + row) * 256 + c4 * 4 : kin(7) + ((size_t)l * MSM + (row - MP)) * 256 + c4 * 4;
            const f32x4 v = *(const f32x4*)src; u32x2 w; w.x = cvt_pk_bf16(v.x, v.y); w.y = cvt_pk_bf16(v.z, v.w); ((u32x2*)PB)[i] = w; }
    }
    {
        bf16_t* KS = (bf16_t*)(ws + WS_KS); bf16_t* VTS = (bf16_t*)(ws + WS_VTS);
        for (size_t i = gt; i < (size_t)NL * DB * 160 * 32; i += NGT) { const int c4 = (int)(i & 31); const size_t t1 = i >> 5; const int key = (int)(t1 % 160); const size_t lb = t1 / 160;
            u32x2 w; w.x = 0u; w.y = 0u;
            if (key < 128) { const f32x4 v = *(const f32x4*)(kin(2) + (lb * 128 + key) * 128 + c4 * 4); w.x = cvt_pk_bf16(v.x, v.y); w.y = cvt_pk_bf16(v.z, v.w); }
            ((u32x2*)KS)[i] = w; }
        for (size_t i = gt; i < (size_t)NL * DB * 32 * 160; i += NGT) { const int t = (int)(i % 160); const size_t t1 = i / 160; const int c4 = (int)(t1 & 31); const size_t lb = t1 >> 5;
            f32x4 v = {0.f, 0.f, 0.f, 0.f}; if (t < 128) v = *(const f32x4*)(kin(3) + (lb * 128 + t) * 128 + c4 * 4);
            const int c = c4 * 4; bf16_t* d = VTS + (lb * 2 + (c >> 6)) * 10240; const int i0 = vt_idx(t, c & 63); d[i0] = f2bf(v.x); d[i0 + 16] = f2bf(v.y); d[i0 + 32] = f2bf(v.z); d[i0 + 48] = f2bf(v.w); }
        for (size_t i = gt; i < (size_t)NL * DB * 120 * 32; i += NGT) { const int c4 = (int)(i & 31); const size_t t1 = i >> 5; const int j = (int)(t1 % 120); const size_t lb = t1 / 120;
            const size_t so = (lb * 128 + j + 8) * 128 + c4 * 4, dofs = (lb * 128 + j) * 128 + c4 * 4;
            *(f32x4*)(out + O_KS + dofs) = *(const f32x4*)(kin(2) + so); *(f32x4*)(out + O_VS + dofs) = *(const f32x4*)(kin(3) + so); }
    }
}

#define MFMA32(a, b, c) __builtin_amdgcn_mfma_f32_32x32x16_bf16((a), (b), (c), 0, 0, 0)
#ifndef MFMA16
#define MFMA16(a, b, c) __builtin_amdgcn_mfma_f32_16x16x32_bf16((a), (b), (c), 0, 0, 0)
#endif

template <bool PASS2, int SEG>
__device__ __forceinline__ void ssm_sub(unsigned char* wl, const bf16_t* urow0, const bf16x8 ua, const bf16x8 (&bfr)[4], const bf16x8 (&cfr)[4], float ar, float ai, float& hr, float& hi, int lane,
                                        const float* h0re, const float* h0im, float* ofre, float* ofim, int segstride, bf16_t* ygrow0, f32x4 dv) {
    float* BU = (float*)wl; unsigned short* HB = (unsigned short*)wl;
    const int r = lane & 31, hf = lane >> 5;
    u32x2 uu[2] = {{0u, 0u}, {0u, 0u}};
    if (PASS2) {
#pragma unroll
        for (int tb = 0; tb < 2; ++tb) uu[tb] = *(const u32x2*)(urow0 + (size_t)(tb * 16 + (lane & 15)) * 16 + 4 * (lane >> 4)); }
    float h0r[32 / SEG], h0i[32 / SEG];
#pragma unroll
    for (int sgi = 0; sgi < 32 / SEG; ++sgi) { h0r[sgi] = 0.f; h0i[sgi] = 0.f; if (SEG < 32) { h0r[sgi] = h0re[(size_t)sgi * segstride + lane]; h0i[sgi] = h0im[(size_t)sgi * segstride + lane]; } }
    asm volatile("" ::: "memory");
    {
#pragma unroll
        for (int cb = 0; cb < 4; ++cb) {
            f32x16 acc;
#pragma unroll
            for (int i = 0; i < 16; ++i) acc[i] = 0.f;
            acc = MFMA32(ua, bfr[cb], acc);
#pragma unroll
            for (int i = 0; i < 16; ++i) BU[((i & 3) + 8 * (i >> 2) + 4 * hf) * 128 + cb * 32 + r] = acc[i];
        }
    }
    asm volatile("" ::: "memory");
#pragma unroll 8
    for (int t = 0; t < 32; ++t) {
        if (SEG < 32 && (t % SEG) == 0) { hr = h0r[t / SEG]; hi = h0i[t / SEG]; }
        const float br = BU[t * 128 + lane], bi = BU[t * 128 + 64 + lane];
        const float nr = fmaf(ar, hr, fmaf(-ai, hi, br)), ni = fmaf(ar, hi, fmaf(ai, hr, bi));
        hr = nr; hi = ni;
        if (PASS2) { HB[t * 136 + lane] = f2bf(hr); HB[t * 136 + 64 + lane] = f2bf(hi); }
        if (SEG < 32 && (t % SEG) == SEG - 1) { ofre[(size_t)(t / SEG) * segstride + lane] = hr; ofim[(size_t)(t / SEG) * segstride + lane] = hi; }
    }
    asm volatile("" ::: "memory");
    if (PASS2) {
        const int tk = lane & 15, q4 = lane >> 4;
#pragma unroll
        for (int tb = 0; tb < 2; ++tb) {
            f32x4 acc = {0.f, 0.f, 0.f, 0.f};
#pragma unroll
            for (int ks = 0; ks < 4; ++ks) { const bf16x8 hfrag = *(const bf16x8*)(wl + (tb * 16 + tk) * 272 + (ks * 32 + q4 * 8) * 2); acc = MFMA16(cfr[ks], hfrag, acc); }
            const size_t ro = (size_t)(tb * 16 + tk) * 512 + 4 * q4;
            const float y0 = gelu_tanh(acc.x + dv.x * bflo(uu[tb].x)), y1 = gelu_tanh(acc.y + dv.y * bfhi(uu[tb].x)), y2 = gelu_tanh(acc.z + dv.z * bflo(uu[tb].y)), y3 = gelu_tanh(acc.w + dv.w * bfhi(uu[tb].y));
            u32x2 w; w.x = cvt_pk_bf16(y0, y1); w.y = cvt_pk_bf16(y2, y3); *(u32x2*)(ygrow0 + ro) = w;
        }
    }
    asm volatile("" ::: "memory");
}


struct Cx { float r, i; };
__device__ __forceinline__ Cx cmul(Cx a, Cx b) { return Cx{a.r * b.r - a.i * b.i, a.r * b.i + a.i * b.r}; }
__device__ __forceinline__ Cx cfma(Cx x, Cx a, Cx b) { return Cx{fmaf(x.r, a.r, fmaf(-x.i, a.i, b.r)), fmaf(x.r, a.i, fmaf(x.i, a.r, b.i))}; }
__device__ __forceinline__ void ssm_p1_sub(const bf16x8 ua, const bf16x8 (&bfr)[4], Cx aA, Cx aB, Cx a8A, Cx a8B, Cx a4own, Cx a32own, int hf, float& hr, float& hi) {
    f32x16 acc[4];
#pragma unroll
    for (int cb = 0; cb < 4; ++cb) {
#pragma unroll
        for (int i = 0; i < 16; ++i) acc[cb][i] = 0.f;
        acc[cb] = MFMA32(ua, bfr[cb], acc[cb]);
    }
    Cx SA = {0.f, 0.f}, SB = {0.f, 0.f};
#pragma unroll
    for (int j = 0; j < 4; ++j) {
        Cx sa = {acc[0][4 * j], acc[2][4 * j]}, sb = {acc[1][4 * j], acc[3][4 * j]};
#pragma unroll
        for (int q = 1; q < 4; ++q) { sa = cfma(sa, aA, Cx{acc[0][4 * j + q], acc[2][4 * j + q]}); sb = cfma(sb, aB, Cx{acc[1][4 * j + q], acc[3][4 * j + q]}); }
        if (j == 0) { SA = sa; SB = sb; } else { SA = cfma(SA, a8A, sa); SB = cfma(SB, a8B, sb); }
    }
    const float sr = hf ? SA.r : SB.r, si = hf ? SA.i : SB.i;
    const Cx other = {__shfl_xor(sr, 32), __shfl_xor(si, 32)}, own = hf ? SB : SA;
    const Cx S = hf ? cfma(other, a4own, own) : cfma(own, a4own, other);
    const Cx h = cfma(Cx{hr, hi}, a32own, S);
    hr = h.r; hi = h.i;
}
__device__ __forceinline__ void ssm_phase(unsigned char* lds, int l, int wave, int lane) {
    unsigned char* ws = kws(); float* out = kout();
    const unsigned char* tab = ws + WS_TAB + (size_t)l * TAB_LAYER;
    const bf16_t* UB = (const bf16_t*)(ws + WS_HB); bf16_t* YG = (bf16_t*)(ws + WS_HB + 2 * SZ_512);
    unsigned char* wl = lds + wave * 16384; float* xch = (float*)(lds + 131072);
    const int r = lane & 31, hf = lane >> 5, tk = lane & 15, q4 = lane >> 4;
    for (int unit = blockIdx.x; unit < NB * 32; unit += gridDim.x) {
        const int b = unit >> 5, g = unit & 31;
        bf16x8 bfr[4], cfr[4];
#pragma unroll
        for (int cb = 0; cb < 4; ++cb) bfr[cb] = *(const bf16x8*)((const bf16_t*)(tab + TAB_BB) + ((size_t)g * 128 + cb * 32 + r) * 16 + hf * 8);
#pragma unroll
        for (int ks = 0; ks < 4; ++ks) cfr[ks] = *(const bf16x8*)((const bf16_t*)(tab + TAB_CM) + ((size_t)g * 16 + tk) * 128 + ks * 32 + q4 * 8);
        const float ar = ((const float*)(tab + TAB_AR))[g * 64 + lane], ai = ((const float*)(tab + TAB_AI))[g * 64 + lane];
        const float a2r = ((const float*)(tab + TAB_A2R))[g * 64 + lane], a2i = ((const float*)(tab + TAB_A2I))[g * 64 + lane];
        const f32x4 dv = *(const f32x4*)(kin(21) + l * 512 + g * 16 + 4 * q4);
        const size_t row0 = (size_t)b * SEQ + wave * 256;
        float hr = 0.f, hi = 0.f;
        const bf16_t* ublk = UB + ((row0 >> 5) * 32 + g) * 512;
        const bf16_t* ub0 = ublk + r * 16 + hf * 8;
        bf16x8 ua = *(const bf16x8*)ub0;
        {
            const float* TAR = (const float*)(tab + TAB_AR) + g * 64; const float* TAI = (const float*)(tab + TAB_AI) + g * 64;
            const Cx aA = {TAR[r], TAI[r]}, aB = {TAR[32 + r], TAI[32 + r]};
            const Cx a2A = cmul(aA, aA), a4A = cmul(a2A, a2A), a8A = cmul(a4A, a4A), a2B = cmul(aB, aB), a4B = cmul(a2B, a2B), a8B = cmul(a4B, a4B);
            const Cx a8o = hf ? a8B : a8A, a16o = cmul(a8o, a8o), a32o = cmul(a16o, a16o), a4o = hf ? a4B : a4A;
            for (int sc = 0; sc < 8; ++sc) { const bf16x8 uc = ua; ua = *(const bf16x8*)(ub0 + (size_t)((sc + 1) & 7) * 32 * 512);
                ssm_p1_sub(uc, bfr, aA, aB, a8A, a8B, a4o, a32o, hf, hr, hi); }
        }
        xch[wave * 128 + lane] = hr; xch[wave * 128 + 64 + lane] = hi;
        __syncthreads();
        float cr = 0.f, ci = 0.f;
        for (int j = 0; j < wave; ++j) { const float sr = xch[j * 128 + lane], si = xch[j * 128 + 64 + lane];
            const float nr = fmaf(a2r, cr, fmaf(-a2i, ci, sr)), ni = fmaf(a2r, ci, fmaf(a2i, cr, si)); cr = nr; ci = ni; }
        hr = cr; hi = ci;
        for (int sc = 0; sc < 8; ++sc) { const bf16x8 uc = ua; ua = *(const bf16x8*)(ub0 + (size_t)((sc + 1) & 7) * 32 * 512);
            ssm_sub<true, 32>(wl, ublk + (size_t)sc * 32 * 512, uc, bfr, cfr, ar, ai, hr, hi, lane, nullptr, nullptr, nullptr, nullptr, 0, YG + (row0 + sc * 32) * 512 + g * 16, dv); }
        if (wave == 7) { out[O_HPR + ((size_t)(l * NB + b) * 32 + g) * 64 + lane] = hr; out[O_HPI + ((size_t)(l * NB + b) * 32 + g) * 64 + lane] = hi; }
        __syncthreads();
    }
    for (int wu = blockIdx.x * 8 + wave; wu < 32 * 32; wu += gridDim.x * 8) {
        const int g = wu & 31, bq = wu >> 5;
        bf16x8 bfr[4], cfr[4];
#pragma unroll
        for (int cb = 0; cb < 4; ++cb) bfr[cb] = *(const bf16x8*)((const bf16_t*)(tab + TAB_BB) + ((size_t)g * 128 + cb * 32 + r) * 16 + hf * 8);
#pragma unroll
        for (int ks = 0; ks < 4; ++ks) cfr[ks] = *(const bf16x8*)((const bf16_t*)(tab + TAB_CM) + ((size_t)g * 16 + tk) * 128 + ks * 32 + q4 * 8);
        const float ar = ((const float*)(tab + TAB_AR))[g * 64 + lane], ai = ((const float*)(tab + TAB_AI))[g * 64 + lane];
        const f32x4 dv = *(const f32x4*)(kin(21) + l * 512 + g * 16 + 4 * q4);
        const size_t row0 = (size_t)MP + bq * 32; const size_t so = ((size_t)(l * DB + bq * 4) * 32 + g) * 64;
        float hr = 0.f, hi = 0.f;
        ssm_sub<true, 8>(wl, UB + ((row0 >> 5) * 32 + g) * 512, *(const bf16x8*)(UB + ((row0 >> 5) * 32 + g) * 512 + r * 16 + hf * 8), bfr, cfr, ar, ai, hr, hi, lane, kin(4) + so, kin(5) + so, out + O_HSR + so, out + O_HSI + so, 32 * 64, YG + row0 * 512 + g * 16, dv);
    }
}

__device__ __forceinline__ void attn_wave(const bf16_t* QB, const bf16_t* Kseq, const bf16_t* Vseq, int tstride, int qrow_base, int nq, int q0, float sink, bf16_t* YA, float* ssqT, int h, int lane) {
    const int r = lane & 31, hf = lane >> 5;
    const int qrow = qrow_base + (r < nq ? r : nq - 1);
    bf16x8 qf[4];
#pragma unroll
    for (int ks = 0; ks < 4; ++ks) qf[ks] = *(const bf16x8*)(QB + (size_t)qrow * 512 + h * 64 + ks * 16 + hf * 8);
    f32x16 s[5];
    const int kb0 = q0 - 128;
#pragma unroll
    for (int jb = 0; jb < 5; ++jb) {
#pragma unroll
        for (int i = 0; i < 16; ++i) s[jb][i] = 0.f;
        const int kp0 = kb0 + 32 * jb;
        if (kp0 >= 0) {
            const bf16_t* kptr = Kseq + (size_t)(kp0 + r) * 128 + hf * 8;
#pragma unroll
            for (int ks = 0; ks < 4; ++ks) { const bf16x8 kf = *(const bf16x8*)(kptr + ks * 16); s[jb] = MFMA32(kf, qf[ks], s[jb]); }
        }
    }
    bf16x8 vfr[5][2][2];
#pragma unroll
    for (int jb = 0; jb < 5; ++jb) {
        const int kp0 = kb0 + 32 * jb;
#pragma unroll
        for (int st = 0; st < 2; ++st)
#pragma unroll
            for (int db = 0; db < 2; ++db) {
                if (kp0 >= 0) vfr[jb][st][db] = *(const bf16x8*)(Vseq + (size_t)((kp0 + 16 * st) >> 4) * 1024 + (db * 32 + r) * 16 + hf * 8);
                else vfr[jb][st][db] = (bf16x8){0, 0, 0, 0, 0, 0, 0, 0}; }
    }
    const int qp = q0 + r;
    float mx = sink;
#pragma unroll
    for (int jb = 0; jb < 5; ++jb)
#pragma unroll
        for (int i = 0; i < 16; ++i) { const int kp = kb0 + 32 * jb + (i & 3) + 8 * (i >> 2) + 4 * hf; const bool ok = (kp >= 0) && (kp <= qp) && (qp - kp < 128);
            s[jb][i] = ok ? s[jb][i] : -1e30f; mx = fmaxf(mx, s[jb][i]); }
    mx = fmaxf(mx, __shfl_xor(mx, 32));
    float sum = 0.f;
#pragma unroll
    for (int jb = 0; jb < 5; ++jb)
#pragma unroll
        for (int i = 0; i < 16; ++i) { const float p = (s[jb][i] > -1e29f) ? __builtin_amdgcn_exp2f((s[jb][i] - mx) * 1.44269504f) : 0.f; s[jb][i] = p; sum += p; }
    sum += __shfl_xor(sum, 32);
    sum += __builtin_amdgcn_exp2f((sink - mx) * 1.44269504f);
    const float inv = 1.0f / sum;
    f32x16 o[2];
#pragma unroll
    for (int i = 0; i < 16; ++i) { o[0][i] = 0.f; o[1][i] = 0.f; }
#pragma unroll
    for (int jb = 0; jb < 5; ++jb) {
        const int kp0 = kb0 + 32 * jb;
        if (kp0 >= 0) {
#pragma unroll
            for (int st = 0; st < 2; ++st) {
                union { bf16x8 v; unsigned u[4]; } pf;
#pragma unroll
                for (int j = 0; j < 4; ++j) pf.u[j] = cvt_pk_bf16(s[jb][8 * st + 2 * j], s[jb][8 * st + 2 * j + 1]);
#pragma unroll
                for (int db = 0; db < 2; ++db) {
                    o[db] = MFMA32(vfr[jb][st][db], pf.v, o[db]);
                }
            }
        }
    }
    float sq = 0.f;
#pragma unroll
    for (int db = 0; db < 2; ++db)
#pragma unroll
        for (int ig = 0; ig < 4; ++ig) {
            const float v0 = o[db][4 * ig] * inv, v1 = o[db][4 * ig + 1] * inv, v2 = o[db][4 * ig + 2] * inv, v3 = o[db][4 * ig + 3] * inv;
            sq += (v0 * v0 + v1 * v1) + (v2 * v2 + v3 * v3);
            if (r < nq) { u32x2 w; w.x = cvt_pk_bf16(v0, v1); w.y = cvt_pk_bf16(v2, v3); *(u32x2*)(YA + (size_t)qrow * 512 + h * 64 + db * 32 + 8 * ig + 4 * hf) = w; }
        }
    sq += __shfl_xor(sq, 32);
    if (hf == 0 && r < nq) ssqT[(size_t)qrow * 8 + h] = sq;
}

__device__ __forceinline__ void attn_phase(int l, int wave, int lane) {
    unsigned char* ws = kws();
    const bf16_t* QB = (const bf16_t*)(ws + WS_HB + SZ_512); bf16_t* YA = (bf16_t*)(ws + WS_HB + 4 * SZ_512);
    const bf16_t* KP = (const bf16_t*)(ws + WS_KP); const bf16_t* VTP = (const bf16_t*)(ws + WS_VTP);
    const bf16_t* KS = (const bf16_t*)(ws + WS_KS); const bf16_t* VTS = (const bf16_t*)(ws + WS_VTS);
    float* ssqT = (float*)(ws + WS_SSQ + 4 * SZ_SSQ16 + SZ_SSQ8);
    const int h = wave, kvh = h >> 2; const float sink = kin(24)[l * 8 + h];
    const int c = (int)blockIdx.x; const bool deal = (gridDim.x == 256);
    for (int k = 0; k < 640; ++k) {
        int bu;
        if (deal) { if (c >= 128) { if (k < 3) bu = 3 * (c - 128) + k; else break; } else { if (k < 2) bu = 384 + 2 * c + k; else break; } }
        else { bu = c + k * (int)gridDim.x; if (bu >= 512 + DB) break; }
        if (bu < 512) { const int b = bu >> 6, q0 = (bu & 63) * 32;
            attn_wave(QB, KP + (size_t)b * SEQ * 128 + kvh * 64, VTP + (size_t)(b * 2 + kvh) * 64 * 2048, 2048, b * SEQ + q0, 32, q0, sink, YA, ssqT, h, lane);
        } else { const int sb = bu - 512;
            attn_wave(QB, KS + (size_t)(l * DB + sb) * 160 * 128 + kvh * 64, VTS + (size_t)((l * DB + sb) * 2 + kvh) * 64 * 160, 160, MP + sb * 8, 8, 128, sink, YA, ssqT, h, lane);
        }
    }
}

#define XB_TMO      128
#define XB_XCNT(j)  (256  + 64 * (j))
#define XB_XSUB(j)  (1280 + 64 * (j))
#define XB_XGEN(j)  (2304 + 64 * (j))
#define XB_TOP      3328
#define XB_TOPGEN   3392
#define XCD_BAR_WORDS 3456
#define XB_SPIN_CAP (1u << 18)
#define LAS __attribute__((address_space(3)))

__device__ __forceinline__ unsigned xb_ld(unsigned* p)              { return __hip_atomic_load(p, __ATOMIC_RELAXED, __HIP_MEMORY_SCOPE_AGENT); }
__device__ __forceinline__ unsigned xb_add(unsigned* p, unsigned v) { return __hip_atomic_fetch_add(p, v, __ATOMIC_RELAXED, __HIP_MEMORY_SCOPE_AGENT); }
__device__ __forceinline__ unsigned xb_xcc_id() { return (unsigned)__builtin_amdgcn_s_getreg((3 << 11) | 20) & 0xFu; }
#define XB_SPIN(cond, bar) do { unsigned _sp = 0; while (cond) { __builtin_amdgcn_s_sleep(1); \
    if ((++_sp & 255u) == 0u) { if (xb_ld(&(bar)[XB_TMO])) break; if (_sp > XB_SPIN_CAP) { atomicAdd(&(bar)[XB_TMO], 1u); break; } } } } while (0)

struct XcdBarrier {
    unsigned* bar; unsigned x;
    volatile LAS unsigned* st;
};

__device__ __forceinline__ XcdBarrier xcd_barrier_post(unsigned* bar, volatile LAS unsigned* st) {
    XcdBarrier b; b.bar = bar; b.x = xb_xcc_id(); b.st = st;
    if (threadIdx.x == 0) (void)xb_add(&bar[XB_XCNT(b.x)], 1u);
    return b;
}
__device__ __forceinline__ void xcd_barrier_complete(unsigned* bar, unsigned x, unsigned& nloc, unsigned& nx) {
    const unsigned G = gridDim.x * gridDim.y * gridDim.z;
    unsigned sum, cnt, mine, sp = 0u;
    for (;;) {
        sum = 0u; cnt = 0u; mine = 0u;
#pragma unroll
        for (unsigned j = 0; j < 16; ++j) { const unsigned c = xb_ld(&bar[XB_XCNT(j)]); sum += c; cnt += (c > 0u) ? 1u : 0u; mine = (j == x) ? c : mine; }
        if (sum == G) break;
        __builtin_amdgcn_s_sleep(1);
        if ((++sp & 255u) == 0u) { if (xb_ld(&bar[XB_TMO])) break; if (sp > XB_SPIN_CAP) { atomicAdd(&bar[XB_TMO], 1u); break; } }
    }
    nloc = mine > 0u ? mine : 1u; nx = cnt > 0u ? cnt : 1u;
}

__device__ __forceinline__ void xcd_barrier(const XcdBarrier& b) {
    asm volatile("s_waitcnt vmcnt(0)" ::: "memory");
    __syncthreads();
    if (pg8::tid_from_lds((const volatile LAS unsigned*)(b.st + 4)) == 0) {
        unsigned* bar = b.bar;
        __builtin_amdgcn_s_waitcnt(0);
        unsigned nloc = b.st[0], nx = b.st[1];
        if (nloc == 0u) { xcd_barrier_complete(bar, b.x, nloc, nx); b.st[0] = nloc; b.st[1] = nx; }
        const unsigned old = xb_add(&bar[XB_XSUB(b.x)], 1u);
        const unsigned gen = old / nloc;
        if (old + 1u == (gen + 1u) * nloc) {
            __builtin_amdgcn_fence(__ATOMIC_RELEASE, "agent");
            asm volatile("s_waitcnt vmcnt(0)" ::: "memory");
            const unsigned og = xb_add(&bar[XB_TOP], 1u);
            const unsigned tg = og / nx;
            if (og + 1u == (tg + 1u) * nx) xb_add(&bar[XB_TOPGEN], 1u);
            else XB_SPIN(xb_ld(&bar[XB_TOPGEN]) == tg, bar);
            __builtin_amdgcn_fence(__ATOMIC_ACQUIRE, "agent");
            xb_add(&bar[XB_XGEN(b.x)], 1u);
            asm volatile("s_waitcnt vmcnt(0)" ::: "memory");
        } else {
            XB_SPIN(xb_ld(&bar[XB_XGEN(b.x)]) == gen, bar);
            __builtin_amdgcn_fence(__ATOMIC_ACQUIRE, "agent");
            asm volatile("s_waitcnt vmcnt(0)" ::: "memory");
        }
    }
    __syncthreads();
}

__device__ __forceinline__ void gbar(unsigned char* lds) {
    XcdBarrier b; b.bar = (unsigned*)(kws() + WS_BAR); b.x = xb_xcc_id(); b.st = (volatile LAS unsigned*)(lds + ST_OFF);
    xcd_barrier(b);
}
#define PH_BEGIN unsigned char* ws = kws(); float* out = kout(); (void)out; \
    bf16_t* XBa = (bf16_t*)(ws + WS_XB0); bf16_t* XBb = (bf16_t*)(ws + WS_XB1); bf16_t* HB = (bf16_t*)(ws + WS_HB); (void)XBa; (void)XBb; (void)HB; \
    const bf16_t* WL = (const bf16_t*)(ws + WS_W) + (size_t)l * E_WLAYER; (void)WL; \
    float* ssq0 = (float*)(ws + WS_SSQ); float* ssq1 = (float*)(ws + WS_SSQ + SZ_SSQ16); float* ssq2 = (float*)(ws + WS_SSQ + 2 * SZ_SSQ16); float* ssq3 = (float*)(ws + WS_SSQ + 3 * SZ_SSQ16); \
    float* ssqS = (float*)(ws + WS_SSQ + 4 * SZ_SSQ16); float* ssqT = (float*)(ws + WS_SSQ + 4 * SZ_SSQ16 + SZ_SSQ8); (void)ssq0; (void)ssq1; (void)ssq2; (void)ssq3; (void)ssqS; (void)ssqT;

__global__ void __launch_bounds__(512, 2) mega_fwd(Args a_unused) {
    extern __shared__ __attribute__((aligned(16))) unsigned char lds[];
    cg::grid_group grid = cg::this_grid();
    if (gridDim.x == 0x7fffffffu) grid.sync();
    if (threadIdx.x < 4) ((volatile LAS unsigned*)(lds + ST_OFF))[threadIdx.x] = 0u;
    if ((threadIdx.x & 63) == 0) ((volatile LAS unsigned*)(lds + ST_OFF + 16))[(unsigned)__builtin_amdgcn_s_getreg((5 << 11) | 4) & 63u] = threadIdx.x >> 6;
    __syncthreads();
    (void)xcd_barrier_post((unsigned*)(kws() + WS_BAR), (volatile LAS unsigned*)(lds + ST_OFF));
    {
        int tid = MYTID(); asm volatile("" : "+v"(tid)); const int lane = tid & 63, wave = __builtin_amdgcn_readfirstlane(tid >> 6);
        p0_phase(lds, wave, lane);
    }
    gbar(lds);
#pragma nounroll
    for (int l = 0; l < NL; ++l) {
        { PH_BEGIN EpiSwiglu E{HB, ssq0}; run_gemm(lds, XBa, WL + OW_GU1, 2 * FF, D, E, M); }
        if (l == 0 && bid() >= 216) { int tid = MYTID(); asm volatile("" : "+v"(tid)); const int lane = tid & 63, wave = __builtin_amdgcn_readfirstlane(tid >> 6);
            conv_weights(lds, wave, lane, 0, 2 * 16 * 88, 3 * 16 * 88, (bid() - 216) * 8 + wave, (gdim() - 216) * 8); }
        gbar(lds);
        { PH_BEGIN EpiRes<0, true> E{XBa, XBb, ssq1, nullptr, nullptr}; run_gemm(lds, HB, WL + OW_D1, D, FF, E); }
        { PH_BEGIN SMALL(1, 16, 0, {HB, FF, WL + OW_D1, FF, l, 1, 1, 0, 0, 0}) }
        { int tid = MYTID(); asm volatile("" : "+v"(tid)); const int lane = tid & 63, wave = __builtin_amdgcn_readfirstlane(tid >> 6);
          if (l == 0) { conv_weights(lds, wave, lane, 0, 3 * 16 * 88, I_LAYER_ALL, bid() * 8 + wave, gdim() * 8); p0_misc(wave, lane, bid(), gdim()); }
        }
        gbar(lds);
        { PH_BEGIN EpiIn E{HB, (bf16_t*)(ws + WS_HB + SZ_512), (bf16_t*)(ws + WS_KP), (bf16_t*)(ws + WS_VTP), (bf16_t*)(ws + WS_KS), (bf16_t*)(ws + WS_VTS), ssq1, out + O_KP, out + O_VP, out + O_KS, out + O_VS, l};
          run_gemm(lds, XBb, WL + OW_IN, INW, D, E, M); }
        if (l + 1 < NL && bid() >= 84) { int tid = MYTID(); asm volatile("" : "+v"(tid)); const int lane = tid & 63, wave = __builtin_amdgcn_readfirstlane(tid >> 6);
            conv_weights(lds, wave, lane, l + 1, 0, I_LAYER_ALL, (bid() - 84) * 8 + wave, (gdim() - 84) * 8); }
        if (l + 1 == NL && bid() >= 84) {
            { PH_BEGIN EpiBf E{(bf16_t*)out, D}; run_gemm(lds, (const bf16_t*)(ws + WS_PB) + (size_t)l * M * 256, WL + OW_PP, D, 256, E, MP, 84); }
            { PH_BEGIN SMALL(4, 16, 84, {(const bf16_t*)(ws + WS_PB) + (size_t)l * M * 256, 256, WL + OW_PP, 256, l, 0, 0, 0, 0, 0}) } }
        gbar(lds);
        {
            int tid = MYTID(); asm volatile("" : "+v"(tid)); const int lane = tid & 63, wave = __builtin_amdgcn_readfirstlane(tid >> 6);
            ssm_phase(lds, l, wave, lane);
        }
        gbar(lds);
        { PH_BEGIN const bf16_t* YG = (const bf16_t*)(ws + WS_HB + 2 * SZ_512); EpiGlu E{YG, (bf16_t*)(ws + WS_HB + 3 * SZ_512), ssqS}; run_gemm(lds, YG, WL + OW_GLU, 512, 512, E); }
        { PH_BEGIN SMALL(3, 8, 128, {(const bf16_t*)(ws + WS_HB + 2 * SZ_512), 512, WL + OW_GLU, 512, l, 0, 0, 0, 0, 0}) }
        {
            int tid = MYTID(); asm volatile("" : "+v"(tid)); const int lane = tid & 63, wave = __builtin_amdgcn_readfirstlane(tid >> 6);
            attn_phase(l, wave, lane);
        }
        gbar(lds);
        { PH_BEGIN SMALL(1, 16, 0, {(const bf16_t*)(ws + WS_HB + 3 * SZ_512), 512, WL + OW_OA, 512, l, 0, -1, 0, 1, 1}) }
        { PH_BEGIN EpiRes<1, true> E{XBb, XBa, ssq2, ssqT, (const bf16_t*)ssqS};
          run_gemm2(lds, (const bf16_t*)(ws + WS_HB + 3 * SZ_512), WL + OW_OA, (const bf16_t*)(ws + WS_HB + 4 * SZ_512), WL + OW_OB, D, 512, E); }
        { PH_BEGIN SMALL(1, 16, 0, {(const bf16_t*)(ws + WS_HB + 4 * SZ_512), 512, WL + OW_OB, 512, l, 0, 2, 1, 1, 0}) }
        gbar(lds);
        { PH_BEGIN EpiSwiglu E{HB, ssq2}; run_gemm(lds, XBa, WL + OW_GU2, 2 * FF, D, E, M); }
        gbar(lds);
        { PH_BEGIN EpiRes<0, true> E{XBa, XBb, ssq3, nullptr, nullptr}; run_gemm(lds, HB, WL + OW_D2, D, FF, E); }
        { PH_BEGIN SMALL(1, 16, 0, {HB, FF, WL + OW_D2, FF, l, 1, 3, 0, 0, 0}) }
        if (l + 1 < NL) {
            { PH_BEGIN EpiBf E{(bf16_t*)out, D}; run_gemm(lds, (const bf16_t*)(ws + WS_PB) + (size_t)l * M * 256, WL + OW_PP, D, 256, E); }
            { PH_BEGIN SMALL(4, 16, 0, {(const bf16_t*)(ws + WS_PB) + (size_t)l * M * 256, 256, WL + OW_PP, 256, l, 0, 0, 0, 0, 0}) } }
        gbar(lds);
        { PH_BEGIN EpiRes<2, true> E{XBb, XBa, ssq0, ssq3, (const bf16_t*)out}; run_gemm(lds, XBb, WL + OW_PG, D, D, E); }
        { PH_BEGIN SMALL(1, 16, 0, {XBb, D, WL + OW_PG, D, l, 0, 0, 3, 2, 1}) }
        gbar(lds);
    }
    {
        int tid = MYTID(); asm volatile("" : "+v"(tid)); const int lane = tid & 63, wave = __builtin_amdgcn_readfirstlane(tid >> 6);
        unsigned char* ws = kws(); float* out = kout(); const float* ssq0 = (const float*)(ws + WS_SSQ); const bf16_t* XBa = (const bf16_t*)(ws + WS_XB0);
        const float* gfin = kin(34);
        for (int m = bid() * 8 + wave; m < M; m += gdim() * 8) {
            float t = (lane < 16) ? ssq0[(size_t)m * 16 + lane] : 0.f; t = wave_sum(t);
            const float rs = __builtin_amdgcn_rsqf(t * (1.f / 1024.f) + 1e-6f);
#pragma unroll
            for (int j = 0; j < 2; ++j) {
                const int c = 512 * j + 8 * lane; const u32x4 xw = *(const u32x4*)(XBa + (size_t)m * D + c);
                const f32x4 g0 = *(const f32x4*)(gfin + c), g1 = *(const f32x4*)(gfin + c + 4);
                f32x4 y0 = {bflo(xw.x), bfhi(xw.x), bflo(xw.y), bfhi(xw.y)}, y1 = {bflo(xw.z), bfhi(xw.z), bflo(xw.w), bfhi(xw.w)};
                y0 = y0 * rs * g0; y1 = y1 * rs * g1;
                *(f32x4*)(out + (size_t)m * D + c) = y0; *(f32x4*)(out + (size_t)m * D + c + 4) = y1;
            }
        }
    }
}

extern "C" void kernel_launch(void* const* d_in, const int* in_sizes, int n_in, void* d_out, int out_size, void* d_ws, size_t ws_size, hipStream_t stream) {
    static int grid_blocks = 0;
    if (!grid_blocks) {
        int dev = 0, cus = 0, per_cu = 0;
        hipGetDevice(&dev);
        hipDeviceGetAttribute(&cus, hipDeviceAttributeMultiprocessorCount, dev);
        hipFuncSetAttribute((const void*)mega_fwd, hipFuncAttributeMaxDynamicSharedMemorySize, LDS_BYTES);
        hipOccupancyMaxActiveBlocksPerMultiprocessor(&per_cu, (const void*)mega_fwd, 512, LDS_BYTES);
        if (per_cu < 1) per_cu = 1;
        if (cus < 1) cus = 256;
        grid_blocks = cus * per_cu;
        if (ws_size < WS_END) fprintf(stderr, "kernel_launch: workspace too small: %zu < %zu\n", ws_size, (size_t)WS_END);
    }
    if (hipMemsetAsync((char*)d_ws + WS_BAR, 0, 16384, stream) != hipSuccess) fprintf(stderr, "memset failed\n");
    Args a{};
    for (int i = 0; i < NIN; ++i) a.in[i] = (const float*)d_in[i];
    a.out = (float*)d_out; a.ws = (unsigned char*)d_ws;
    void* args[] = {&a};
    hipError_t e = hipLaunchCooperativeKernel((const void*)mega_fwd, dim3(grid_blocks), dim3(512), args, LDS_BYTES, stream);
    if (e != hipSuccess) fprintf(stderr, "cooperative launch failed: %s (grid %d)\n", hipGetErrorString(e), grid_blocks);
}
```
